# Optimizing an MI355X kernel written in HIP

```python
import math
import jax, jax.numpy as jnp
from jax import lax
import numpy as np

D_MODEL = 2048
BATCH = 8
SEQ = 2048
DEPTH = 1

D_MIX = D_MODEL
POOL_WIDTH = D_MIX // 2
N_POOL_GROUPS = 4
POOL_GROUP_WIDTH = POOL_WIDTH // N_POOL_GROUPS
POOL_WINDOWS = (2, 4, 8, 16)
ATTN_WIDTH = D_MIX - POOL_WIDTH
HEAD_DIM = 128
N_HEADS = ATTN_WIDTH // HEAD_DIM
N_KV_HEADS = 2
HEAD_GROUP = N_HEADS // N_KV_HEADS
IDX_HEADS = 16
IDX_DIM = 64
TOPK_MAX = 256
ATTN_BLOCK = 128
N_BUCKETS = 32
MAX_DISTANCE = 128
N_GROUPS = 4
EXPERTS_PER_GROUP = 8
N_EXPERTS = N_GROUPS * EXPERTS_PER_GROUP
TOPK_EXPERTS = 2
D_EXPERT = D_MODEL // 4
MOE_BLOCK = 128
EPS = 1e-6
NEG_INF = -1e30
P_IN = (POOL_WIDTH + N_HEADS * HEAD_DIM + 2 * N_KV_HEADS * HEAD_DIM
        + IDX_HEADS * IDX_DIM + IDX_DIM + IDX_HEADS)

kernel_name = "hybrid_pool_dsa_hmoe_block"


def rmsnorm(x, g):
    xf = x.astype(jnp.float32)
    y = xf * lax.rsqrt(jnp.mean(xf * xf, axis=-1, keepdims=True) + EPS)
    return (y * g.astype(jnp.float32)).astype(x.dtype)


def modulate(h, shift, scale):
    return h * (1.0 + scale[:, None, :]) + shift[:, None, :]


def t5_bucket(rel):
    max_exact = N_BUCKETS // 2
    is_small = rel < max_exact
    relf = jnp.maximum(rel, 1).astype(jnp.float32)
    large = max_exact + (jnp.log(relf / max_exact) / math.log(MAX_DISTANCE / max_exact)
                         * (N_BUCKETS - max_exact)).astype(jnp.int32)
    large = jnp.minimum(large, N_BUCKETS - 1)
    return jnp.where(is_small, rel, large)


def pool_mixer(u, w_pool, pool_scale):
    b, s, _ = u.shape
    ug = u.astype(jnp.float32).reshape(b, s, N_POOL_GROUPS, POOL_GROUP_WIDTH)
    cs = jnp.cumsum(ug, axis=1)
    t = jnp.arange(s)
    outs = []
    for g, w in enumerate(POOL_WINDOWS):
        cp = jnp.pad(cs[:, :, g], ((0, 0), (w, 0), (0, 0)))
        win = cp[:, w:w + s] - cp[:, :s]
        cnt = jnp.minimum(t + 1, w).astype(jnp.float32)
        outs.append(win / cnt[None, :, None] - ug[:, :, g])
    p = jnp.stack(outs, axis=2).astype(u.dtype)
    y = jnp.einsum('bsgc,gcd->bsgd', p, w_pool)
    return y.reshape(b, s, POOL_WIDTH) * pool_scale


def dsa_mixer(q, k, v, q_idx, k_idx, w_idx, rel_bias):
    b, s = q.shape[0], q.shape[1]
    topk = min(TOPK_MAX, s // 4)
    nblk = s // ATTN_BLOCK

    def to_blocks(a):
        return a.reshape(b, nblk, ATTN_BLOCK, *a.shape[2:]).swapaxes(0, 1)

    qb, qib, wib = to_blocks(q), to_blocks(q_idx), to_blocks(w_idx)
    kif = k_idx.astype(jnp.float32)
    key_pos = jnp.arange(s)
    idx_scale = (IDX_DIM ** -0.5) * (IDX_HEADS ** -0.5)
    gather = jax.vmap(lambda kb, ib: kb[ib])

    def block_fn(args):
        blk, qblk, qiblk, wiblk = args
        qpos = blk * ATTN_BLOCK + jnp.arange(ATTN_BLOCK)
        dots = jnp.einsum('bqhd,bsd->bqhs', qiblk.astype(jnp.float32), kif)
        score = jnp.einsum('bqh,bqhs->bqs', wiblk.astype(jnp.float32), jax.nn.relu(dots)) * idx_scale
        causal = key_pos[None, :] <= qpos[:, None]
        score = jnp.where(causal[None], score, NEG_INF)
        _, sel = lax.top_k(score, topk)
        valid = sel <= qpos[None, :, None]
        k_sel = gather(k, sel)
        v_sel = gather(v, sel)
        qg = qblk.reshape(b, ATTN_BLOCK, N_KV_HEADS, HEAD_GROUP, HEAD_DIM)
        logits = jnp.einsum('bqhgd,bqjhd->bqhgj', qg, k_sel).astype(jnp.float32) * (HEAD_DIM ** -0.5)
        bucket = t5_bucket(jnp.maximum(qpos[None, :, None] - sel, 0))
        bias = rel_bias.astype(jnp.float32)[bucket]
        bias = bias.reshape(b, ATTN_BLOCK, topk, N_KV_HEADS, HEAD_GROUP).transpose(0, 1, 3, 4, 2)
        logits = jnp.where(valid[:, :, None, None, :], logits + bias, NEG_INF)
        probs = jax.nn.softmax(logits, axis=-1).astype(v_sel.dtype)
        o = jnp.einsum('bqhgj,bqjhd->bqhgd', probs, v_sel)
        return o.reshape(b, ATTN_BLOCK, N_HEADS * HEAD_DIM)

    out = lax.map(block_fn, (jnp.arange(nblk), qb, qib, wib))
    return out.swapaxes(0, 1).reshape(b, s, N_HEADS * HEAD_DIM)


def hier_moe(h, w_group, b_group, w_router, b_router, w_gate, w_up, w_down):
    b, s, d = h.shape
    n_tok = b * s
    ht = h.reshape(n_tok, d)
    glog = (ht @ w_group).astype(jnp.float32) + b_group
    gprob = jax.nn.softmax(glog, axis=-1)
    g_sel = jnp.argmax(glog, axis=-1)
    onehot = jax.nn.one_hot(g_sel, N_GROUPS, dtype=jnp.float32)
    p_g = jnp.sum(gprob * onehot, axis=-1)
    elog = ((ht @ w_router).astype(jnp.float32) + b_router).reshape(n_tok, N_GROUPS, EXPERTS_PER_GROUP)
    elog_sel = jnp.einsum('tg,tge->te', onehot, elog)
    eprob = jax.nn.softmax(elog_sel, axis=-1)
    top_p, top_i = lax.top_k(eprob, TOPK_EXPERTS)
    gates = p_g[:, None] * top_p / jnp.sum(top_p, axis=-1, keepdims=True)
    expert_ids = g_sel[:, None].astype(jnp.int32) * EXPERTS_PER_GROUP + top_i.astype(jnp.int32)

    n_asg = n_tok * TOPK_EXPERTS
    e_flat = expert_ids.reshape(n_asg)
    tok_flat = jnp.repeat(jnp.arange(n_tok, dtype=jnp.int32), TOPK_EXPERTS)
    gate_flat = gates.reshape(n_asg)
    order = jnp.argsort(e_flat)
    e_sorted = e_flat[order]
    counts = jnp.zeros((N_EXPERTS,), jnp.int32).at[e_flat].add(1)
    padded = (counts + MOE_BLOCK - 1) // MOE_BLOCK * MOE_BLOCK
    starts = jnp.cumsum(counts) - counts
    pends = jnp.cumsum(padded)
    pstarts = pends - padded
    dest = pstarts[e_sorted] + (jnp.arange(n_asg, dtype=jnp.int32) - starts[e_sorted])
    n_slots = (-(-n_asg // MOE_BLOCK) + N_EXPERTS) * MOE_BLOCK
    n_blocks = n_slots // MOE_BLOCK
    slot_tok = jnp.zeros((n_slots,), jnp.int32).at[dest].set(tok_flat[order])
    slot_gate = jnp.zeros((n_slots,), jnp.float32).at[dest].set(gate_flat[order])
    block_start = jnp.arange(n_blocks, dtype=jnp.int32) * MOE_BLOCK
    block_exp = jnp.minimum(jnp.searchsorted(pends, block_start, side='right'), N_EXPERTS - 1)
    xs = ht[slot_tok].reshape(n_blocks, MOE_BLOCK, d)

    def expert_block(args):
        xb, e = args
        a = jax.nn.silu(xb @ w_gate[e]) * (xb @ w_up[e])
        return a @ w_down[e]

    ys = lax.map(expert_block, (xs, block_exp)).reshape(n_slots, d)
    out = jnp.zeros((n_tok, d), jnp.float32).at[slot_tok].add(ys.astype(jnp.float32) * slot_gate[:, None])
    return out.astype(h.dtype).reshape(b, s, d)


def setup_inputs(seed: int = 0) -> dict:
    key = jax.random.key(seed)
    ks = jax.random.split(key, 20)
    f32 = jnp.float32
    nrm = lambda k, shape, sc: jax.random.normal(k, shape, f32) * sc
    return {
        "x": nrm(ks[0], (BATCH, SEQ, D_MODEL), 1.0),
        "c": nrm(ks[1], (BATCH, D_MODEL), 1.0),
        "w_ada": nrm(ks[2], (DEPTH, D_MODEL, 6 * D_MODEL), 0.5 * D_MODEL ** -0.5),
        "b_ada": nrm(ks[3], (DEPTH, 6 * D_MODEL), 0.02),
        "g_mix": 1.0 + nrm(ks[4], (DEPTH, D_MODEL), 0.05),
        "w_in": nrm(ks[5], (DEPTH, D_MODEL, P_IN), D_MODEL ** -0.5),
        "w_pool": nrm(ks[6], (DEPTH, N_POOL_GROUPS, POOL_GROUP_WIDTH, POOL_GROUP_WIDTH), POOL_GROUP_WIDTH ** -0.5),
        "pool_scale": 1.0 + nrm(ks[7], (DEPTH, POOL_WIDTH), 0.1),
        "rel_bias": nrm(ks[8], (N_BUCKETS, N_HEADS), 0.5),
        "w_out": nrm(ks[9], (DEPTH, D_MIX, D_MODEL), D_MIX ** -0.5),
        "g_ffn": 1.0 + nrm(ks[10], (DEPTH, D_MODEL), 0.05),
        "w_group": nrm(ks[11], (DEPTH, D_MODEL, N_GROUPS), D_MODEL ** -0.5),
        "b_group": nrm(ks[12], (DEPTH, N_GROUPS), 0.01),
        "w_router": nrm(ks[13], (DEPTH, D_MODEL, N_EXPERTS), D_MODEL ** -0.5),
        "b_router": nrm(ks[14], (DEPTH, N_EXPERTS), 0.01),
        "w_gate": nrm(ks[15], (DEPTH, N_EXPERTS, D_MODEL, D_EXPERT), D_MODEL ** -0.5),
        "w_up": nrm(ks[16], (DEPTH, N_EXPERTS, D_MODEL, D_EXPERT), D_MODEL ** -0.5),
        "w_down": nrm(ks[17], (DEPTH, N_EXPERTS, D_EXPERT, D_MODEL), D_EXPERT ** -0.5),
        "g_final": 1.0 + nrm(ks[18], (D_MODEL,), 0.05),
    }


def reference(x, c, w_ada, b_ada, g_mix, w_in, w_pool, pool_scale, rel_bias, w_out,
              g_ffn, w_group, b_group, w_router, b_router, w_gate, w_up, w_down, g_final):
    b, s, _ = x.shape
    sizes = [POOL_WIDTH, N_HEADS * HEAD_DIM, N_KV_HEADS * HEAD_DIM, N_KV_HEADS * HEAD_DIM,
             IDX_HEADS * IDX_DIM, IDX_DIM]
    cuts = [int(v) for v in np.cumsum(sizes)]
    for i in range(DEPTH):
        mod = jax.nn.silu(c) @ w_ada[i] + b_ada[i]
        sh1, sc1, gt1, sh2, sc2, gt2 = jnp.split(mod, 6, axis=-1)
        h = modulate(rmsnorm(x, g_mix[i]), sh1, sc1)
        proj = h @ w_in[i]
        u, q, k, v, qi, ki, wi = jnp.split(proj, cuts, axis=-1)
        pool_out = pool_mixer(u, w_pool[i], pool_scale[i])
        attn_out = dsa_mixer(q.reshape(b, s, N_HEADS, HEAD_DIM),
                             k.reshape(b, s, N_KV_HEADS, HEAD_DIM),
                             v.reshape(b, s, N_KV_HEADS, HEAD_DIM),
                             qi.reshape(b, s, IDX_HEADS, IDX_DIM), ki, wi, rel_bias)
        mixed = jnp.concatenate([pool_out, attn_out], axis=-1) @ w_out[i]
        x = x + gt1[:, None, :] * mixed
        h2 = modulate(rmsnorm(x, g_ffn[i]), sh2, sc2)
        x = x + gt2[:, None, :] * hier_moe(h2, w_group[i], b_group[i], w_router[i], b_router[i],
                                           w_gate[i], w_up[i], w_down[i])
    return rmsnorm(x, g_final)
```

```cpp
#include <hip/hip_runtime.h>
#include <cstdio>
#include <cstdint>

#ifndef MK_N_LAUNCHES
#define MK_N_LAUNCHES 1
#endif

#ifndef P8_ALIGN
#define P8_ALIGN true
#endif
#ifndef PROBE_DUP
#define PROBE_DUP -1
#endif
#define GAS __attribute__((address_space(1)))
#define LAS __attribute__((address_space(3)))
typedef unsigned short bf16;
typedef short bf16x8 __attribute__((ext_vector_type(8)));
typedef short s16x4 __attribute__((ext_vector_type(4)));
typedef float f32x4 __attribute__((ext_vector_type(4)));
typedef float f32x2 __attribute__((ext_vector_type(2)));
typedef float f32x16 __attribute__((ext_vector_type(16)));
typedef unsigned u32x4 __attribute__((ext_vector_type(4)));
typedef unsigned u32x2 __attribute__((ext_vector_type(2)));

constexpr int DM = 2048, NB = 8, SEQ = 2048, NTOK = NB * SEQ;
constexpr int POOLW = 1024, NHEAD = 8, HD = 128, NKV = 2, IDXH = 16, IDXD = 64, TOPK = 256;
constexpr int PIN = 3664, PLD = 3840;
constexpr int C_U = 0, C_Q = 1024, C_K = 2048, C_V = 2304, C_QI = 2560, C_KI = 3584, C_WI = 3648;
constexpr int NEXP = 32, DEXP = 512, NGRP = 4, EPG = 8;
constexpr int MAXSLOT = 40960;
constexpr float EPS = 1e-6f;

constexpr size_t MiB = 1u << 20;
constexpr size_t WS_CTL = 0, CTL_ZERO_BYTES = 1 * MiB;
constexpr size_t WS_MOD = 1 * MiB;
constexpr size_t WS_RW = 1 * MiB + 512 * 1024;
constexpr size_t WS_TOKINFO = 2 * MiB;
constexpr size_t WS_TOKLIST = 3 * MiB;
constexpr size_t WS_WPT = 5 * MiB;
constexpr size_t WS_MASK = 6 * MiB;
constexpr size_t WS_WINP = 10 * MiB;
constexpr size_t WS_WIN = 16 * MiB;
constexpr size_t WS_WOUT = 32 * MiB;
constexpr size_t WS_WGU = 40 * MiB;
constexpr size_t WS_WD = 168 * MiB;
constexpr size_t WS_H = 232 * MiB;
constexpr size_t WS_P = 296 * MiB;
constexpr size_t WS_CAT = 416 * MiB;
constexpr size_t WS_Y = 296 * MiB;
constexpr size_t WS_A = 480 * MiB;
constexpr size_t WS_X1 = 520 * MiB;
constexpr size_t WS_END = 584 * MiB;
static_assert(WS_Y + (size_t)MAXSLOT * DM * 2 <= WS_A && WS_P + (size_t)NTOK * PLD * 2 <= WS_CAT && WS_A + (size_t)MAXSLOT * DEXP * 2 <= WS_X1 && WS_X1 + (size_t)NTOK * DM * 2 <= WS_END, "ws map");
constexpr int CW_TMO = 0, CW_Q0 = 64, CW_BAR = 4096, CW_ECNT = 16384;

constexpr int RING_BYTES = 131072;
constexpr int MISC_OFF = RING_BYTES;
constexpr int LDS_BYTES = 147456;
constexpr int NWAVES = 8, NTHR = 512;

#define LDS_WAIT() asm volatile("s_waitcnt lgkmcnt(0)" ::: "memory")
#define VM_WAIT() asm volatile("s_waitcnt vmcnt(0)" ::: "memory")
__device__ __forceinline__ unsigned cvt_pk_bf16(float lo, float hi) { unsigned r; asm volatile("v_cvt_pk_bf16_f32 %0, %1, %2" : "=v"(r) : "v"(lo), "v"(hi)); return r; }
__device__ __forceinline__ float bf2f(bf16 v) { return __builtin_bit_cast(float, (unsigned)v << 16); }
__device__ __forceinline__ float wave_sum(float v) {
#pragma unroll
    for (int o = 1; o < 64; o <<= 1) v += __shfl_xor(v, o);
    return v;
}

__device__ __forceinline__ int lane_now() { int l; asm volatile("v_mbcnt_lo_u32_b32 %0, -1, 0\n\tv_mbcnt_hi_u32_b32 %0, -1, %0" : "=v"(l)); return l; }
namespace pg8 {
constexpr int BM = 256, BK = 64, HALF = 128, HTB = HALF * BK * 2, STAGE_BYTES = 8 * HTB, NXCD = 8, WGM = 4;
__host__ __device__ __forceinline__ int lds_byte(int r, int c) { const int st = (r >> 4) * 2 + (c >> 5), rr = r & 15, cc = c & 31, ob = rr * 64 + cc * 2; return st * 1024 + (ob ^ (((ob >> 9) & 1) << 5)); }
__host__ __device__ __forceinline__ void stage_rc(int b, int& R, int& C) { const int st = b / 1024, sb = b % 1024, swz = sb ^ (((sb >> 9) & 1) << 5); R = (st >> 1) * 16 + swz / 64; C = (st & 1) * 32 + (swz % 64) / 2; }
__host__ __device__ __forceinline__ int perm32(int rho) { const int n = rho >> 4, i = rho & 15; return 8 * (i >> 2) + 4 * n + (i & 3); }

typedef int v4i_t __attribute__((ext_vector_type(4)));
typedef int v8i_t __attribute__((ext_vector_type(8)));
struct Unit { int pm, pn, e, ord, half; };
struct Gemm { const bf16* A; const bf16* Bt; int K, lda, ldb; const LAS unsigned* rowtab; };

struct StaticOrder {
    int nM, nN, nwg, G, c, reps;
    __device__ void init(int M, int N, int G_, int c_) { nM = M / BM; nN = N / BM; nwg = nM * nN; G = G_; c = c_; reps = 1; }
    __device__ bool next(int i, Unit& u) const {
        const long L = (long)i * G + c; if (L >= (long)nwg * reps) return false;
        int wgid = (int)(L % nwg); { const int q = nwg / NXCD, r = nwg % NXCD, xcd = wgid % NXCD, off = wgid / NXCD; wgid = (xcd < r ? xcd * (q + 1) : r * (q + 1) + (xcd - r) * q) + off; }
        const int nig = WGM * nN, gid = wgid / nig, fm = gid * WGM, gsz = (nM - fm) < WGM ? (nM - fm) : WGM;
        u.pm = fm + ((wgid % nig) % gsz); u.pn = (wgid % nig) / gsz; u.e = 0; u.ord = i; u.half = 0; return true;
    }
    __device__ __forceinline__ size_t b_off(const Unit& u, int ldb) const { return (size_t)u.pn * BM * ldb * 2; }
};
struct FoldOrder {
    int G, c;
    __device__ bool next(int i, Unit& u) const { const int L = i * G + c; if (L >= 32) return false; u.pm = L >> 3; u.pn = L & 7; u.e = 0; u.ord = i; u.half = 0; return true; }
    __device__ __forceinline__ size_t b_off(const Unit& u, int ldb) const { return ((size_t)u.pn * BM * ldb + (size_t)u.pm * 256) * 2; }
};
struct MoeTabs { const LAS int* tb; const LAS int* tf; const LAS int* hl; };
__device__ __forceinline__ bool moe_unit(const MoeTabs& T, int NT, int L, int reps, int& pm, int& pn, int& e, int& half) {
    const int nf = T.tf[NEXP], nh = T.hl[NEXP], total = (nf + nh) * NT;
    if (L >= total * reps) return false;
    L %= total;
    const int mt = L / NT; pn = L - mt * NT;
    if (mt < nf) { int x = 0; while (x < NEXP - 1 && T.tf[x + 1] <= mt) ++x; e = x; pm = T.tb[x] + (mt - T.tf[x]); half = 0; }
    else { e = T.hl[mt - nf]; pm = T.tb[e + 1] - 1; half = 1; }
    return true;
}
struct GroupedOrder {
    MoeTabs T; int NT, G, c, rows_per_e, reps;
    __device__ bool next(int i, Unit& u) const { u.ord = i; return moe_unit(T, NT, i * G + c, reps, u.pm, u.pn, u.e, u.half); }
    __device__ __forceinline__ size_t b_off(const Unit& u, int ldb) const { return ((size_t)u.e * rows_per_e + (size_t)u.pn * BM) * ldb * 2; }
};

template <class Epi, class Sched, bool GATHER, bool ALIGN_EPI, bool FP8 = false>
__device__ __forceinline__ void gemm_phase(LAS unsigned char* lds, const Gemm g, const Sched& S, const Epi& E, const int wid) {
    const int lane = lane_now(), tid = wid * 64 + lane, wr = wid >> 2, wc = wid & 3, fr = lane & 15, fq = lane >> 4;
    const int K = g.K, nt = K / BK;
    int Rr[2], Cc[2];
    unsigned voffB[2];
    unsigned cva[2][2], nva[2][2];
#pragma unroll
    for (int i = 0; i < 2; ++i) { int R, C; stage_rc(tid * 16 + i * 8192, R, C); Rr[i] = R; Cc[i] = C; const int Rb = Epi::PERM ? ((R & ~31) + perm32(R & 31)) : R;
        voffB[i] = (unsigned)(Rb * g.ldb + C) * 2u; }
    const size_t kstep = (size_t)(BK * 2);
    const unsigned hstepA = (unsigned)HALF * g.lda * 2u;
    const size_t hstepB = (size_t)HALF * g.ldb * 2;
    const unsigned ldsw = (unsigned)wid * 1024u;
    const int aoff = lds_byte(wr * 64 + fr, fq * 8), boff = lds_byte(wc * 32 + fr, fq * 8);
#define PG8_SA(b, h) (((b) * 2 + (h)) * HTB)
#define PG8_SB(b, h) ((4 + (b) * 2 + (h)) * HTB)
#define PG8_STAGE(bufoff, gbase, v0, v1) do { \
        __builtin_amdgcn_global_load_lds((const unsigned*)((const char*)(gbase) + (v0)), (LAS unsigned*)(lds + (bufoff) + ldsw), 16, 0, 0); \
        __builtin_amdgcn_global_load_lds((const unsigned*)((const char*)(gbase) + (v1)), (LAS unsigned*)(lds + (bufoff) + ldsw + 8192), 16, 0, 0); } while (0)
#define PG8_STAGE_B(bufoff, gbase) PG8_STAGE(bufoff, gbase, voffB[0], voffB[1])
#define PG8_LD8(base) __builtin_shufflevector(*(const LAS v4i_t*)(base), *(const LAS v4i_t*)((base) + 1024), 0, 1, 2, 3, 4, 5, 6, 7)
#define PG8_LDA(dst, b, h) do { _Pragma("unroll") for (int m = 0; m < 4; ++m) dst[m] = PG8_LD8(lds + PG8_SA(b, h) + aoff + m * 2048); } while (0)
#define PG8_LDB(dst, b, h) do { _Pragma("unroll") for (int n = 0; n < 2; ++n) dst[n] = PG8_LD8(lds + PG8_SB(b, h) + boff + n * 2048); } while (0)
#define PG8_LO(x) __builtin_bit_cast(bf16x8, __builtin_shufflevector((x), (x), 0, 1, 2, 3))
#define PG8_HI(x) __builtin_bit_cast(bf16x8, __builtin_shufflevector((x), (x), 4, 5, 6, 7))
#define PG8_MMA(ai, bj, At, Bt) do { __builtin_amdgcn_s_setprio(1); _Pragma("unroll") for (int m = 0; m < 4; ++m) _Pragma("unroll") for (int n = 0; n < 2; ++n) { \
        if constexpr (FP8) asm volatile("v_mfma_scale_f32_16x16x128_f8f6f4 %0, %1, %2, %0, %3, %3 op_sel_hi:[0,0,0]" : "+v"(acc[ai][bj][m][n]) : "v"(Bt[n]), "v"(At[m]), "v"(sc8));   \
        else { acc[ai][bj][m][n] = __builtin_amdgcn_mfma_f32_16x16x32_bf16(PG8_LO(Bt[n]), PG8_LO(At[m]), acc[ai][bj][m][n], 0, 0, 0); \
               acc[ai][bj][m][n] = __builtin_amdgcn_mfma_f32_16x16x32_bf16(PG8_HI(Bt[n]), PG8_HI(At[m]), acc[ai][bj][m][n], 0, 0, 0); } } \
        __builtin_amdgcn_s_setprio(0); } while (0)
#define PG8_WAIT_V(n) asm volatile("s_waitcnt vmcnt(" #n ")" ::: "memory")
#define PG8_WAIT_L(n) asm volatile("s_waitcnt lgkmcnt(" #n ")" ::: "memory")
#define PG8_BAR __builtin_amdgcn_s_barrier()
#define PG8_SCHED __builtin_amdgcn_sched_barrier(0)
#define PG8_AOFF(dst, u) do { _Pragma("unroll") for (int h_ = 0; h_ < 2; ++h_) _Pragma("unroll") for (int i_ = 0; i_ < 2; ++i_) { \
        if constexpr (GATHER) dst[h_][i_] = g.rowtab[(u).ord * 256 + h_ * HALF + Rr[i_]] + (unsigned)Cc[i_] * 2u; \
        else dst[h_][i_] = (unsigned)(Rr[i_] * g.lda + Cc[i_]) * 2u + (unsigned)h_ * hstepA; } } while (0)
    Unit cur, nxt; int ui = 0;
    if (!S.next(0, cur)) return;
    const int sc8 = 0x7f7f7f7f;
    f32x4 acc[2][2][4][2];
#pragma unroll
    for (int a = 0; a < 2; ++a)
#pragma unroll
        for (int b = 0; b < 2; ++b)
#pragma unroll
            for (int m = 0; m < 4; ++m)
#pragma unroll
                for (int n = 0; n < 2; ++n) acc[a][b][m][n] = (f32x4){0.f, 0.f, 0.f, 0.f};
    v8i_t At[4], B0[2], B1[2];
    const size_t tstepA = (size_t)BM * g.lda * 2;
    const char* cA = GATHER ? (const char*)g.A : (const char*)g.A + (size_t)cur.pm * tstepA;
    const char* cB = (const char*)g.Bt + S.b_off(cur, g.ldb);
    PG8_AOFF(cva, cur);
#pragma unroll
    for (int h_ = 0; h_ < 2; ++h_)
#pragma unroll
        for (int i_ = 0; i_ < 2; ++i_) nva[h_][i_] = cva[h_][i_];
    if constexpr (GATHER) { LDS_WAIT(); }
    PG8_STAGE_B(PG8_SB(0, 0), cB); PG8_STAGE_B(PG8_SB(0, 1), cB + hstepB); PG8_STAGE(PG8_SA(0, 0), cA, cva[0][0], cva[0][1]); PG8_STAGE(PG8_SA(0, 1), cA, cva[1][0], cva[1][1]);
    if (wr == 1) PG8_BAR;
    PG8_WAIT_V(2); PG8_BAR;
    PG8_STAGE_B(PG8_SB(1, 0), cB + kstep); PG8_STAGE(PG8_SA(1, 0), cA + kstep, cva[0][0], cva[0][1]); PG8_STAGE_B(PG8_SB(1, 1), cB + hstepB + kstep);
    PG8_WAIT_V(6); PG8_BAR;
    for (;;) {
        const bool has_next = S.next(ui + 1, nxt);
        const bool full = (cur.half == 0);
        const char* nA = GATHER ? cA : (has_next ? (const char*)g.A + (size_t)nxt.pm * tstepA : cA);
        const char* nB = has_next ? (const char*)g.Bt + S.b_off(nxt, g.ldb) : cB;
#pragma nounroll
        for (int t = 0; t < nt; t += 2) {
            const bool last = (t == nt - 2);
            const char* a1 = cA + (size_t)(t + 1) * kstep;
            const char* a2 = last ? nA : cA + (size_t)(t + 2) * kstep; const char* b2 = last ? nB : cB + (size_t)(t + 2) * kstep;
            const char* a3 = a2 + kstep; const char* b3 = b2 + kstep;
            if (last) { if (has_next) { PG8_AOFF(nva, nxt); } else {
#pragma unroll
                for (int h_ = 0; h_ < 2; ++h_)
#pragma unroll
                    for (int i_ = 0; i_ < 2; ++i_) nva[h_][i_] = cva[h_][i_]; }
                if constexpr (GATHER) { LDS_WAIT(); } }
            unsigned v2[2][2];
#pragma unroll
            for (int h_ = 0; h_ < 2; ++h_)
#pragma unroll
                for (int i_ = 0; i_ < 2; ++i_) v2[h_][i_] = last ? nva[h_][i_] : cva[h_][i_];
            PG8_LDB(B0, 0, 0); PG8_LDB(B1, 0, 1); PG8_SCHED; PG8_LDA(At, 0, 0); PG8_STAGE(PG8_SA(1, 1), a1, cva[1][0], cva[1][1]);
            PG8_WAIT_V(8); PG8_WAIT_L(0); PG8_BAR; PG8_MMA(0, 0, At, B0); PG8_MMA(0, 1, At, B1); PG8_BAR; PG8_SCHED;
            PG8_LDA(At, 0, 1); PG8_STAGE_B(PG8_SB(0, 0), b2); PG8_STAGE_B(PG8_SB(0, 1), b2 + hstepB); PG8_STAGE(PG8_SA(0, 0), a2, v2[0][0], v2[0][1]);
            PG8_WAIT_V(8); PG8_WAIT_L(0); PG8_BAR; if (full) { PG8_MMA(1, 0, At, B0); PG8_MMA(1, 1, At, B1); } PG8_BAR; PG8_SCHED;
            PG8_LDB(B0, 1, 0); PG8_LDB(B1, 1, 1); PG8_SCHED; PG8_LDA(At, 1, 0); PG8_STAGE(PG8_SA(0, 1), a2, v2[1][0], v2[1][1]);
            PG8_WAIT_V(8); PG8_WAIT_L(0); PG8_BAR; PG8_MMA(0, 0, At, B0); PG8_MMA(0, 1, At, B1); PG8_BAR; PG8_SCHED;
            PG8_LDA(At, 1, 1); PG8_STAGE_B(PG8_SB(1, 0), b3); PG8_STAGE_B(PG8_SB(1, 1), b3 + hstepB); PG8_STAGE(PG8_SA(1, 0), a3, v2[0][0], v2[0][1]);
            PG8_WAIT_V(8); PG8_WAIT_L(0); PG8_BAR; if (full) { PG8_MMA(1, 0, At, B0); PG8_MMA(1, 1, At, B1); } PG8_BAR; PG8_SCHED;
        }
        if constexpr (FP8) asm volatile("s_nop 15\n\ts_nop 15" ::: "memory");
        if constexpr (ALIGN_EPI) { if (wr == 0) PG8_BAR; }
        E(acc, cur, wr, wc, fr, fq);
        if (!has_next) break;
#pragma unroll
        for (int a = 0; a < 2; ++a)
#pragma unroll
            for (int b = 0; b < 2; ++b)
#pragma unroll
                for (int m = 0; m < 4; ++m)
#pragma unroll
                    for (int n = 0; n < 2; ++n) acc[a][b][m][n] = (f32x4){0.f, 0.f, 0.f, 0.f};
        cur = nxt; cA = nA; cB = nB; ++ui;
#pragma unroll
        for (int h_ = 0; h_ < 2; ++h_)
#pragma unroll
            for (int i_ = 0; i_ < 2; ++i_) cva[h_][i_] = nva[h_][i_];
        if constexpr (ALIGN_EPI) { if (wr == 1) PG8_BAR; }
    }
    PG8_WAIT_V(0);
    if constexpr (!ALIGN_EPI) { if (wr == 0) PG8_BAR; }
    PG8_BAR;
#undef PG8_SA
#undef PG8_SB
#undef PG8_STAGE
#undef PG8_STAGE_B
#undef PG8_LDA
#undef PG8_LDB
#undef PG8_MMA
#undef PG8_LD8
#undef PG8_LO
#undef PG8_HI
#undef PG8_WAIT_V
#undef PG8_WAIT_L
#undef PG8_BAR
#undef PG8_SCHED
#undef PG8_AOFF
}

struct EpiBf16 {
    static constexpr bool PERM = true;
    bf16* O; int ldc; const float* rowscale; float oscale;
    __device__ __forceinline__ void operator()(const f32x4 (&acc)[2][2][4][2], const Unit& u, int wr, int wc, int fr, int fq) const {
        const int row0 = u.pm * BM + wr * 64 + fr, col0 = u.pn * BM + wc * 32 + 8 * fq;
#pragma unroll
        for (int ai = 0; ai < 2; ++ai)
#pragma unroll
            for (int m = 0; m < 4; ++m) { const int row = row0 + ai * HALF + m * 16; bf16* rowp = O + (size_t)row * ldc + col0; const float s = rowscale ? rowscale[row] * oscale : oscale;
#pragma unroll
                for (int bj = 0; bj < 2; ++bj) { const f32x4 v0 = acc[ai][bj][m][0] * s, v1 = acc[ai][bj][m][1] * s;
                    u32x4 w; w.x = cvt_pk_bf16(v0[0], v0[1]); w.y = cvt_pk_bf16(v0[2], v0[3]); w.z = cvt_pk_bf16(v1[0], v1[1]); w.w = cvt_pk_bf16(v1[2], v1[3]);
                    *(u32x4*)(rowp + bj * HALF) = w; } }
    }
};
struct EpiFp8 {
    static constexpr bool PERM = true;
    unsigned char* O; int ldc; float oscale;
    __device__ __forceinline__ void operator()(const f32x4 (&acc)[2][2][4][2], const Unit& u, int wr, int wc, int fr, int fq) const {
        const int row0 = u.pm * BM + wr * 64 + fr, col0 = u.pn * BM + wc * 32 + 8 * fq;
#pragma unroll
        for (int ai = 0; ai < 2; ++ai)
#pragma unroll
            for (int m = 0; m < 4; ++m) { unsigned char* rowp = O + (size_t)(row0 + ai * HALF + m * 16) * ldc + col0;
#pragma unroll
                for (int bj = 0; bj < 2; ++bj) { const f32x4 v0 = acc[ai][bj][m][0] * oscale, v1 = acc[ai][bj][m][1] * oscale; u32x2 w;
                    { int p = __builtin_amdgcn_cvt_pk_fp8_f32(v0[0], v0[1], 0, false); p = __builtin_amdgcn_cvt_pk_fp8_f32(v0[2], v0[3], p, true); w.x = (unsigned)p; }
                    { int p = __builtin_amdgcn_cvt_pk_fp8_f32(v1[0], v1[1], 0, false); p = __builtin_amdgcn_cvt_pk_fp8_f32(v1[2], v1[3], p, true); w.y = (unsigned)p; }
                    *(u32x2*)(rowp + bj * HALF) = w; } }
    }
};
struct EpiResid {
    static constexpr bool PERM = true;
    const float* X; bf16* X1; const float* gate;
    __device__ __forceinline__ void operator()(const f32x4 (&acc)[2][2][4][2], const Unit& u, int wr, int wc, int fr, int fq) const {
        const int row0 = u.pm * BM + wr * 64 + fr, col0 = u.pn * BM + wc * 32 + 8 * fq;
        const float* gp = gate + (size_t)((u.pm * BM) / SEQ) * (6 * DM) + col0;
        f32x4 gv[2][2];
#pragma unroll
        for (int bj = 0; bj < 2; ++bj)
#pragma unroll
            for (int n = 0; n < 2; ++n) gv[bj][n] = *(const f32x4*)(gp + bj * HALF + n * 4);
#pragma unroll
        for (int ai = 0; ai < 2; ++ai) {
            f32x4 xv[4][2][2];
#pragma unroll
            for (int m = 0; m < 4; ++m) { const size_t ro = (size_t)(row0 + ai * HALF + m * 16) * DM + col0;
#pragma unroll
                for (int bj = 0; bj < 2; ++bj) { xv[m][bj][0] = *(const f32x4*)(X + ro + bj * HALF); xv[m][bj][1] = *(const f32x4*)(X + ro + bj * HALF + 4); } }
#pragma unroll
            for (int m = 0; m < 4; ++m) { const size_t ro = (size_t)(row0 + ai * HALF + m * 16) * DM + col0;
#pragma unroll
                for (int bj = 0; bj < 2; ++bj) {
                    const f32x4 v0 = xv[m][bj][0] + gv[bj][0] * acc[ai][bj][m][0], v1 = xv[m][bj][1] + gv[bj][1] * acc[ai][bj][m][1];
                    u32x4 w; w.x = cvt_pk_bf16(v0[0], v0[1]); w.y = cvt_pk_bf16(v0[2], v0[3]); w.z = cvt_pk_bf16(v1[0], v1[1]); w.w = cvt_pk_bf16(v1[2], v1[3]);
                    *(u32x4*)(X1 + ro + bj * HALF) = w; } }
        }
    }
};
struct EpiGateUp {
    static constexpr bool PERM = true;
    unsigned char* O; float isc;
    __device__ __forceinline__ void operator()(const f32x4 (&acc)[2][2][4][2], const Unit& u, int wr, int wc, int fr, int fq) const {
        const int row0 = u.pm * BM + wr * 64 + fr, col0 = u.pn * HALF + wc * 32 + 8 * fq;
#pragma unroll
        for (int ai = 0; ai < 2; ++ai)
#pragma unroll
            for (int m = 0; m < 4; ++m) { unsigned char* rowp = O + (size_t)(row0 + ai * HALF + m * 16) * DEXP + col0; float r[8];
#pragma unroll
                for (int n = 0; n < 2; ++n)
#pragma unroll
                    for (int j = 0; j < 4; ++j) { const float gt = acc[ai][0][m][n][j] * isc, up = acc[ai][1][m][n][j] * isc;
                        r[n * 4 + j] = gt * __builtin_amdgcn_rcpf(1.f + __builtin_amdgcn_exp2f(-1.4426950408889634f * gt)) * up; }
                u32x2 w; { int p = __builtin_amdgcn_cvt_pk_fp8_f32(r[0], r[1], 0, false); p = __builtin_amdgcn_cvt_pk_fp8_f32(r[2], r[3], p, true); w.x = (unsigned)p; }
                { int p = __builtin_amdgcn_cvt_pk_fp8_f32(r[4], r[5], 0, false); p = __builtin_amdgcn_cvt_pk_fp8_f32(r[6], r[7], p, true); w.y = (unsigned)p; }
                *(u32x2*)rowp = w; }
    }
};
}

constexpr int MISC_BASE = 139264;
constexpr int LDS_TOTAL = 159744;
constexpr int MO_BARW = 0;
constexpr int MO_TB = 256;
constexpr int MO_CNT = 768;
constexpr int MO_ROWTAB = 1024;
constexpr int MO_BIAS = 10240;
constexpr int MAXU = 8;
static_assert(MISC_BASE + MO_BIAS + 304 * 4 <= LDS_TOTAL, "lds map");

#define XB_TMO      128
#define XB_XCNT(j)  (256  + 64 * (j))
#define XB_XSUB(j)  (1280 + 64 * (j))
#define XB_XGEN(j)  (2304 + 64 * (j))
#define XB_TOP      3328
#define XB_TOPGEN   3392
#define XCD_BAR_WORDS 3456
#define XB_SPIN_CAP (1u << 18)
__device__ __forceinline__ unsigned xb_ld(unsigned* p)              { return __hip_atomic_load(p, __ATOMIC_RELAXED, __HIP_MEMORY_SCOPE_AGENT); }
__device__ __forceinline__ unsigned xb_add(unsigned* p, unsigned v) { return __hip_atomic_fetch_add(p, v, __ATOMIC_RELAXED, __HIP_MEMORY_SCOPE_AGENT); }
__device__ __forceinline__ unsigned xb_xcc_id() { return (unsigned)__builtin_amdgcn_s_getreg((3 << 11) | 20) & 0xFu; }
#define XB_SPIN(cond, bar) do { unsigned _sp = 0; while (cond) { __builtin_amdgcn_s_sleep(1); \
    if ((++_sp & 255u) == 0u) { if (xb_ld(&(bar)[XB_TMO])) break; if (_sp > XB_SPIN_CAP) { atomicAdd(&(bar)[XB_TMO], 1u); break; } } } } while (0)
struct XcdBarrier { unsigned* bar; unsigned x; volatile LAS unsigned* st; int wave; };
__device__ __forceinline__ XcdBarrier xcd_barrier_post(unsigned* bar, volatile LAS unsigned* st, int wave) {
    XcdBarrier b; b.bar = bar; b.x = xb_xcc_id(); b.st = st; b.wave = wave;
    if (wave == 0 && lane_now() == 0) (void)xb_add(&bar[XB_XCNT(b.x)], 1u);
    return b;
}
__device__ __forceinline__ void xcd_barrier_complete(unsigned* bar, unsigned x, unsigned& nloc, unsigned& nx) {
    const unsigned G = gridDim.x * gridDim.y * gridDim.z;
    unsigned sum, cnt, mine, sp = 0u;
    for (;;) {
        sum = 0u; cnt = 0u; mine = 0u;
#pragma unroll
        for (unsigned j = 0; j < 16; ++j) { const unsigned c = xb_ld(&bar[XB_XCNT(j)]); sum += c; cnt += (c > 0u) ? 1u : 0u; mine = (j == x) ? c : mine; }
        if (sum == G) break;
        __builtin_amdgcn_s_sleep(1);
        if ((++sp & 255u) == 0u) { if (xb_ld(&bar[XB_TMO])) break; if (sp > XB_SPIN_CAP) { atomicAdd(&bar[XB_TMO], 1u); break; } }
    }
    nloc = mine > 0u ? mine : 1u; nx = cnt > 0u ? cnt : 1u;
}
__device__ __forceinline__ void xcd_barrier(const XcdBarrier& b) {
    asm volatile("s_waitcnt vmcnt(0)" ::: "memory");
    __syncthreads();
    if (b.wave == 0 && lane_now() == 0) {
        unsigned* bar = b.bar;
        __builtin_amdgcn_s_waitcnt(0);
        unsigned nloc = b.st[0], nx = b.st[1];
        if (nloc == 0u) { xcd_barrier_complete(bar, b.x, nloc, nx); b.st[0] = nloc; b.st[1] = nx; }
        const unsigned old = xb_add(&bar[XB_XSUB(b.x)], 1u);
        const unsigned gen = old / nloc;
        if (old + 1u == (gen + 1u) * nloc) {
            __builtin_amdgcn_fence(__ATOMIC_RELEASE, "agent");
            asm volatile("s_waitcnt vmcnt(0)" ::: "memory");
            const unsigned og = xb_add(&bar[XB_TOP], 1u);
            const unsigned tg = og / nx;
            if (og + 1u == (tg + 1u) * nx) xb_add(&bar[XB_TOPGEN], 1u);
            else XB_SPIN(xb_ld(&bar[XB_TOPGEN]) == tg, bar);
            __builtin_amdgcn_fence(__ATOMIC_ACQUIRE, "agent");
            xb_add(&bar[XB_XGEN(b.x)], 1u);
            asm volatile("s_waitcnt vmcnt(0)" ::: "memory");
        } else {
            XB_SPIN(xb_ld(&bar[XB_XGEN(b.x)]) == gen, bar);
            __builtin_amdgcn_fence(__ATOMIC_ACQUIRE, "agent");
            asm volatile("s_waitcnt vmcnt(0)" ::: "memory");
        }
    }
    __syncthreads();
}

struct Frame {
    LAS unsigned char* lds;
    unsigned* ctl;
    int tid, lane, wave, G, bid, vcu;
    const float *x, *c, *w_ada, *b_ada, *g_mix, *w_in, *w_pool, *pool_scale, *rel_bias, *w_out, *g_ffn, *w_group, *b_group, *w_router, *b_router, *w_gate, *w_up, *w_down, *g_final;
    float* out; float* mod;
    bf16 *RW, *WpT, *WinP, *Win, *Wout, *Wgu, *Wd, *H, *P, *CAT, *Y, *A, *X1;
    unsigned* MASK; int* TOKLIST; unsigned* TOKINFO;
};

constexpr float Y_SCALE = 8.f;
constexpr float WD_SCALE = 16.f;
constexpr float WGU_SCALE = 32.f;
__device__ __forceinline__ unsigned pk4_fp8(float a, float b, float c, float d) { int p = __builtin_amdgcn_cvt_pk_fp8_f32(a, b, 0, false); p = __builtin_amdgcn_cvt_pk_fp8_f32(c, d, p, true); return (unsigned)p; }
struct P0Tile { const float* src; unsigned char* dst; int ld_src, k0, n0, nvalid, ld_dst, himul, radd, fp8; float scale; };
constexpr int P0_R0 = 32 * 44, P0_R1 = 32 * 32, P0_R2 = 32 * 256, P0_R5 = 64, P0_R6 = 512, P0_R7 = 32;
constexpr int P0_TILES = P0_R0 + P0_R1 + 3 * P0_R2 + P0_R5;
constexpr int P0_ITEMS = P0_TILES + P0_R6 + P0_R7;
constexpr int P0_OFF_START = P0_R0 + P0_R1 + 2 * P0_R2 + 24 * 256, P0_OFF_LEN = 8 * 256;
__device__ __forceinline__ P0Tile p0_decode(Frame& F, int it) {
    P0Tile t; t.fp8 = 0; t.scale = 1.f; t.himul = 128; t.radd = 0;
    if (it < P0_R0) { const int kb = it / 44, nb = it % 44; t.src = F.w_in; t.ld_src = PIN; t.k0 = 64 * kb; t.n0 = 1024 + 64 * nb; t.nvalid = PIN; t.dst = (unsigned char*)F.Win; t.ld_dst = DM * 2; return t; } it -= P0_R0;
    if (it < P0_R1) { const int kb = it >> 5, nb = it & 31; t.src = F.w_out; t.ld_src = DM; t.k0 = 64 * kb; t.n0 = 64 * nb; t.nvalid = DM; t.dst = (unsigned char*)F.Wout; t.ld_dst = DM * 2; return t; } it -= P0_R1;
    if (it < 2 * P0_R2) { const int up = it >= P0_R2; if (up) it -= P0_R2; const int e = it >> 8, r = it & 255, kb = r >> 3, nb = r & 7;
        t.src = (up ? F.w_up : F.w_gate) + (size_t)e * DM * DEXP; t.ld_src = DEXP; t.k0 = 64 * kb; t.n0 = 64 * nb; t.nvalid = DEXP; t.dst = (unsigned char*)F.Wgu + (size_t)e * 1024 * DM; t.ld_dst = DM;
        t.himul = 256; t.radd = up ? 128 : 0; t.fp8 = 1; t.scale = WGU_SCALE; return t; } it -= 2 * P0_R2;
    if (it < P0_R2) { const int e = it >> 8, r = it & 255, kb = r >> 5, nb = r & 31;
        t.src = F.w_down + (size_t)e * DEXP * DM; t.ld_src = DM; t.k0 = 64 * kb; t.n0 = 64 * nb; t.nvalid = DM; t.dst = (unsigned char*)F.Wd + (size_t)e * DM * DEXP; t.ld_dst = DEXP; t.fp8 = 1; t.scale = WD_SCALE; return t; } it -= P0_R2;
    { const int g = it >> 4, r = it & 15, kb = r >> 2, nb = r & 3; t.src = F.w_pool + (size_t)g * 65536; t.ld_src = 256; t.k0 = 64 * kb; t.n0 = 64 * nb; t.nvalid = 256; t.dst = (unsigned char*)(F.WpT + (size_t)g * 65536); t.ld_dst = 512; return t; }
}
__device__ __forceinline__ void p0_tile_load(const P0Tile& t, f32x4 (&v)[16], int lane) {
    const int nn = (lane & 15) * 4, kr = lane >> 4;
#pragma unroll
    for (int i = 0; i < 16; ++i) { v[i] = (f32x4){0.f, 0.f, 0.f, 0.f}; if (t.n0 + nn < t.nvalid) v[i] = *(const f32x4*)(t.src + (size_t)(t.k0 + 4 * i + kr) * t.ld_src + t.n0 + nn); }
}
__device__ __forceinline__ void p0_tile_park(const P0Tile& t, const f32x4 (&v)[16], LAS float* scr, int lane) {
    const int nn = (lane & 15) * 4, kr = lane >> 4;
#pragma unroll
    for (int i = 0; i < 16; ++i) { LAS float* s = scr + (4 * i + kr) * 65 + nn; s[0] = v[i][0] * t.scale; s[1] = v[i][1] * t.scale; s[2] = v[i][2] * t.scale; s[3] = v[i][3] * t.scale; }
    LDS_WAIT(); asm volatile("" ::: "memory");
}
__device__ __forceinline__ void p0_tile_store(const P0Tile& t, LAS float* scr, int lane) {
    if (t.fp8) {
        const int c = lane & 3;
#pragma unroll
        for (int j = 0; j < 4; ++j) { const int n = (lane >> 2) + 16 * j; const LAS float* s = scr + (16 * c) * 65 + n;
            u32x4 o; o.x = pk4_fp8(s[0 * 65], s[1 * 65], s[2 * 65], s[3 * 65]); o.y = pk4_fp8(s[4 * 65], s[5 * 65], s[6 * 65], s[7 * 65]);
            o.z = pk4_fp8(s[8 * 65], s[9 * 65], s[10 * 65], s[11 * 65]); o.w = pk4_fp8(s[12 * 65], s[13 * 65], s[14 * 65], s[15 * 65]);
            const int ng = t.n0 + n, row = (ng >> 7) * t.himul + (ng & 127) + t.radd;
            *(u32x4*)(t.dst + (size_t)row * t.ld_dst + t.k0 + 16 * c) = o; }
    } else {
        const int c = lane & 7;
#pragma unroll
        for (int j = 0; j < 8; ++j) { const int n = (lane >> 3) + 8 * j; const LAS float* s = scr + (8 * c) * 65 + n;
            u32x4 o; o.x = cvt_pk_bf16(s[0 * 65], s[1 * 65]); o.y = cvt_pk_bf16(s[2 * 65], s[3 * 65]); o.z = cvt_pk_bf16(s[4 * 65], s[5 * 65]); o.w = cvt_pk_bf16(s[6 * 65], s[7 * 65]);
            const int ng = t.n0 + n, row = (ng >> 7) * t.himul + (ng & 127) + t.radd;
            *(u32x4*)(t.dst + (size_t)row * t.ld_dst + (t.k0 + 8 * c) * 2) = o; }
    }
    LDS_WAIT(); asm volatile("" ::: "memory");
}
__device__ __forceinline__ void p0_small_item(Frame& F, int it) {
    const int lane = F.lane;
    if (it < P0_R6) {
        f32x4 v[4][4];
#pragma unroll
        for (int rr = 0; rr < 4; ++rr)
#pragma unroll
            for (int j = 0; j < 4; ++j) v[rr][j] = *(const f32x4*)(F.w_in + (size_t)(it * 4 + rr) * PIN + j * 256 + lane * 4);
#pragma unroll
        for (int rr = 0; rr < 4; ++rr)
#pragma unroll
            for (int j = 0; j < 4; ++j) { u32x2 o; o.x = cvt_pk_bf16(v[rr][j][0], v[rr][j][1]); o.y = cvt_pk_bf16(v[rr][j][2], v[rr][j][3]);
                *(u32x2*)(F.WinP + (size_t)(it * 4 + rr) * 1024 + j * 256 + lane * 4) = o; }
        return; } it -= P0_R6;
    {
        const int k = it * 64 + lane;
        const f32x4 g = *(const f32x4*)(F.w_group + (size_t)k * 4);
        f32x4 r[8];
#pragma unroll
        for (int q = 0; q < 8; ++q) r[q] = *(const f32x4*)(F.w_router + (size_t)k * 32 + 4 * q);
#pragma unroll
        for (int j = 0; j < 48; ++j) { float v = 0.f; if (j < 4) v = g[j]; else if (j < 36) v = r[(j - 4) >> 2][(j - 4) & 3];
            F.RW[(size_t)j * DM + k] = (bf16)(cvt_pk_bf16(v, 0.f) & 0xffffu); }
    }
}
__device__ __forceinline__ void p0_mod_item(Frame& F, int m) {
    LAS float* sil = (LAS float*)F.lds;
    LAS float* part = (LAS float*)(F.lds + 65536);
    { float cv[NB * DM / NTHR];
#pragma unroll
      for (int q = 0; q < NB * DM / NTHR; ++q) cv[q] = F.c[F.tid + q * NTHR];
#pragma unroll
      for (int q = 0; q < NB * DM / NTHR; ++q) sil[F.tid + q * NTHR] = cv[q] / (1.f + __expf(-cv[q])); }
    __syncthreads();
    const int lane = F.lane, cq = lane & 15, rs = lane >> 4, j0 = 64 * m + 4 * cq;
    f32x4 acc[NB];
#pragma unroll
    for (int b = 0; b < NB; ++b) acc[b] = (f32x4){0.f, 0.f, 0.f, 0.f};
#pragma unroll 1
    for (int i0 = 0; i0 < 64; i0 += 16) {
        f32x4 w[16];
#pragma unroll
        for (int u = 0; u < 16; ++u) w[u] = *(const f32x4*)(F.w_ada + (size_t)(256 * F.wave + 4 * (i0 + u) + rs) * (6 * DM) + j0);
        __builtin_amdgcn_sched_barrier(0);
#pragma unroll
        for (int u = 0; u < 16; ++u) { const int k = 256 * F.wave + 4 * (i0 + u) + rs;
#pragma unroll
            for (int b = 0; b < NB; ++b) acc[b] += w[u] * sil[b * DM + k];
            if ((u & 1) == 1) __builtin_amdgcn_sched_barrier(0); }
    }
#pragma unroll
    for (int b = 0; b < NB; ++b)
#pragma unroll
        for (int j = 0; j < 4; ++j) { float v = acc[b][j]; v += __shfl_xor(v, 16); v += __shfl_xor(v, 32); acc[b][j] = v; }
    if (rs == 0) {
#pragma unroll
        for (int b = 0; b < NB; ++b) *(LAS f32x4*)(part + (F.wave * NB + b) * 64 + 4 * cq) = acc[b]; }
    __syncthreads();
    { const int b = F.tid >> 6, col = F.tid & 63; float s = F.b_ada[64 * m + col];
#pragma unroll
        for (int w = 0; w < NWAVES; ++w) s += part[(w * NB + b) * 64 + col];
        F.mod[(size_t)b * (6 * DM) + 64 * m + col] = s; }
    __syncthreads();
}
__device__ __forceinline__ void p0_run(Frame& F, int r, int stride, int a0, int lenA, int b0, int lenB) {
    LAS float* scr = (LAS float*)(F.lds + F.wave * 16640);
    const int total = lenA + lenB;
#define P0_MAP(d) ((d) < lenA ? a0 + (d) : b0 + ((d) - lenA))
    f32x4 v[16]; bool loaded = false; P0Tile cur, nxt;
    if (r < total && P0_MAP(r) < P0_TILES) { cur = p0_decode(F, P0_MAP(r)); p0_tile_load(cur, v, F.lane); loaded = true; }
    for (int d = r; d < total; d += stride) {
        const int it = P0_MAP(d);
        if (it < P0_TILES) {
            if (!loaded) { cur = p0_decode(F, it); p0_tile_load(cur, v, F.lane); }
            p0_tile_park(cur, v, scr, F.lane);
            const int dn = d + stride; loaded = false;
            if (dn < total && P0_MAP(dn) < P0_TILES) { nxt = p0_decode(F, P0_MAP(dn)); p0_tile_load(nxt, v, F.lane); loaded = true; }
            p0_tile_store(cur, scr, F.lane);
            cur = nxt;
        } else p0_small_item(F, it - P0_TILES);
    }
#undef P0_MAP
}
constexpr int P0_EARLY_A = P0_R0 + P0_R1, P0_EARLY_B0 = P0_R0 + P0_R1 + 3 * P0_R2, P0_EARLY_BLEN = P0_ITEMS - P0_EARLY_B0;
__device__ __forceinline__ void p0_prologue(Frame& F, int qword) {
    (void)qword;
    __syncthreads();
    for (int m = F.bid; m < 192; m += F.G) p0_mod_item(F, m);
    const int gw = F.bid * NWAVES + F.wave;
    const int r = (F.G == 256) ? ((F.bid >= 192) ? gw - 192 * NWAVES : gw + 64 * NWAVES) : gw;
    p0_run(F, r, F.G * NWAVES, 0, P0_EARLY_A, P0_EARLY_B0, P0_EARLY_BLEN);
}
__device__ __forceinline__ void p0_late(Frame& F) {
    __syncthreads();
    const int end = (F.G == 256) ? P0_OFF_START : P0_EARLY_B0;
    p0_run(F, F.bid * NWAVES + F.wave, F.G * NWAVES, P0_EARLY_A + P0_R2, end - P0_EARLY_A - P0_R2, 0, 0);
}
__device__ __forceinline__ void p0_deferred(Frame& F) {
    if (F.G != 256 || F.bid < 192) return;
    LAS float* scr = (LAS float*)(F.lds + F.wave * 16640);
    f32x4 v[16]; P0Tile cur, nxt; const int w0 = (F.bid - 192) * NWAVES + F.wave;
    cur = p0_decode(F, P0_OFF_START + w0); p0_tile_load(cur, v, F.lane);
    for (int j = w0; j < P0_OFF_LEN; j += 64 * NWAVES) {
        p0_tile_park(cur, v, scr, F.lane);
        if (j + 64 * NWAVES < P0_OFF_LEN) { nxt = p0_decode(F, P0_OFF_START + j + 64 * NWAVES); p0_tile_load(nxt, v, F.lane); }
        p0_tile_store(cur, scr, F.lane);
        cur = nxt;
    }
}

__device__ __forceinline__ void p1_norm_rows(Frame& F, const float* xin, const float* gvec, int sh_off, int sc_off, bf16* hout) {
    const int gw = F.bid * NWAVES + F.wave, NGW = F.G * NWAVES, lane = F.lane;
    for (int grp = gw; grp < NTOK / 8; grp += NGW) {
        const int m0 = grp * 8, b = m0 / SEQ;
        const float* modb = F.mod + (size_t)b * (6 * DM);
        f32x4 gs[8], sh[8];
#pragma unroll
        for (int j = 0; j < 8; ++j) { const int col = 256 * j + 4 * lane; const f32x4 g = *(const f32x4*)(gvec + col), sc = *(const f32x4*)(modb + sc_off + col);
            gs[j] = g * (sc + 1.f); sh[j] = *(const f32x4*)(modb + sh_off + col); }
        f32x4 xa[8], xb[8];
#pragma unroll
        for (int j = 0; j < 8; ++j) xa[j] = *(const f32x4*)(xin + (size_t)m0 * DM + 256 * j + 4 * lane);
#define P1_ROW(CUR, NXT, r) do { \
            if ((r) + 1 < 8) { _Pragma("unroll") for (int j = 0; j < 8; ++j) NXT[j] = *(const f32x4*)(xin + (size_t)(m0 + (r) + 1) * DM + 256 * j + 4 * lane); } \
            float s = 0.f; \
            _Pragma("unroll") for (int j = 0; j < 8; ++j) s += (CUR[j][0] * CUR[j][0] + CUR[j][1] * CUR[j][1]) + (CUR[j][2] * CUR[j][2] + CUR[j][3] * CUR[j][3]); \
            const float rstd = 1.f / sqrtf(wave_sum(s) * (1.f / DM) + EPS); \
            bf16* orow = hout + (size_t)(m0 + (r)) * DM; \
            _Pragma("unroll") for (int j = 0; j < 8; ++j) { const f32x4 y = CUR[j] * rstd * gs[j] + sh[j]; \
                u32x2 o; o.x = cvt_pk_bf16(y[0], y[1]); o.y = cvt_pk_bf16(y[2], y[3]); *(u32x2*)(orow + 256 * j + 4 * lane) = o; } } while (0)
#pragma unroll 1
        for (int rp = 0; rp < 4; ++rp) { P1_ROW(xa, xb, 2 * rp); P1_ROW(xb, xa, 2 * rp + 1); }
#undef P1_ROW
    }
}

template <int W>
__device__ __forceinline__ void p3_window_load(Frame& F, int g, int tp, int lane, bf16x8 (&v)[W]) {
    const int m = 2 * tp + (lane >> 5), t = m & (SEQ - 1), c0 = g * 256 + 8 * (lane & 31);
    const char* up = (const char*)(F.P + (size_t)m * PLD + C_U + c0);
#pragma unroll
    for (int tau = 0; tau < W; ++tau) { const int back = (t - tau >= 0) ? tau : 0; v[tau] = *(const bf16x8*)(up - (size_t)back * (PLD * 2)); }
}
template <int W>
__device__ __forceinline__ void p3_window_finish(Frame& F, int g, int tp, int lane, const bf16x8 (&v)[W]) {
    const int m = 2 * tp + (lane >> 5), t = m & (SEQ - 1), c0 = g * 256 + 8 * (lane & 31);
    float sum[8], self[8];
#pragma unroll
    for (int j = 0; j < 8; ++j) { self[j] = bf2f((bf16)v[0][j]); sum[j] = self[j]; }
#pragma unroll
    for (int tau = 1; tau < W; ++tau) { const float wgt = (t - tau >= 0) ? 1.f : 0.f;
#pragma unroll
        for (int j = 0; j < 8; ++j) sum[j] = fmaf(wgt, bf2f((bf16)v[tau][j]), sum[j]); }
    const float inv = 1.f / (float)((t + 1) < W ? (t + 1) : W);
    u32x4 o; o.x = cvt_pk_bf16(sum[0] * inv - self[0], sum[1] * inv - self[1]); o.y = cvt_pk_bf16(sum[2] * inv - self[2], sum[3] * inv - self[3]);
    o.z = cvt_pk_bf16(sum[4] * inv - self[4], sum[5] * inv - self[5]); o.w = cvt_pk_bf16(sum[6] * inv - self[6], sum[7] * inv - self[7]);
    *(u32x4*)(F.CAT + (size_t)m * DM + c0) = o;
}
__device__ __forceinline__ void p3_window(Frame& F) {
    const int gw = F.bid * NWAVES + F.wave, NGW = F.G * NWAVES, lane = F.lane;
    for (int tp = gw; tp < NTOK / 2; tp += NGW) {
        bf16x8 v2[2], v4[4], v8[8], v16[16];
        p3_window_load<2>(F, 0, tp, lane, v2); p3_window_load<4>(F, 1, tp, lane, v4); p3_window_load<8>(F, 2, tp, lane, v8); p3_window_load<16>(F, 3, tp, lane, v16);
        p3_window_finish<2>(F, 0, tp, lane, v2); p3_window_finish<4>(F, 1, tp, lane, v4); p3_window_finish<8>(F, 2, tp, lane, v8); p3_window_finish<16>(F, 3, tp, lane, v16);
    }
}
__device__ __forceinline__ int half_sum32(int v) {
    v += __builtin_amdgcn_update_dpp(0, v, 0x128, 0xf, 0xf, false);
    v += __builtin_amdgcn_update_dpp(0, v, 0x124, 0xf, 0xf, false);
    v += __builtin_amdgcn_update_dpp(0, v, 0x122, 0xf, 0xf, false);
    v += __builtin_amdgcn_update_dpp(0, v, 0x121, 0xf, 0xf, false);
    v += __shfl_xor(v, 16);
    return v;
}
__device__ __forceinline__ float relu_asm(float x) { const int i = __builtin_bit_cast(int, x); return __builtin_bit_cast(float, i > 0 ? i : 0); }
constexpr int IDX_CH = 512;
__device__ __forceinline__ void p3_indexer_item(Frame& F, int conv_it, const bf16* Pb, unsigned* Mb, int tb, LAS unsigned char* kl, int tid, int wave, int lane) {
    const int r = lane & 31, hi = lane >> 5, t0 = tb + 2 * wave, ktd = t0 >> 5, tq = t0 + hi;
    const int nch = ((tb + 15) / IDX_CH) + 1;
    const GAS char* Pc = (const GAS char*)Pb;
    const unsigned srow = (unsigned)(tid >> 3), sch = (unsigned)(tid & 7);
    const unsigned sgo = (srow * PLD + C_KI + sch * 8) * 2u;
    const unsigned slo = srow * 128u + ((sch ^ ((srow >> 1) & 7u)) * 16u);
    bf16x8 stg[8];
#define IDX_LOAD(c) do { _Pragma("unroll") for (int i = 0; i < 8; ++i) { const GAS char* bp_ = Pc + (size_t)((c) * IDX_CH + 64 * i) * (PLD * 2); asm volatile("" : "+s"(bp_)); \
        stg[i] = *(const GAS bf16x8*)(bp_ + sgo); } } while (0)
    IDX_LOAD(0);
    bf16x8 aq[4];
    { const unsigned qoff = (unsigned)((t0 + (r >> 4)) * PLD + C_QI + (r & 15) * 64 + 8 * hi) * 2u;
#pragma unroll
      for (int j = 0; j < 4; ++j) aq[j] = *(const GAS bf16x8*)(Pc + qoff + 32 * j); }
    bf16x8 a0, a1;
    { const GAS char* w0p = Pc + (size_t)t0 * (PLD * 2) + (C_WI + 4 * hi) * 2; const GAS char* w1p = w0p + PLD * 2;
      const u32x2 x0 = *(const GAS u32x2*)w0p, x1 = *(const GAS u32x2*)(w0p + 16), y0 = *(const GAS u32x2*)w1p, y1 = *(const GAS u32x2*)(w1p + 16);
      u32x4 wa = {x0.x, x0.y, x1.x, x1.y}, wb = {y0.x, y0.y, y1.x, y1.y};
      if (r != 0) wa = (u32x4){0u, 0u, 0u, 0u};
      if (r != 4) wb = (u32x4){0u, 0u, 0u, 0u};
      a0 = *reinterpret_cast<bf16x8*>(&wa); a1 = *reinterpret_cast<bf16x8*>(&wb); }
    float key[64];
    float vmax = -__builtin_inff(), vmin = __builtin_inff(), s1 = 0.f, s2 = 0.f;
    unsigned kro[4];
#pragma unroll
    for (int j = 0; j < 4; ++j) kro[j] = (unsigned)r * 128u + ((((unsigned)(2 * j + hi)) ^ (((unsigned)r >> 1) & 7u)) * 16u);
    for (int crep = 0; crep < ((PROBE_DUP == 32) ? 2 : 1); ++crep) {
    if (crep) { IDX_LOAD(0); }
#pragma unroll
    for (int c = 0; c < SEQ / IDX_CH; ++c) {
        if (c < nch) {
            __syncthreads();
#pragma unroll
            for (int i = 0; i < 8; ++i) *(LAS bf16x8*)(kl + slo + i * 8192) = stg[i];
            __syncthreads();
            if (c + 1 < nch) IDX_LOAD(c + 1);
#pragma unroll
            for (int g = 0; g < IDX_CH / 128; ++g) {
                const int kt0 = c * (IDX_CH / 32) + 4 * g;
                if (kt0 <= ktd) {
#pragma unroll
                    for (int q = 0; q < 4; ++q) {
                        const int kt = kt0 + q; const LAS unsigned char* tl = kl + (4 * g + q) * 4096;
                        f32x16 d = {};
#pragma unroll
                        for (int j = 0; j < 4; ++j) d = __builtin_amdgcn_mfma_f32_32x32x16_bf16(aq[j], *(const LAS bf16x8*)(tl + kro[j]), d, 0, 0, 0);
                        u32x4 b0, b1;
                        b0.x = cvt_pk_bf16(relu_asm(d[0]), relu_asm(d[1])); b0.y = cvt_pk_bf16(relu_asm(d[2]), relu_asm(d[3]));
                        b0.z = cvt_pk_bf16(relu_asm(d[4]), relu_asm(d[5])); b0.w = cvt_pk_bf16(relu_asm(d[6]), relu_asm(d[7]));
                        b1.x = cvt_pk_bf16(relu_asm(d[8]), relu_asm(d[9])); b1.y = cvt_pk_bf16(relu_asm(d[10]), relu_asm(d[11]));
                        b1.z = cvt_pk_bf16(relu_asm(d[12]), relu_asm(d[13])); b1.w = cvt_pk_bf16(relu_asm(d[14]), relu_asm(d[15]));
                        asm volatile("s_nop 1" ::: "memory");
                        f32x16 e = {};
                        e = __builtin_amdgcn_mfma_f32_32x32x16_bf16(a0, *reinterpret_cast<bf16x8*>(&b0), e, 0, 0, 0);
                        e = __builtin_amdgcn_mfma_f32_32x32x16_bf16(a1, *reinterpret_cast<bf16x8*>(&b1), e, 0, 0, 0);
                        const bool ok = (kt * 32 + r <= tq);
                        const float sv = ok ? e[0] : -__builtin_inff();
                        key[kt] = sv; vmax = fmaxf(vmax, sv); vmin = fminf(vmin, ok ? e[0] : __builtin_inff());
                        { const float z0 = ok ? e[0] : 0.f; s1 += z0; s2 = fmaf(z0, z0, s2); }
                    }
                } else {
#pragma unroll
                    for (int q = 0; q < 4; ++q) key[kt0 + q] = -__builtin_inff();
                }
            }
        } else {
#pragma unroll
            for (int q = 0; q < IDX_CH / 32; ++q) key[c * (IDX_CH / 32) + q] = -__builtin_inff();
        }
    }
    }
#undef IDX_LOAD
    f32x4 cv[16];
    { const int r = conv_it & 255; const float* gsrc = F.w_gate + (size_t)(conv_it >> 8) * DM * DEXP + (size_t)(64 * (r >> 3)) * DEXP + 64 * (r & 7) + (size_t)(lane >> 4) * DEXP + (lane & 15) * 4;
#pragma unroll
      for (int i = 0; i < 16; ++i) cv[i] = *(const f32x4*)(gsrc + (size_t)(4 * i) * DEXP); }
    float T = -3.0e38f;
    const bool need = (tq + 1) > TOPK;
    for (int srep = 0; srep < ((PROBE_DUP == 31) ? 2 : 1); ++srep)
    if (__any(need)) {
#pragma unroll
        for (int o = 1; o < 32; o <<= 1) { vmax = fmaxf(vmax, __shfl_xor(vmax, o)); vmin = fminf(vmin, __shfl_xor(vmin, o)); s1 += __shfl_xor(s1, o); s2 += __shfl_xor(s2, o); }
        const float nf = (float)(tq + 1), mu = s1 / nf, sd = sqrtf(fmaxf(s2 / nf - mu * mu, 1e-20f));
        float zq; { const float pu = (float)TOPK / nf;
            const float q = fminf(pu, 1.f - pu), t = sqrtf(-2.f * __logf(fmaxf(q, 1e-6f)));
            const float zz = t - (2.515517f + t * (0.802853f + t * 0.010328f)) / (1.f + t * (1.432788f + t * (0.189269f + t * 0.001308f)));
            zq = (pu < 0.5f) ? zz : -zz; }
        const float dens = nf * 0.3989423f * __expf(-0.5f * zq * zq) / sd;
        float lo = vmin, hi = vmax, prev = mu + zq * sd, flo = (float)(tq + 1) - 255.5f, fhi = 1.f - 255.5f; int pcnt = TOPK, side = 0; bool done = !need;
        for (int it = 0; it < 96; ++it) {
            const float mid = 0.5f * lo + 0.5f * hi;
            float cand = ((it & 3) == 3) ? mid : lo + (hi - lo) * flo / (flo - fhi);
            if (it == 0) cand = prev;
            if (it == 1) cand = prev + ((float)(pcnt - TOPK) + 0.5f) / dens;
            if (!(cand > lo && cand < hi)) cand = mid;
            if (!(cand > lo && cand < hi)) done = true;
            if (__all(done)) break;
            int cnt = 0;
#pragma unroll
            for (int g = 0; g < 8; ++g) {
                if (8 * g <= ktd) {
#define CNT4(k0, k1, k2, k3) asm volatile("v_cmp_ge_f32_e64 s[88:89], %1, %5\n\tv_cmp_ge_f32_e64 s[90:91], %2, %5\n\tv_cmp_ge_f32_e64 s[92:93], %3, %5\n\tv_cmp_ge_f32_e64 s[94:95], %4, %5\n\t" \
                        "v_addc_co_u32_e64 %0, s[88:89], 0, %0, s[88:89]\n\tv_addc_co_u32_e64 %0, s[90:91], 0, %0, s[90:91]\n\tv_addc_co_u32_e64 %0, s[92:93], 0, %0, s[92:93]\n\tv_addc_co_u32_e64 %0, s[94:95], 0, %0, s[94:95]" \
                        : "+v"(cnt) : "v"(k0), "v"(k1), "v"(k2), "v"(k3), "v"(cand) : "s88", "s89", "s90", "s91", "s92", "s93", "s94", "s95")
                    CNT4(key[8 * g + 0], key[8 * g + 1], key[8 * g + 2], key[8 * g + 3]);
                    CNT4(key[8 * g + 4], key[8 * g + 5], key[8 * g + 6], key[8 * g + 7]);
#undef CNT4
                }
            }
            cnt = half_sum32(cnt);
            if (!done) {
                if (cnt >= TOPK) { lo = cand; flo = (float)cnt - 255.5f; if (side == 1) fhi *= 0.5f; side = 1; }
                else { hi = cand; fhi = (float)cnt - 255.5f; if (side == 2) flo *= 0.5f; side = 2; }
                if (cnt == TOPK) done = true; }
            prev = cand; pcnt = cnt;
        }
        if (need) T = lo;
    }
    unsigned mw0 = 0u, mw1 = 0u;
#pragma unroll
    for (int kt = 0; kt < 64; ++kt) {
        if (kt <= ktd) { const unsigned long long bal = __ballot(key[kt] >= T);
            const unsigned blo = (unsigned)bal, bhi = (unsigned)(bal >> 32);
            asm volatile("s_nop 4\n\tv_writelane_b32 %0, %2, %4\n\tv_writelane_b32 %1, %3, %4" : "+v"(mw0), "+v"(mw1) : "s"(blo), "s"(bhi), "n"(kt)); }
    }
    Mb[(size_t)t0 * 64 + lane] = mw0; Mb[(size_t)(t0 + 1) * 64 + lane] = mw1;
    __syncthreads();
    { P0Tile t; const int r = conv_it & 255; t.src = nullptr; t.ld_src = DEXP; t.k0 = 64 * (r >> 3); t.n0 = 64 * (r & 7); t.nvalid = DEXP; t.dst = (unsigned char*)F.Wgu + (size_t)(conv_it >> 8) * 1024 * DM; t.ld_dst = DM;
      t.himul = 256; t.radd = 0; t.fp8 = 1; t.scale = WGU_SCALE;
      LAS float* scr = (LAS float*)(kl + wave * 16640); p0_tile_park(t, cv, scr, lane); p0_tile_store(t, scr, lane); }
}
__device__ __forceinline__ void p3_indexer(Frame& F) {
    for (int wgi = F.vcu; wgi < 256; wgi += F.G) {
        const int b = wgi >> 5, j = wgi & 31;
#pragma unroll 1
        for (int s = 0; s < 4; ++s) { const int q16 = (s == 0) ? j : (s == 1) ? 63 - j : (s == 2) ? 64 + j : 127 - j;
            p3_indexer_item(F, (wgi * 4 + s) * NWAVES + F.wave, F.P + (size_t)b * SEQ * PLD, F.MASK + (size_t)b * SEQ * 64, q16 * 16, F.lds, F.tid, F.wave, F.lane); }
    }
}

namespace att {
constexpr int D = 128, QBLK = 32, KVBLK = 64, QB = 256;
constexpr int SHM_V = KVBLK * D * 2, SHM_K = KVBLK * D * 2;
constexpr int ATT_LDS = 2 * SHM_V + 2 * SHM_K + NWAVES * 64 * 4;
constexpr float SCALE = 0.08838834764831845f, THR = 8.f;
constexpr int RMAX = 207, NBIAS = 304;
#define KSWZ(row, colB) ((row) * 256 + ((colB) ^ (((row) & 7) << 4)))
#define SBAR() __builtin_amdgcn_sched_barrier(0)
__device__ __forceinline__ int v_st(int k, int c) { const int kk = (k & ~0xC) | ((k & 4) << 1) | ((k & 8) >> 1); return ((kk >> 3) * 4 + (c >> 5)) * 512 + ((kk & 7) * 32 + (c & 31)) * 2; }
__device__ __forceinline__ int v_rd_base(int lane) { return ((lane & 3) << 3) | (((lane >> 2) & 3) << 6) | (((lane >> 4) & 1) << 5) | (((lane >> 5) & 1) << 8); }
constexpr int v_rd_off(int d0, int ks, int half) { return d0 * 512 + ks * 4096 + half * 2048; }
__device__ __forceinline__ int crow(int r, int hi) { return (r & 3) + 8 * (r >> 2) + 4 * hi; }

__device__ __forceinline__ void mask_bias_tile(f32x16& p0, f32x16& p1, u32x2 mk, int hi, bool near, const LAS float* tb) {
    const float NEG = -__builtin_inff();
    const unsigned w0 = mk.x >> (4 * hi), w1 = mk.y >> (4 * hi);
    if (near) {
#pragma unroll
        for (int r = 0; r < 16; ++r) { const int c = (r & 3) + 8 * (r >> 2); p0[r] += tb[c]; p1[r] += tb[c + 32]; }
    }
    const int negb = __float_as_int(NEG);
#pragma unroll
    for (int r = 0; r < 16; ++r) { const int c = (r & 3) + 8 * (r >> 2);
        const int m0 = __builtin_amdgcn_sbfe((int)w0, c, 1), m1 = __builtin_amdgcn_sbfe((int)w1, c, 1);
        const float x0 = p0[r], x1 = p1[r];
        p0[r] = __int_as_float((__float_as_int(x0) & m0) | (negb & ~m0));
        p1[r] = __int_as_float((__float_as_int(x1) & m1) | (negb & ~m1)); }
}
__device__ __forceinline__ void partialSM(f32x16& p0, f32x16& p1, float& m_reg, float& mn, float& alpha) {
    float pmax = p0[0];
#pragma unroll
    for (int r = 1; r < 16; ++r) pmax = fmaxf(pmax, p0[r]);
#pragma unroll
    for (int r = 0; r < 16; ++r) pmax = fmaxf(pmax, p1[r]);
    { auto rr = __builtin_amdgcn_permlane32_swap(__float_as_uint(pmax), __float_as_uint(pmax), false, false);
      pmax = fmaxf(__uint_as_float(rr[0]), __uint_as_float(rr[1])); }
    constexpr float C2 = 1.4426950408889634f * SCALE;
    if (__builtin_expect(__all((pmax - m_reg) * SCALE <= THR), 1)) { mn = m_reg; alpha = 1.f; }
    else { mn = fmaxf(m_reg, pmax); alpha = __builtin_amdgcn_exp2f((m_reg - mn) * C2); m_reg = mn; }
    const float mnL = -mn * C2;
#pragma unroll
    for (int r = 0; r < 16; ++r) p0[r] = fmaf(p0[r], C2, mnL);
#pragma unroll
    for (int r = 0; r < 16; ++r) p1[r] = fmaf(p1[r], C2, mnL);
#pragma unroll
    for (int r = 0; r < 16; ++r) p0[r] = __builtin_amdgcn_exp2f(p0[r]);
}
__device__ __forceinline__ void finishSM(f32x16& p0, f32x16& p1, float alpha, float& l_reg, bf16x8& pa0, bf16x8& pa1, bf16x8& pa2, bf16x8& pa3) {
#pragma unroll
    for (int r = 0; r < 16; ++r) p1[r] = __builtin_amdgcn_exp2f(p1[r]);
    float ps = 0;
#pragma unroll
    for (int r = 0; r < 16; ++r) ps += p0[r];
#pragma unroll
    for (int r = 0; r < 16; ++r) ps += p1[r];
    { auto rr = __builtin_amdgcn_permlane32_swap(__float_as_uint(ps), __float_as_uint(ps), false, false);
      ps = __uint_as_float(rr[0]) + __uint_as_float(rr[1]); }
    l_reg = l_reg * alpha + ps;
#define PK4(P, B_, OUT) do { unsigned a0 = cvt_pk_bf16(P[B_+0], P[B_+1]), a1 = cvt_pk_bf16(P[B_+2], P[B_+3]);                          \
        unsigned b0 = cvt_pk_bf16(P[B_+4], P[B_+5]), b1 = cvt_pk_bf16(P[B_+6], P[B_+7]);                                             \
        auto r0 = __builtin_amdgcn_permlane32_swap(a0, b0, false, false); auto r1 = __builtin_amdgcn_permlane32_swap(a1, b1, false, false); \
        u32x4 w = {r0[0], r1[0], r0[1], r1[1]}; OUT = *reinterpret_cast<bf16x8*>(&w); } while (0)
    PK4(p0, 0, pa0); PK4(p0, 8, pa1); PK4(p1, 0, pa2); PK4(p1, 8, pa3);
#undef PK4
}
template <int KB>
__device__ __forceinline__ void qkt(f32x16& p0, f32x16& p1, const char* K_lds, const char* Qw, int r32, int hi) {
    p0 = f32x16{}; p1 = f32x16{};
    const char* kb[4]; const char* qb[4];
#pragma unroll
    for (int dd = 0; dd < 4; ++dd) { kb[dd] = K_lds + KB * SHM_K + KSWZ(r32, (dd * 16 + hi * 8) * 2); qb[dd] = Qw + KSWZ(r32, (dd * 16 + hi * 8) * 2); }
#pragma unroll
    for (int d0 = 0; d0 < 8; ++d0) { const char* a = kb[d0 & 3] + (d0 >> 2) * 128;
        bf16x8 b0 = *reinterpret_cast<const bf16x8*>(a);
        bf16x8 b1 = *reinterpret_cast<const bf16x8*>(a + 32 * 256);
        bf16x8 q = *reinterpret_cast<const bf16x8*>(qb[d0 & 3] + (d0 >> 2) * 128);
        p0 = __builtin_amdgcn_mfma_f32_32x32x16_bf16(b0, q, p0, 0, 0, 0);
        p1 = __builtin_amdgcn_mfma_f32_32x32x16_bf16(b1, q, p1, 0, 0, 0); }
    __builtin_amdgcn_sched_group_barrier(0x100, 3, 0);
#pragma unroll
    for (int d0 = 0; d0 < 7; ++d0) { __builtin_amdgcn_sched_group_barrier(0x100, 3, 0); __builtin_amdgcn_sched_group_barrier(0x008, 2, 0); }
    __builtin_amdgcn_sched_group_barrier(0x008, 2, 0);
}
template <int VB>
__device__ __forceinline__ void pv_tile(f32x16* o, int vb0, bf16x8 pa0, bf16x8 pa1, bf16x8 pa2, bf16x8 pa3) {
#define TRRD(dst, off) asm volatile("ds_read_b64_tr_b16 %0, %1 offset:%2" : "=&v"(dst) : "v"(vb0), "i"(off) : "memory")
#define PV_D0(d0) do { s16x4 l0, l1, l2, l3, h0, h1, h2, h3; constexpr int b_ = VB * SHM_V + v_rd_off(d0, 0, 0); \
        TRRD(l0, b_); TRRD(h0, b_ + 2048); TRRD(l1, b_ + 4096); TRRD(h1, b_ + 6144); TRRD(l2, b_ + 8192); TRRD(h2, b_ + 10240); TRRD(l3, b_ + 12288); TRRD(h3, b_ + 14336); \
        asm volatile("s_waitcnt lgkmcnt(0)" ::: "memory"); SBAR();   \
        o[d0] = __builtin_amdgcn_mfma_f32_32x32x16_bf16(pa0, (bf16x8){l0[0], l0[1], l0[2], l0[3], h0[0], h0[1], h0[2], h0[3]}, o[d0], 0, 0, 0);   \
        o[d0] = __builtin_amdgcn_mfma_f32_32x32x16_bf16(pa1, (bf16x8){l1[0], l1[1], l1[2], l1[3], h1[0], h1[1], h1[2], h1[3]}, o[d0], 0, 0, 0);   \
        o[d0] = __builtin_amdgcn_mfma_f32_32x32x16_bf16(pa2, (bf16x8){l2[0], l2[1], l2[2], l2[3], h2[0], h2[1], h2[2], h2[3]}, o[d0], 0, 0, 0);   \
        o[d0] = __builtin_amdgcn_mfma_f32_32x32x16_bf16(pa3, (bf16x8){l3[0], l3[1], l3[2], l3[3], h3[0], h3[1], h3[2], h3[3]}, o[d0], 0, 0, 0); } while (0)
    PV_D0(0); PV_D0(1); PV_D0(2); PV_D0(3);
#undef PV_D0
#undef TRRD
}
struct BlockRef { const bf16* Q; const bf16* K; bf16* O; const unsigned* M; int P0; };
struct Seam { bf16x8 st_v0, st_v1, st_k0, st_k1; u32x2 mkA; };
constexpr int Q_OFF = 2 * SHM_V + 2 * SHM_K + NWAVES * 64 * 4;
constexpr int ATT_LDS_ALL = Q_OFF + NWAVES * 8192;
#define VMW() asm volatile("s_waitcnt vmcnt(0)" ::: "memory")
#define KVROW (PLD * 2)
#define SLOAD_H(Kp, k0) do { const char* kt_ = (const char*)(Kp) + (size_t)(k0) * KVROW; \
        S.st_k0 = *(const bf16x8*)(kt_ + kvo); S.st_k1 = *(const bf16x8*)(kt_ + 32 * KVROW + kvo); \
        S.st_v0 = *(const bf16x8*)(kt_ + (C_V - C_K) * 2 + kvo); S.st_v1 = *(const bf16x8*)(kt_ + 32 * KVROW + (C_V - C_K) * 2 + kvo); } while (0)
#define SWRITE_HK(bf) do { *(bf16x8*)(K_lds + (bf) * SHM_K + kws) = S.st_k0; *(bf16x8*)(K_lds + (bf) * SHM_K + kws + 32 * 256) = S.st_k1; } while (0)
#define SWRITE_HV(bf) do { *(bf16x8*)(V_lds + (bf) * SHM_V + vst0) = S.st_v0; *(bf16x8*)(V_lds + (bf) * SHM_V + vst1) = S.st_v1; } while (0)
#define SWRITE_H(bf) do { SWRITE_HV(bf); SWRITE_HK(bf); } while (0)
#define MLOAD(ref, tile) (*(const u32x2*)((const char*)((ref).M + (size_t)wid * QBLK * 64 + 2 * (tile)) + mro))
__device__ __forceinline__ void attn_prime(const BlockRef& cur, char* lds, Seam& S, const int wid, const int lane) {
    const int tid = wid * 64 + lane, r32 = lane & 31;
    const int sr = tid >> 4, sc = (tid & 15) * 8, kws = KSWZ(sr, sc * 2); char* K_lds = lds + 2 * SHM_V;
    const unsigned kvo = (unsigned)(sr * PLD + sc) * 2u, mro = (unsigned)r32 * 256u;
    SLOAD_H(cur.K, 0); S.mkA = MLOAD(cur, 0); VMW(); SWRITE_HK(0);
    __syncthreads();
}
__device__ __forceinline__ void attn_block(const BlockRef& cur, const BlockRef& nxt, char* lds, const LAS float* btab, Seam& S, const int wid, const int lane) {
    const int tid = wid * 64 + lane, r32 = lane & 31, hi = lane >> 5;
    const int NT = (cur.P0 + QB - 1) / KVBLK + 1;
    const int qlo = cur.P0 + wid * QBLK, pos = qlo + r32;
    char* V_lds = lds; char* K_lds = lds + 2 * SHM_V; char* Qw = lds + Q_OFF + wid * 8192;
    float* ws = (float*)(lds + 2 * SHM_V + 2 * SHM_K) + wid * 64; float* li_l = ws, * al_l = ws + 32;
    float m_reg = -1e30f, l_reg = 0; f32x16 o[4] = {};
    const int sr = tid >> 4, sc = (tid & 15) * 8, vst0 = v_st(sr, sc), vst1 = v_st(32 + sr, sc), kws = KSWZ(sr, sc * 2);
    const unsigned kvo = (unsigned)(sr * PLD + sc) * 2u, mro = (unsigned)r32 * 256u;
    const int vb0 = (int)(uintptr_t)V_lds + v_rd_base(lane);
    const bf16* Kh = cur.K;
    u32x2 mkA = S.mkA, mkB = (u32x2){0u, 0u};
    {
        const char* qg = (const char*)(cur.Q + (size_t)wid * QBLK * PLD) + (unsigned)(r32 * PLD + hi * 8) * 2u;
        bf16x8 qv[8];
#pragma unroll
        for (int d0 = 0; d0 < 8; ++d0) qv[d0] = *(const bf16x8*)(qg + d0 * 32);
#pragma unroll
        for (int d0 = 0; d0 < 8; ++d0) *(bf16x8*)(Qw + KSWZ(r32, (d0 * 16 + hi * 8) * 2)) = qv[d0];
        asm volatile("s_waitcnt lgkmcnt(0)" ::: "memory");
    }
#define RESC(a) do { if (__any((a) < 1.f)) { if (hi == 0) al_l[r32] = (a); asm volatile("s_waitcnt lgkmcnt(0)" ::: "memory");              \
                     for (int d_ = 0; d_ < 4; ++d_) for (int r = 0; r < 16; ++r) o[d_][r] *= al_l[crow(r, hi)]; } } while (0)
#define KBASE(t) ((t) * KVBLK)
#define MASKT(P0_, P1_, mk, t) do { const int kb_ = KBASE(t); const bool near_ = (kb_ <= qlo + QBLK - 1) && (kb_ > qlo - 176); \
        mask_bias_tile(P0_, P1_, mk, hi, near_, btab + (RMAX - (pos - kb_ - 4 * hi))); } while (0)
    f32x16 pA0, pA1, pB0, pB1; float mnA, mnB, alA, alB; bf16x8 pa0, pa1, pa2, pa3;
    SWRITE_HV(0); SBAR();
    if (NT > 1) { SLOAD_H(Kh, KBASE(1)); mkB = MLOAD(cur, 1); }
    SBAR(); qkt<0>(pA0, pA1, K_lds, Qw, r32, hi);
    MASKT(pA0, pA1, mkA, 0); partialSM(pA0, pA1, m_reg, mnA, alA);
    if (NT > 1) { VMW(); SWRITE_H(1); }
    __syncthreads();
#define HALF_STEP(PX0, PX1, mnX, alX, mkX, PY0, PY1, alY, mkY, t, KB, VB, SB) do {                                                      \
        SBAR(); qkt<KB>(PX0, PX1, K_lds, Qw, r32, hi);                                             \
        finishSM(PY0, PY1, alY, l_reg, pa0, pa1, pa2, pa3); SBAR();                                                           \
        if ((t) + 1 < NT) { SLOAD_H(Kh, KBASE((t) + 1)); mkY = MLOAD(cur, (t) + 1); SBAR(); }                                               \
        pv_tile<VB>(o, vb0, pa0, pa1, pa2, pa3); MASKT(PX0, PX1, mkX, (t)); partialSM(PX0, PX1, m_reg, mnX, alX);                                        \
        __syncthreads();                                                                                                      \
        if ((t) + 1 < NT) { VMW(); SWRITE_H(SB); }                                                                          \
        RESC(alX); __syncthreads(); } while (0)
    for (int t = 1; t + 1 < NT; t += 2) {
        HALF_STEP(pB0, pB1, mnB, alB, mkB, pA0, pA1, alA, mkA, t, 1, 0, 0);
        HALF_STEP(pA0, pA1, mnA, alA, mkA, pB0, pB1, alB, mkB, t + 1, 0, 1, 1);
    }
    const bool even = (NT & 1) == 0;
    if (even) { SBAR(); qkt<1>(pB0, pB1, K_lds, Qw, r32, hi); SBAR(); }
    SLOAD_H(nxt.K, 0); mkA = MLOAD(nxt, 0); SBAR();
    finishSM(pA0, pA1, alA, l_reg, pa0, pa1, pa2, pa3); SBAR();
    pv_tile<0>(o, vb0, pa0, pa1, pa2, pa3);
    if (even) { MASKT(pB0, pB1, mkB, NT - 1); partialSM(pB0, pB1, m_reg, mnB, alB); __syncthreads(); RESC(alB);
        finishSM(pB0, pB1, alB, l_reg, pa0, pa1, pa2, pa3); SBAR(); pv_tile<1>(o, vb0, pa0, pa1, pa2, pa3); }
    SBAR(); VMW(); SWRITE_HK(0); SBAR();
    S.mkA = mkA;
    if (hi == 0) li_l[r32] = l_reg; asm volatile("s_waitcnt lgkmcnt(0)" ::: "memory");
    float rli[16];
#pragma unroll
    for (int r = 0; r < 16; ++r) rli[r] = __builtin_amdgcn_rcpf(li_l[crow(r, hi)]);
    {
        bf16* ol = (bf16*)Qw;
#pragma unroll
        for (int r = 0; r < 16; ++r) { const int orow = crow(r, hi);
#pragma unroll
            for (int d0 = 0; d0 < 4; ++d0) ol[orow * D + d0 * 32 + r32] = (bf16)(cvt_pk_bf16(o[d0][r] * rli[r], 0.f) & 0xffffu); }
        asm volatile("s_waitcnt lgkmcnt(0)" ::: "memory");
        char* Ob = (char*)(cur.O + (size_t)(wid * QBLK) * DM);
        const unsigned ovo = (unsigned)((lane >> 4) * (DM * 2) + (lane & 15) * 16);
#pragma unroll
        for (int i = 0; i < 8; ++i) { const u32x4 w = *(const u32x4*)(Qw + i * 1024 + lane * 16);
            GAS char* Obi = (GAS char*)(Ob + (size_t)i * (4 * DM * 2)); asm volatile("" : "+s"(Obi));
            *(GAS u32x4*)(Obi + ovo) = w; }
        asm volatile("s_waitcnt lgkmcnt(0)" ::: "memory");
    }
    __syncthreads();
#undef RESC
#undef KBASE
#undef MASKT
#undef HALF_STEP
}
#undef VMW
#undef SLOAD_H
#undef SWRITE_HK
#undef SWRITE_HV
#undef SWRITE_H
#undef MLOAD
#undef KVROW
}

__device__ __forceinline__ int t5_bucket(int rel) {
    if (rel < 16) return rel;
    int v = 16 + (int)(logf((float)rel / 16.f) / logf(8.f) * 16.f);
    return v < 31 ? v : 31;
}
__device__ __forceinline__ att::BlockRef p4_ref(Frame& F, int it, int pass) {
    const int b = it >> 5, h = (it >> 2) & 7, p = it & 3, kvh = h >> 2, qb = pass ? 7 - p : p;
    const bf16* Pb = F.P + (size_t)b * SEQ * PLD;
    att::BlockRef r; r.P0 = qb * 256;
    r.Q = Pb + (size_t)r.P0 * PLD + C_Q + h * HD; r.K = Pb + C_K + kvh * HD;
    r.O = F.CAT + (size_t)(b * SEQ + r.P0) * DM + POOLW + h * HD; r.M = F.MASK + (size_t)(b * SEQ + r.P0) * 64;
    return r;
}
__device__ __forceinline__ void p4_attention(Frame& F, int nitems) {
    LAS float* btab = (LAS float*)(F.lds + MISC_BASE + MO_BIAS);
    char* lds = (char*)F.lds;
    int it = F.vcu, pass = 0;
    if (it >= nitems) return;
    att::Seam S;
    { const att::BlockRef c0 = p4_ref(F, it & 255, 0); att::attn_prime(c0, lds, S, F.wave, F.lane); }
    for (;;) {
        if (pass == 0) {
            const int h = (it >> 2) & 7;
            __syncthreads();
            for (int i = F.tid; i < att::NBIAS; i += NTHR) { const int rel = att::RMAX - i; float v = 0.f;
                if (rel >= 0) v = (F.rel_bias[t5_bucket(rel) * NHEAD + h] - F.rel_bias[31 * NHEAD + h]) * (1.f / att::SCALE);
                btab[i] = v; }
            __syncthreads();
        }
        const bool more_item = it + F.G < nitems, last = (pass == 1) && !more_item;
        const int itn = (pass == 0) ? it : (more_item ? it + F.G : it), passn = (pass == 0) ? 1 : (more_item ? 0 : 1);
        const att::BlockRef cur = p4_ref(F, it & 255, pass), nxt = p4_ref(F, itn & 255, passn);
        att::attn_block(cur, nxt, lds, btab, S, F.wave, F.lane);
        if (last) break;
        it = itn; pass = passn;
    }
}

constexpr int P6_ROWS = 32, P6_PITCH = 4112;
constexpr int P6_LOG = P6_ROWS * P6_PITCH;
static_assert(P6_LOG + P6_ROWS * 48 * 4 <= MISC_BASE, "P6 LDS");
__device__ __forceinline__ void p6_route(Frame& F, const LAS float* lg, int m) {
    float gmax = lg[0] + F.b_group[0]; int gsel = 0;
#pragma unroll
    for (int i = 1; i < NGRP; ++i) { const float v = lg[i] + F.b_group[i]; if (v > gmax) { gmax = v; gsel = i; } }
    float gz = 0.f;
#pragma unroll
    for (int i = 0; i < NGRP; ++i) gz += __expf(lg[i] + F.b_group[i] - gmax);
    const float pg = 1.f / gz;
    float e1v = -3.0e38f, e2v = -3.0e38f; int i1 = 0, i2 = 0;
#pragma unroll
    for (int i = 0; i < EPG; ++i) { const float v = lg[4 + gsel * EPG + i] + F.b_router[gsel * EPG + i];
        if (v > e1v) { e2v = e1v; i2 = i1; e1v = v; i1 = i; } else if (v > e2v) { e2v = v; i2 = i; } }
    const float w1 = 1.f / (1.f + __expf(e2v - e1v)), w2 = 1.f - w1;
    const int ex1 = gsel * EPG + i1, ex2 = gsel * EPG + i2;
    const unsigned p1 = atomicAdd(F.ctl + CW_ECNT + 16 * ex1, 1u), p2 = atomicAdd(F.ctl + CW_ECNT + 16 * ex2, 1u);
    F.TOKLIST[ex1 * NTOK + (int)p1] = m; F.TOKLIST[ex2 * NTOK + (int)p2] = m;
    unsigned* ti = F.TOKINFO + (size_t)m * 8;
    ti[0] = (unsigned)ex1; ti[1] = p1; ti[2] = (unsigned)ex2; ti[3] = p2; ti[4] = __float_as_uint(pg * w1); ti[5] = __float_as_uint(pg * w2);
}
__device__ __forceinline__ void p6_norm_router(Frame& F, bool route) {
    LAS unsigned char* tile = F.lds;
    LAS float* logit = (LAS float*)(F.lds + P6_LOG);
    const int lane = F.lane, wave = F.wave, fr = lane & 15, fq = lane >> 4;
    int prev_m0 = -1;
    for (int grp = F.bid; grp < NTOK / P6_ROWS; grp += F.G) {
        const int m0 = grp * P6_ROWS, b = m0 / SEQ;
        const float* modb = F.mod + (size_t)b * (6 * DM);
        u32x2 xb[4][8];
#pragma unroll
        for (int rr = 0; rr < 4; ++rr)
#pragma unroll
            for (int j = 0; j < 8; ++j) xb[rr][j] = *(const u32x2*)(F.X1 + (size_t)(m0 + 4 * wave + rr) * DM + 256 * j + 4 * lane);
        f32x4 gs[8], sh[8];
#pragma unroll
        for (int j = 0; j < 8; ++j) { const int col = 256 * j + 4 * lane; const f32x4 g = *(const f32x4*)(F.g_ffn + col), sc = *(const f32x4*)(modb + 4 * DM + col);
            gs[j] = g * (sc + 1.f); sh[j] = *(const f32x4*)(modb + 3 * DM + col); }
        if (route && prev_m0 >= 0 && lane < 4) p6_route(F, logit + (4 * wave + lane) * 48, prev_m0 + 4 * wave + lane);
#pragma unroll
        for (int rr = 0; rr < 4; ++rr) {
            const int lr = 4 * wave + rr, m = m0 + lr;
            f32x4 v[8]; float s = 0.f;
#pragma unroll
            for (int j = 0; j < 8; ++j) { const u32x2 q = xb[rr][j];
                v[j][0] = __uint_as_float(q.x << 16); v[j][1] = __uint_as_float(q.x & 0xffff0000u); v[j][2] = __uint_as_float(q.y << 16); v[j][3] = __uint_as_float(q.y & 0xffff0000u);
                s += (v[j][0] * v[j][0] + v[j][1] * v[j][1]) + (v[j][2] * v[j][2] + v[j][3] * v[j][3]); }
            const float rstd = 1.f / sqrtf(wave_sum(s) * (1.f / DM) + EPS);
            unsigned char* orow = (unsigned char*)F.H + (size_t)m * DM;
#pragma unroll
            for (int j = 0; j < 8; ++j) { const f32x4 y = v[j] * rstd * gs[j] + sh[j];
                u32x2 o; o.x = cvt_pk_bf16(y[0], y[1]); o.y = cvt_pk_bf16(y[2], y[3]);
                *(unsigned*)(orow + 256 * j + 4 * lane) = pk4_fp8(y[0], y[1], y[2], y[3]);
                *(LAS u32x2*)(tile + lr * P6_PITCH + (256 * j + 4 * lane) * 2) = o; }
        }
        __syncthreads();
        if (wave < 6) {
            const int rb = wave / 3, nb = wave - 3 * rb;
            f32x4 acc = (f32x4){0.f, 0.f, 0.f, 0.f};
            const LAS unsigned char* ap = tile + (rb * 16 + fr) * P6_PITCH + 16 * fq;
            const bf16* bp = F.RW + (size_t)(nb * 16 + fr) * DM + 8 * fq;
#pragma unroll 16
            for (int ks = 0; ks < 64; ++ks) acc = __builtin_amdgcn_mfma_f32_16x16x32_bf16(*(const LAS bf16x8*)(ap + 64 * ks), *(const bf16x8*)(bp + 32 * ks), acc, 0, 0, 0);
#pragma unroll
            for (int j = 0; j < 4; ++j) logit[(rb * 16 + 4 * fq + j) * 48 + nb * 16 + fr] = acc[j];
        }
        __syncthreads();
        prev_m0 = m0;
    }
    if (route && prev_m0 >= 0 && lane < 4) p6_route(F, logit + (4 * wave + lane) * 48, prev_m0 + 4 * wave + lane);
}
constexpr int S6_ROWS = 16, S6_LOG = S6_ROWS * P6_PITCH, S6_CTR = 69120, S6_SCR_HI = 69632;
static_assert(S6_LOG + S6_ROWS * 48 * 4 <= S6_CTR && S6_SCR_HI + 4 * 16640 <= MISC_BASE, "side-by-side LDS map");
__device__ __forceinline__ void bar4(volatile LAS unsigned* cnt, unsigned& target, int lane) {
    asm volatile("s_waitcnt lgkmcnt(0)" ::: "memory");
    target += 4u;
    if (lane == 0) (void)__hip_atomic_fetch_add((LAS unsigned*)cnt, 1u, __ATOMIC_RELAXED, __HIP_MEMORY_SCOPE_WORKGROUP);
    while (*cnt < target) __builtin_amdgcn_s_sleep(1);
    asm volatile("" ::: "memory");
}
__device__ __forceinline__ void s6_router(Frame& F, volatile LAS unsigned* bcnt) {
    LAS unsigned char* tile = F.lds;
    LAS float* logit = (LAS float*)(F.lds + S6_LOG);
    const int lane = F.lane, wave = F.wave, fr = lane & 15, fq = lane >> 4;
    unsigned btarget = 0u; int prev_m0 = -1;
    for (int grp = F.bid; grp < NTOK / S6_ROWS; grp += F.G) {
        const int m0 = grp * S6_ROWS, b = m0 / SEQ;
        const float* modb = F.mod + (size_t)b * (6 * DM);
        u32x2 xb[4][8];
#pragma unroll
        for (int rr = 0; rr < 4; ++rr)
#pragma unroll
            for (int j = 0; j < 8; ++j) xb[rr][j] = *(const u32x2*)(F.X1 + (size_t)(m0 + 4 * wave + rr) * DM + 256 * j + 4 * lane);
        f32x4 gs[8], sh[8];
#pragma unroll
        for (int j = 0; j < 8; ++j) { const int col = 256 * j + 4 * lane; const f32x4 g = *(const f32x4*)(F.g_ffn + col), sc = *(const f32x4*)(modb + 4 * DM + col);
            gs[j] = g * (sc + 1.f); sh[j] = *(const f32x4*)(modb + 3 * DM + col); }
        if (prev_m0 >= 0 && lane < 4) p6_route(F, logit + (4 * wave + lane) * 48, prev_m0 + 4 * wave + lane);
        bar4(bcnt, btarget, lane);
#pragma unroll
        for (int rr = 0; rr < 4; ++rr) {
            const int lr = 4 * wave + rr, m = m0 + lr;
            f32x4 v[8]; float s = 0.f;
#pragma unroll
            for (int j = 0; j < 8; ++j) { const u32x2 q = xb[rr][j];
                v[j][0] = __uint_as_float(q.x << 16); v[j][1] = __uint_as_float(q.x & 0xffff0000u); v[j][2] = __uint_as_float(q.y << 16); v[j][3] = __uint_as_float(q.y & 0xffff0000u);
                s += (v[j][0] * v[j][0] + v[j][1] * v[j][1]) + (v[j][2] * v[j][2] + v[j][3] * v[j][3]); }
            const float rstd = 1.f / sqrtf(wave_sum(s) * (1.f / DM) + EPS);
            unsigned char* orow = (unsigned char*)F.H + (size_t)m * DM;
#pragma unroll
            for (int j = 0; j < 8; ++j) { const f32x4 y = v[j] * rstd * gs[j] + sh[j];
                u32x2 o; o.x = cvt_pk_bf16(y[0], y[1]); o.y = cvt_pk_bf16(y[2], y[3]);
                *(unsigned*)(orow + 256 * j + 4 * lane) = pk4_fp8(y[0], y[1], y[2], y[3]);
                *(LAS u32x2*)(tile + lr * P6_PITCH + (256 * j + 4 * lane) * 2) = o; }
        }
        bar4(bcnt, btarget, lane);
        if (wave < 3) {
            const int nb = wave;
            f32x4 acc = (f32x4){0.f, 0.f, 0.f, 0.f};
            const LAS unsigned char* ap = tile + fr * P6_PITCH + 16 * fq;
            const bf16* bp = F.RW + (size_t)(nb * 16 + fr) * DM + 8 * fq;
#pragma unroll 16
            for (int ks = 0; ks < 64; ++ks) acc = __builtin_amdgcn_mfma_f32_16x16x32_bf16(*(const LAS bf16x8*)(ap + 64 * ks), *(const bf16x8*)(bp + 32 * ks), acc, 0, 0, 0);
#pragma unroll
            for (int j = 0; j < 4; ++j) logit[(4 * fq + j) * 48 + nb * 16 + fr] = acc[j];
        }
        bar4(bcnt, btarget, lane);
        prev_m0 = m0;
    }
    if (prev_m0 >= 0 && lane < 4) p6_route(F, logit + (4 * wave + lane) * 48, prev_m0 + 4 * wave + lane);
    bar4(bcnt, btarget, lane);
}
__device__ __forceinline__ int lds_pop(LAS unsigned* ctr, int lane) {
    int v = 0; if (lane == 0) v = (int)__hip_atomic_fetch_add(ctr, 1u, __ATOMIC_RELAXED, __HIP_MEMORY_SCOPE_WORKGROUP);
    return __builtin_amdgcn_readfirstlane(v);
}
__device__ __forceinline__ void s6_convert(Frame& F, LAS unsigned* ctr, LAS float* scr, int a0, int total) {
    f32x4 v[16]; P0Tile cur, nxt;
    int d = F.bid + F.G * lds_pop(ctr, F.lane);
    if (d >= total) return;
    cur = p0_decode(F, a0 + d); p0_tile_load(cur, v, F.lane);
    for (;;) {
        p0_tile_park(cur, v, scr, F.lane);
        const int dn = F.bid + F.G * lds_pop(ctr, F.lane); const bool more = dn < total;
        if (more) { nxt = p0_decode(F, a0 + dn); p0_tile_load(nxt, v, F.lane); }
        p0_tile_store(cur, scr, F.lane);
        if (!more) break;
        cur = nxt;
    }
}
__device__ __forceinline__ void p6_side_by_side(Frame& F) {
    LAS unsigned* ctrs = (LAS unsigned*)(F.lds + S6_CTR);
    __syncthreads();
    if (F.tid == 0) { ctrs[0] = 0u; ctrs[1] = 0u; }
    __syncthreads();
    constexpr int A0 = P0_EARLY_A + P0_R2;
    const int total = ((F.G == 256) ? P0_OFF_START : P0_EARLY_B0) - A0;
    if (F.wave < 4) { s6_router(F, (volatile LAS unsigned*)ctrs); s6_convert(F, ctrs + 1, (LAS float*)(F.lds + F.wave * 16640), A0, total); }
    else s6_convert(F, ctrs + 1, (LAS float*)(F.lds + S6_SCR_HI + (F.wave - 4) * 16640), A0, total);
}

__device__ __forceinline__ pg8::MoeTabs moe_tabs(Frame& F) {
    pg8::MoeTabs T; T.tb = (const LAS int*)(F.lds + MISC_BASE + MO_TB); T.tf = T.tb + 40; T.hl = T.tb + 80; return T;
}
__device__ __forceinline__ void moe_tables(Frame& F) {
    LAS int* tb = (LAS int*)(F.lds + MISC_BASE + MO_TB); LAS int* tf = tb + 40; LAS int* hl = tb + 80; LAS int* cnt = (LAS int*)(F.lds + MISC_BASE + MO_CNT);
    __syncthreads();
    if (F.tid < NEXP) cnt[F.tid] = (int)__hip_atomic_load(F.ctl + CW_ECNT + 16 * F.tid, __ATOMIC_RELAXED, __HIP_MEMORY_SCOPE_AGENT);
    __syncthreads();
    if (F.tid == 0) { int s = 0, f = 0, nh = 0;
        for (int e = 0; e < NEXP; ++e) { const int c = cnt[e], t = (c + 255) >> 8, rem = c - ((t - 1) << 8), h = (t > 0 && rem <= 128) ? 1 : 0;
            tb[e] = s; tf[e] = f; s += t; f += t - h; if (h) hl[nh++] = e; }
        tb[NEXP] = s; tf[NEXP] = f; hl[NEXP] = nh; }
    __syncthreads();
}
__device__ __forceinline__ void p7_rowtab(Frame& F, int reps) {
    const pg8::MoeTabs T = moe_tabs(F); const LAS int* cnt = (const LAS int*)(F.lds + MISC_BASE + MO_CNT);
    LAS unsigned* rowtab = (LAS unsigned*)(F.lds + MISC_BASE + MO_ROWTAB);
    unsigned off[MAXU * 256 / NTHR];
#pragma unroll
    for (int q = 0; q < MAXU * 256 / NTHR; ++q) { const int idx = F.tid + q * NTHR, ord = idx >> 8, r = idx & 255; int pm, pn, e, half; off[q] = 0u;
        if (pg8::moe_unit(T, 4, ord * F.G + F.vcu, reps, pm, pn, e, half)) {
            const int slot = (pm - T.tb[e]) * 256 + r; if (slot < cnt[e]) off[q] = (unsigned)F.TOKLIST[e * NTOK + slot] * (unsigned)DM; } }
#pragma unroll
    for (int q = 0; q < MAXU * 256 / NTHR; ++q) rowtab[F.tid + q * NTHR] = off[q];
    __syncthreads();
}
struct P9Row { u32x2 x[8]; int ya[8], yc[8]; };
__device__ __forceinline__ void p9_load(Frame& F, const LAS int* tb, int m, int e1, int p1, int e2, int p2, P9Row& R, int lane) {
    const bf16* x1r = F.X1 + (size_t)m * DM;
    const unsigned char* y1 = (const unsigned char*)F.Y + ((size_t)tb[e1] * 256 + p1) * DM; const unsigned char* y2 = (const unsigned char*)F.Y + ((size_t)tb[e2] * 256 + p2) * DM;
#pragma unroll
    for (int j = 0; j < 8; ++j) { const int col = 256 * j + 4 * lane; R.x[j] = *(const u32x2*)(x1r + col); R.ya[j] = *(const int*)(y1 + col); R.yc[j] = *(const int*)(y2 + col); }
}
__device__ __forceinline__ void p9_final(Frame& F) {
    const LAS int* tb = (const LAS int*)(F.lds + MISC_BASE + MO_TB);
    const int gw = F.bid * NWAVES + F.wave, NGW = F.G * NWAVES, lane = F.lane;
    for (int grp = gw; grp < NTOK / 8; grp += NGW) {
        const int m0 = grp * 8, b = m0 / SEQ;
        const unsigned tiw = (lane < 48) ? F.TOKINFO[(size_t)(m0 + lane / 6) * 8 + (lane % 6)] : 0u;
        f32x4 gt[8], gf[8];
#pragma unroll
        for (int j = 0; j < 8; ++j) { const int col = 256 * j + 4 * lane; gt[j] = *(const f32x4*)(F.mod + (size_t)b * (6 * DM) + 5 * DM + col); gf[j] = *(const f32x4*)(F.g_final + col); }
        P9Row R[2];
#define P9_TI(r, w) __builtin_amdgcn_readlane((int)tiw, 6 * (r) + (w))
        p9_load(F, tb, m0, P9_TI(0, 0), P9_TI(0, 1), P9_TI(0, 2), P9_TI(0, 3), R[0], lane);
#pragma unroll
        for (int r = 0; r < 8; ++r) {
            if (r + 1 < 8) p9_load(F, tb, m0 + r + 1, P9_TI(r + 1, 0), P9_TI(r + 1, 1), P9_TI(r + 1, 2), P9_TI(r + 1, 3), R[(r + 1) & 1], lane);
            const P9Row& C = R[r & 1];
            const float g1s = __uint_as_float((unsigned)P9_TI(r, 4)) * (1.f / Y_SCALE), g2s = __uint_as_float((unsigned)P9_TI(r, 5)) * (1.f / Y_SCALE);
            f32x4 v[8]; float s = 0.f;
#pragma unroll
            for (int j = 0; j < 8; ++j) { const u32x2 xb = C.x[j]; const int a = C.ya[j], c = C.yc[j];
                f32x4 xv; xv[0] = __uint_as_float(xb.x << 16); xv[1] = __uint_as_float(xb.x & 0xffff0000u); xv[2] = __uint_as_float(xb.y << 16); xv[3] = __uint_as_float(xb.y & 0xffff0000u);
                f32x4 ya, yc;
                { const f32x2 lo = __builtin_amdgcn_cvt_pk_f32_fp8(a, false), hi = __builtin_amdgcn_cvt_pk_f32_fp8(a, true); ya[0] = lo[0]; ya[1] = lo[1]; ya[2] = hi[0]; ya[3] = hi[1]; }
                { const f32x2 lo = __builtin_amdgcn_cvt_pk_f32_fp8(c, false), hi = __builtin_amdgcn_cvt_pk_f32_fp8(c, true); yc[0] = lo[0]; yc[1] = lo[1]; yc[2] = hi[0]; yc[3] = hi[1]; }
                v[j] = xv + gt[j] * (ya * g1s + yc * g2s);
                s += (v[j][0] * v[j][0] + v[j][1] * v[j][1]) + (v[j][2] * v[j][2] + v[j][3] * v[j][3]); }
            const float rstd = 1.f / sqrtf(wave_sum(s) * (1.f / DM) + EPS);
            float* xr = F.out + (size_t)(m0 + r) * DM;
#pragma unroll
            for (int j = 0; j < 8; ++j) *(f32x4*)(xr + 256 * j + 4 * lane) = v[j] * rstd * gf[j];
        }
#undef P9_TI
    }
}

struct Args { const float* in[19]; float* out; unsigned char* ws; int ph_lo, ph_hi; };
constexpr int N_PHASES = 10;
__global__ void __launch_bounds__(NTHR, 2) fwd(Args args) {
    extern __shared__ __attribute__((aligned(16))) unsigned char lds_raw[];
    Frame F;
    F.lds = (LAS unsigned char*)lds_raw;
    F.wave = __builtin_amdgcn_readfirstlane((int)threadIdx.x >> 6); F.lane = lane_now(); F.tid = F.wave * 64 + F.lane; F.G = gridDim.x; F.bid = blockIdx.x; F.vcu = (F.G % 8 == 0) ? (F.bid % 8) * (F.G / 8) + F.bid / 8 : F.bid;
    unsigned char* ws = args.ws;
    F.ctl = (unsigned*)(ws + WS_CTL);
    F.x = args.in[0]; F.c = args.in[1]; F.w_ada = args.in[2]; F.b_ada = args.in[3]; F.g_mix = args.in[4]; F.w_in = args.in[5]; F.w_pool = args.in[6]; F.pool_scale = args.in[7];
    F.rel_bias = args.in[8]; F.w_out = args.in[9]; F.g_ffn = args.in[10]; F.w_group = args.in[11]; F.b_group = args.in[12]; F.w_router = args.in[13]; F.b_router = args.in[14];
    F.w_gate = args.in[15]; F.w_up = args.in[16]; F.w_down = args.in[17]; F.g_final = args.in[18];
    F.out = args.out; F.mod = (float*)(ws + WS_MOD);
    F.RW = (bf16*)(ws + WS_RW); F.WpT = (bf16*)(ws + WS_WPT); F.WinP = (bf16*)(ws + WS_WINP); F.Win = (bf16*)(ws + WS_WIN); F.Wout = (bf16*)(ws + WS_WOUT);
    F.Wgu = (bf16*)(ws + WS_WGU); F.Wd = (bf16*)(ws + WS_WD); F.H = (bf16*)(ws + WS_H); F.P = (bf16*)(ws + WS_P); F.CAT = (bf16*)(ws + WS_CAT); F.Y = (bf16*)(ws + WS_Y); F.A = (bf16*)(ws + WS_A); F.X1 = (bf16*)(ws + WS_X1);
    F.MASK = (unsigned*)(ws + WS_MASK); F.TOKLIST = (int*)(ws + WS_TOKLIST); F.TOKINFO = (unsigned*)(ws + WS_TOKINFO);
    volatile LAS unsigned* barw = (volatile LAS unsigned*)(F.lds + MISC_BASE + MO_BARW);
    if (F.tid < 4) barw[F.tid] = 0u;
    __syncthreads();
    XcdBarrier bar; bar.bar = F.ctl + CW_BAR; bar.x = 0; bar.st = nullptr; bar.wave = F.wave;
    if (MK_N_LAUNCHES == 1) bar = xcd_barrier_post(F.ctl + CW_BAR, barw, F.wave);
    const int lo = args.ph_lo, hi = args.ph_hi;
#ifndef PH_MASK
#define PH_MASK 0x3ff
#endif
#define IN(k) (((PH_MASK >> (k)) & 1) && lo <= (k) && (k) < hi && (F.lane = lane_now(), F.tid = F.wave * 64 + F.lane, true))
#define SEAM(k) do { if (MK_N_LAUNCHES == 1 && IN(k) && IN((k) + 1)) xcd_barrier(bar); } while (0)
    LAS unsigned char* ring = F.lds;

#define REP(k) for (int rep_ = 0; rep_ < ((PROBE_DUP == (k) && ((k) == 0 || (k) == 6 || (k) == 9 || (k) == 11)) ? 2 : 1); ++rep_)
#define NREP(k) ((PROBE_DUP == (k)) ? 2 : 1)
    if (IN(0)) { REP(0) { p0_prologue(F, CW_Q0 + 64 * rep_); } SEAM(0); }
    if (IN(1)) {
        REP(1) {
        { pg8::Gemm g{F.WpT, F.WinP, 256, 256, 1024, nullptr}; pg8::FoldOrder S{F.G, F.bid}; pg8::EpiBf16 E{F.Win, DM, F.pool_scale, 1.f};
          pg8::gemm_phase<pg8::EpiBf16, pg8::FoldOrder, false, true>(ring, g, S, E, F.wave); }
        REP(11) { p1_norm_rows(F, F.x, F.g_mix, 0, DM, F.H); }
        }
        SEAM(1);
    }
    if (IN(2)) {
        REP(2) {
        pg8::Gemm g{F.H, F.Win, DM, DM, DM, nullptr}; pg8::StaticOrder S; S.init(NTOK, PLD, F.G, F.bid); S.reps = NREP(2); pg8::EpiBf16 E{F.P, PLD, nullptr, 1.f};
        pg8::gemm_phase<pg8::EpiBf16, pg8::StaticOrder, false, true>(ring, g, S, E, F.wave);
        }
        p0_deferred(F);
        SEAM(2);
    }
    if (IN(3)) { if (PROBE_DUP == 3) { p3_window(F); p3_indexer(F); } if (PROBE_DUP == 33) p3_window(F); p3_window(F); p3_indexer(F); SEAM(3); }
    if (IN(4)) { p4_attention(F, PROBE_DUP == 4 ? 512 : 256); SEAM(4); }
    if (IN(5)) {
        REP(5) {
        pg8::Gemm g{F.CAT, F.Wout, DM, DM, DM, nullptr}; pg8::StaticOrder S; S.init(NTOK, DM, F.G, F.bid); S.reps = NREP(5); pg8::EpiResid E{F.x, F.X1, F.mod + 2 * DM};
        pg8::gemm_phase<pg8::EpiResid, pg8::StaticOrder, false, true>(ring, g, S, E, F.wave);
        }
        SEAM(5);
    }
    if (IN(6)) { if (PROBE_DUP == 6) { REP(6) { p6_norm_router(F, rep_ == 0); } p0_late(F); } else p6_side_by_side(F); SEAM(6); }
    if (IN(7)) {
        moe_tables(F); p7_rowtab(F, NREP(7));
        REP(7) {
        pg8::Gemm g{F.H, F.Wgu, DM / 2, DM / 2, DM / 2, (const LAS unsigned*)(F.lds + MISC_BASE + MO_ROWTAB)};
        pg8::GroupedOrder S{moe_tabs(F), 4, F.G, F.vcu, 1024, NREP(7)}; pg8::EpiGateUp E{(unsigned char*)F.A, 1.f / WGU_SCALE};
        pg8::gemm_phase<pg8::EpiGateUp, pg8::GroupedOrder, true, true, true>(ring, g, S, E, F.wave);
        }
        SEAM(7);
    }
    if (IN(8)) {
        if (MK_N_LAUNCHES != 1) moe_tables(F);
        REP(8) {
        pg8::Gemm g{F.A, F.Wd, DEXP / 2, DEXP / 2, DEXP / 2, nullptr};
        pg8::GroupedOrder S{moe_tabs(F), 8, F.G, F.vcu, DM, NREP(8)}; pg8::EpiFp8 E{(unsigned char*)F.Y, DM, Y_SCALE / WD_SCALE};
        pg8::gemm_phase<pg8::EpiFp8, pg8::GroupedOrder, false, P8_ALIGN, true>(ring, g, S, E, F.wave);
        }
        SEAM(8);
    }
    if (IN(9)) { if (MK_N_LAUNCHES != 1) moe_tables(F); REP(9) { p9_final(F); } }
#undef REP
#undef NREP
#undef IN
#undef SEAM
}

extern "C" void kernel_launch(void* const* d_in, const int* in_sizes, int n_in, void* d_out, int out_size, void* d_ws, size_t ws_size, hipStream_t stream) {
    static int grid = 0;
    if (grid == 0) {
        if (n_in != 19 || in_sizes[0] != NTOK * DM || out_size != NTOK * DM || ws_size < WS_END) {
            fprintf(stderr, "kernel_launch: unexpected shapes (n_in %d, in0 %d, out %d, ws %zu); nothing launched\n", n_in, n_in > 0 ? in_sizes[0] : -1, out_size, ws_size); grid = -1; return; }
        int dev = 0, cus = 0;
        if (hipGetDevice(&dev) != hipSuccess || hipDeviceGetAttribute(&cus, hipDeviceAttributeMultiprocessorCount, dev) != hipSuccess || cus < 128) { fprintf(stderr, "kernel_launch: device query failed or too few CUs (%d)\n", cus); grid = -1; return; }
        if (hipFuncSetAttribute((const void*)fwd, hipFuncAttributeMaxDynamicSharedMemorySize, LDS_TOTAL) != hipSuccess) { fprintf(stderr, "kernel_launch: hipFuncSetAttribute failed\n"); grid = -1; return; }
        int per_cu = 0;
        if (hipOccupancyMaxActiveBlocksPerMultiprocessor(&per_cu, (const void*)fwd, NTHR, LDS_TOTAL) != hipSuccess || per_cu < 1) fprintf(stderr, "kernel_launch: note: occupancy query reports %d blocks per CU\n", per_cu);
        (void)hipGetLastError();
        grid = cus;
    }
    if (grid < 0) return;
    if (hipMemsetAsync((char*)d_ws + WS_CTL, 0, CTL_ZERO_BYTES, stream) != hipSuccess) { fprintf(stderr, "kernel_launch: memset failed\n"); return; }
    Args a{};
    for (int i = 0; i < 19; ++i) a.in[i] = (const float*)d_in[i];
    a.out = (float*)d_out; a.ws = (unsigned char*)d_ws;
    const int nl = MK_N_LAUNCHES;
    for (int li = 0; li < nl; ++li) {
        a.ph_lo = (nl == 1) ? 0 : li; a.ph_hi = (nl == 1) ? N_PHASES : li + 1;
        hipLaunchKernelGGL(fwd, dim3(grid), dim3(NTHR), LDS_TOTAL, stream, a);
        const hipError_t le = hipPeekAtLastError();
        if (le != hipSuccess) { fprintf(stderr, "kernel_launch: launch %d failed: %s\n", li, hipGetErrorName(le)); break; }
    }
}
```

```cpp
#include <hip/hip_runtime.h>
#include <cstdio>
#include <cstdint>

#ifndef MK_N_LAUNCHES
#define MK_N_LAUNCHES 1
#endif

#ifndef P8_ALIGN
#define P8_ALIGN true
#endif
#ifndef PROBE_DUP
#define PROBE_DUP -1
#endif
#define GAS __attribute__((address_space(1)))
#define LAS __attribute__((address_space(3)))
typedef unsigned short bf16;
typedef short bf16x8 __attribute__((ext_vector_type(8)));
typedef short s16x4 __attribute__((ext_vector_type(4)));
typedef float f32x4 __attribute__((ext_vector_type(4)));
typedef float f32x2 __attribute__((ext_vector_type(2)));
typedef float f32x16 __attribute__((ext_vector_type(16)));
typedef unsigned u32x4 __attribute__((ext_vector_type(4)));
typedef unsigned u32x2 __attribute__((ext_vector_type(2)));

constexpr int DM = 2048, NB = 8, SEQ = 2048, NTOK = NB * SEQ;
constexpr int POOLW = 1024, NHEAD = 8, HD = 128, NKV = 2, IDXH = 16, IDXD = 64, TOPK = 256;
constexpr int PIN = 3664, PLD = 3840;
constexpr int C_U = 0, C_Q = 1024, C_K = 2048, C_V = 2304, C_QI = 2560, C_KI = 3584, C_WI = 3648;
constexpr int NEXP = 32, DEXP = 512, NGRP = 4, EPG = 8;
constexpr int MAXSLOT = 40960;
constexpr float EPS = 1e-6f;

constexpr size_t MiB = 1u << 20;
constexpr size_t WS_CTL = 0, CTL_ZERO_BYTES = 1 * MiB;
constexpr size_t WS_MOD = 1 * MiB;
constexpr size_t WS_RW = 1 * MiB + 512 * 1024;
constexpr size_t WS_TOKINFO = 2 * MiB;
constexpr size_t WS_TOKLIST = 3 * MiB;
constexpr size_t WS_WPT = 5 * MiB;
constexpr size_t WS_MASK = 6 * MiB;
constexpr size_t WS_WINP = 10 * MiB;
constexpr size_t WS_WIN = 16 * MiB;
constexpr size_t WS_WOUT = 32 * MiB;
constexpr size_t WS_WGU = 40 * MiB;
constexpr size_t WS_WD = 168 * MiB;
constexpr size_t WS_H = 232 * MiB;
constexpr size_t WS_P = 296 * MiB;
constexpr size_t WS_CAT = 416 * MiB;
constexpr size_t WS_Y = 296 * MiB;
constexpr size_t WS_A = 480 * MiB;
constexpr size_t WS_X1 = 520 * MiB;
constexpr size_t WS_END = 584 * MiB;
static_assert(WS_Y + (size_t)MAXSLOT * DM * 2 <= WS_A && WS_P + (size_t)NTOK * PLD * 2 <= WS_CAT && WS_A + (size_t)MAXSLOT * DEXP * 2 <= WS_X1 && WS_X1 + (size_t)NTOK * DM * 2 <= WS_END, "ws map");
constexpr int CW_TMO = 0, CW_Q0 = 64, CW_BAR = 4096, CW_ECNT = 16384;

constexpr int RING_BYTES = 131072;
constexpr int MISC_OFF = RING_BYTES;
constexpr int LDS_BYTES = 147456;
constexpr int NWAVES = 8, NTHR = 512;

#define LDS_WAIT() asm volatile("s_waitcnt lgkmcnt(0)" ::: "memory")
#define VM_WAIT() asm volatile("s_waitcnt vmcnt(0)" ::: "memory")
__device__ __forceinline__ unsigned cvt_pk_bf16(float lo, float hi) { unsigned r; asm volatile("v_cvt_pk_bf16_f32 %0, %1, %2" : "=v"(r) : "v"(lo), "v"(hi)); return r; }
__device__ __forceinline__ float bf2f(bf16 v) { return __builtin_bit_cast(float, (unsigned)v << 16); }
__device__ __forceinline__ float wave_sum(float v) {
#pragma unroll
    for (int o = 1; o < 64; o <<= 1) v += __shfl_xor(v, o);
    return v;
}

__device__ __forceinline__ int lane_now() { int l; asm volatile("v_mbcnt_lo_u32_b32 %0, -1, 0\n\tv_mbcnt_hi_u32_b32 %0, -1, %0" : "=v"(l)); return l; }
namespace pg8 {
constexpr int BM = 256, BK = 64, HALF = 128, HTB = HALF * BK * 2, STAGE_BYTES = 8 * HTB, NXCD = 8, WGM = 4;
__host__ __device__ __forceinline__ int lds_byte(int r, int c) { const int st = (r >> 4) * 2 + (c >> 5), rr = r & 15, cc = c & 31, ob = rr * 64 + cc * 2; return st * 1024 + (ob ^ (((ob >> 9) & 1) << 5)); }
__host__ __device__ __forceinline__ void stage_rc(int b, int& R, int& C) { const int st = b / 1024, sb = b % 1024, swz = sb ^ (((sb >> 9) & 1) << 5); R = (st >> 1) * 16 + swz / 64; C = (st & 1) * 32 + (swz % 64) / 2; }
__host__ __device__ __forceinline__ int perm32(int rho) { const int n = rho >> 4, i = rho & 15; return 8 * (i >> 2) + 4 * n + (i & 3); }

typedef int v4i_t __attribute__((ext_vector_type(4)));
typedef int v8i_t __attribute__((ext_vector_type(8)));
struct Unit { int pm, pn, e, ord, half; };
struct Gemm { const bf16* A; const bf16* Bt; int K, lda, ldb; const LAS unsigned* rowtab; };

struct StaticOrder {
    int nM, nN, nwg, G, c, reps;
    __device__ void init(int M, int N, int G_, int c_) { nM = M / BM; nN = N / BM; nwg = nM * nN; G = G_; c = c_; reps = 1; }
    __device__ bool next(int i, Unit& u) const {
        const long L = (long)i * G + c; if (L >= (long)nwg * reps) return false;
        int wgid = (int)(L % nwg); { const int q = nwg / NXCD, r = nwg % NXCD, xcd = wgid % NXCD, off = wgid / NXCD; wgid = (xcd < r ? xcd * (q + 1) : r * (q + 1) + (xcd - r) * q) + off; }
        const int nig = WGM * nN, gid = wgid / nig, fm = gid * WGM, gsz = (nM - fm) < WGM ? (nM - fm) : WGM;
        u.pm = fm + ((wgid % nig) % gsz); u.pn = (wgid % nig) / gsz; u.e = 0; u.ord = i; u.half = 0; return true;
    }
    __device__ __forceinline__ size_t b_off(const Unit& u, int ldb) const { return (size_t)u.pn * BM * ldb * 2; }
};
struct FoldOrder {
    int G, c;
    __device__ bool next(int i, Unit& u) const { const int L = i * G + c; if (L >= 32) return false; u.pm = L >> 3; u.pn = L & 7; u.e = 0; u.ord = i; u.half = 0; return true; }
    __device__ __forceinline__ size_t b_off(const Unit& u, int ldb) const { return ((size_t)u.pn * BM * ldb + (size_t)u.pm * 256) * 2; }
};
struct MoeTabs { const LAS int* tb; const LAS int* tf; const LAS int* hl; };
__device__ __forceinline__ bool moe_unit(const MoeTabs& T, int NT, int L, int reps, int& pm, int& pn, int& e, int& half) {
    const int nf = T.tf[NEXP], nh = T.hl[NEXP], total = (nf + nh) * NT;
    if (L >= total * reps) return false;
    L %= total;
    const int mt = L / NT; pn = L - mt * NT;
    if (mt < nf) { int x = 0; while (x < NEXP - 1 && T.tf[x + 1] <= mt) ++x; e = x; pm = T.tb[x] + (mt - T.tf[x]); half = 0; }
    else { e = T.hl[mt - nf]; pm = T.tb[e + 1] - 1; half = 1; }
    return true;
}
struct GroupedOrder {
    MoeTabs T; int NT, G, c, rows_per_e, reps;
    __device__ bool next(int i, Unit& u) const { u.ord = i; return moe_unit(T, NT, i * G + c, reps, u.pm, u.pn, u.e, u.half); }
    __device__ __forceinline__ size_t b_off(const Unit& u, int ldb) const { return ((size_t)u.e * rows_per_e + (size_t)u.pn * BM) * ldb * 2; }
};

template <class Epi, class Sched, bool GATHER, bool ALIGN_EPI, bool FP8 = false>
__device__ __forceinline__ void gemm_phase(LAS unsigned char* lds, const Gemm g, const Sched& S, const Epi& E, const int wid) {
    const int lane = lane_now(), tid = wid * 64 + lane, wr = wid >> 2, wc = wid & 3, fr = lane & 15, fq = lane >> 4;
    const int K = g.K, nt = K / BK;
    int Rr[2], Cc[2];
    unsigned voffB[2];
    unsigned cva[2][2], nva[2][2];
#pragma unroll
    for (int i = 0; i < 2; ++i) { int R, C; stage_rc(tid * 16 + i * 8192, R, C); Rr[i] = R; Cc[i] = C; const int Rb = Epi::PERM ? ((R & ~31) + perm32(R & 31)) : R;
        voffB[i] = (unsigned)(Rb * g.ldb + C) * 2u; }
    const size_t kstep = (size_t)(BK * 2);
    const unsigned hstepA = (unsigned)HALF * g.lda * 2u;
    const size_t hstepB = (size_t)HALF * g.ldb * 2;
    const unsigned ldsw = (unsigned)wid * 1024u;
    const int aoff = lds_byte(wr * 64 + fr, fq * 8), boff = lds_byte(wc * 32 + fr, fq * 8);
#define PG8_SA(b, h) (((b) * 2 + (h)) * HTB)
#define PG8_SB(b, h) ((4 + (b) * 2 + (h)) * HTB)
#define PG8_STAGE(bufoff, gbase, v0, v1) do { \
        __builtin_amdgcn_global_load_lds((const unsigned*)((const char*)(gbase) + (v0)), (LAS unsigned*)(lds + (bufoff) + ldsw), 16, 0, 0); \
        __builtin_amdgcn_global_load_lds((const unsigned*)((const char*)(gbase) + (v1)), (LAS unsigned*)(lds + (bufoff) + ldsw + 8192), 16, 0, 0); } while (0)
#define PG8_STAGE_B(bufoff, gbase) PG8_STAGE(bufoff, gbase, voffB[0], voffB[1])
#define PG8_LD8(base) __builtin_shufflevector(*(const LAS v4i_t*)(base), *(const LAS v4i_t*)((base) + 1024), 0, 1, 2, 3, 4, 5, 6, 7)
#define PG8_LDA(dst, b, h) do { _Pragma("unroll") for (int m = 0; m < 4; ++m) dst[m] = PG8_LD8(lds + PG8_SA(b, h) + aoff + m * 2048); } while (0)
#define PG8_LDB(dst, b, h) do { _Pragma("unroll") for (int n = 0; n < 2; ++n) dst[n] = PG8_LD8(lds + PG8_SB(b, h) + boff + n * 2048); } while (0)
#define PG8_LO(x) __builtin_bit_cast(bf16x8, __builtin_shufflevector((x), (x), 0, 1, 2, 3))
#define PG8_HI(x) __builtin_bit_cast(bf16x8, __builtin_shufflevector((x), (x), 4, 5, 6, 7))
#define PG8_MMA(ai, bj, At, Bt) do { __builtin_amdgcn_s_setprio(1); _Pragma("unroll") for (int m = 0; m < 4; ++m) _Pragma("unroll") for (int n = 0; n < 2; ++n) { \
        if constexpr (FP8) asm volatile("v_mfma_scale_f32_16x16x128_f8f6f4 %0, %1, %2, %0, %3, %3 op_sel_hi:[0,0,0]" : "+v"(acc[ai][bj][m][n]) : "v"(Bt[n]), "v"(At[m]), "v"(sc8));   \
        else { acc[ai][bj][m][n] = __builtin_amdgcn_mfma_f32_16x16x32_bf16(PG8_LO(Bt[n]), PG8_LO(At[m]), acc[ai][bj][m][n], 0, 0, 0); \
               acc[ai][bj][m][n] = __builtin_amdgcn_mfma_f32_16x16x32_bf16(PG8_HI(Bt[n]), PG8_HI(At[m]), acc[ai][bj][m][n], 0, 0, 0); } } \
        __builtin_amdgcn_s_setprio(0); } while (0)
#define PG8_WAIT_V(n) asm volatile("s_waitcnt vmcnt(" #n ")" ::: "memory")
#define PG8_WAIT_L(n) asm volatile("s_waitcnt lgkmcnt(" #n ")" ::: "memory")
#define PG8_BAR __builtin_amdgcn_s_barrier()
#define PG8_SCHED __builtin_amdgcn_sched_barrier(0)
#define PG8_AOFF(dst, u) do { _Pragma("unroll") for (int h_ = 0; h_ < 2; ++h_) _Pragma("unroll") for (int i_ = 0; i_ < 2; ++i_) { \
        if constexpr (GATHER) dst[h_][i_] = g.rowtab[(u).ord * 256 + h_ * HALF + Rr[i_]] + (unsigned)Cc[i_] * 2u; \
        else dst[h_][i_] = (unsigned)(Rr[i_] * g.lda + Cc[i_]) * 2u + (unsigned)h_ * hstepA; } } while (0)
    Unit cur, nxt; int ui = 0;
    if (!S.next(0, cur)) return;
    const int sc8 = 0x7f7f7f7f;
    f32x4 acc[2][2][4][2];
#pragma unroll
    for (int a = 0; a < 2; ++a)
#pragma unroll
        for (int b = 0; b < 2; ++b)
#pragma unroll
            for (int m = 0; m < 4; ++m)
#pragma unroll
                for (int n = 0; n < 2; ++n) acc[a][b][m][n] = (f32x4){0.f, 0.f, 0.f, 0.f};
    v8i_t At[4], B0[2], B1[2];
    const size_t tstepA = (size_t)BM * g.lda * 2;
    const char* cA = GATHER ? (const char*)g.A : (const char*)g.A + (size_t)cur.pm * tstepA;
    const char* cB = (const char*)g.Bt + S.b_off(cur, g.ldb);
    PG8_AOFF(cva, cur);
#pragma unroll
    for (int h_ = 0; h_ < 2; ++h_)
#pragma unroll
        for (int i_ = 0; i_ < 2; ++i_) nva[h_][i_] = cva[h_][i_];
    if constexpr (GATHER) { LDS_WAIT(); }
    PG8_STAGE_B(PG8_SB(0, 0), cB); PG8_STAGE_B(PG8_SB(0, 1), cB + hstepB); PG8_STAGE(PG8_SA(0, 0), cA, cva[0][0], cva[0][1]); PG8_STAGE(PG8_SA(0, 1), cA, cva[1][0], cva[1][1]);
    if (wr == 1) PG8_BAR;
    PG8_WAIT_V(2); PG8_BAR;
    PG8_STAGE_B(PG8_SB(1, 0), cB + kstep); PG8_STAGE(PG8_SA(1, 0), cA + kstep, cva[0][0], cva[0][1]); PG8_STAGE_B(PG8_SB(1, 1), cB + hstepB + kstep);
    PG8_WAIT_V(6); PG8_BAR;
    for (;;) {
        const bool has_next = S.next(ui + 1, nxt);
        const bool full = (cur.half == 0);
        const char* nA = GATHER ? cA : (has_next ? (const char*)g.A + (size_t)nxt.pm * tstepA : cA);
        const char* nB = has_next ? (const char*)g.Bt + S.b_off(nxt, g.ldb) : cB;
#pragma nounroll
        for (int t = 0; t < nt; t += 2) {
            const bool last = (t == nt - 2);
            const char* a1 = cA + (size_t)(t + 1) * kstep;
            const char* a2 = last ? nA : cA + (size_t)(t + 2) * kstep; const char* b2 = last ? nB : cB + (size_t)(t + 2) * kstep;
            const char* a3 = a2 + kstep; const char* b3 = b2 + kstep;
            if (last) { if (has_next) { PG8_AOFF(nva, nxt); } else {
#pragma unroll
                for (int h_ = 0; h_ < 2; ++h_)
#pragma unroll
                    for (int i_ = 0; i_ < 2; ++i_) nva[h_][i_] = cva[h_][i_]; }
                if constexpr (GATHER) { LDS_WAIT(); } }
            unsigned v2[2][2];
#pragma unroll
            for (int h_ = 0; h_ < 2; ++h_)
#pragma unroll
                for (int i_ = 0; i_ < 2; ++i_) v2[h_][i_] = last ? nva[h_][i_] : cva[h_][i_];
            PG8_LDB(B0, 0, 0); PG8_LDB(B1, 0, 1); PG8_SCHED; PG8_LDA(At, 0, 0); PG8_STAGE(PG8_SA(1, 1), a1, cva[1][0], cva[1][1]);
            PG8_WAIT_V(8); PG8_WAIT_L(0); PG8_BAR; PG8_MMA(0, 0, At, B0); PG8_MMA(0, 1, At, B1); PG8_BAR; PG8_SCHED;
            PG8_LDA(At, 0, 1); PG8_STAGE_B(PG8_SB(0, 0), b2); PG8_STAGE_B(PG8_SB(0, 1), b2 + hstepB); PG8_STAGE(PG8_SA(0, 0), a2, v2[0][0], v2[0][1]);
            PG8_WAIT_V(8); PG8_WAIT_L(0); PG8_BAR; if (full) { PG8_MMA(1, 0, At, B0); PG8_MMA(1, 1, At, B1); } PG8_BAR; PG8_SCHED;
            PG8_LDB(B0, 1, 0); PG8_LDB(B1, 1, 1); PG8_SCHED; PG8_LDA(At, 1, 0); PG8_STAGE(PG8_SA(0, 1), a2, v2[1][0], v2[1][1]);
            PG8_WAIT_V(8); PG8_WAIT_L(0); PG8_BAR; PG8_MMA(0, 0, At, B0); PG8_MMA(0, 1, At, B1); PG8_BAR; PG8_SCHED;
            PG8_LDA(At, 1, 1); PG8_STAGE_B(PG8_SB(1, 0), b3); PG8_STAGE_B(PG8_SB(1, 1), b3 + hstepB); PG8_STAGE(PG8_SA(1, 0), a3, v2[0][0], v2[0][1]);
            PG8_WAIT_V(8); PG8_WAIT_L(0); PG8_BAR; if (full) { PG8_MMA(1, 0, At, B0); PG8_MMA(1, 1, At, B1); } PG8_BAR; PG8_SCHED;
        }
        if constexpr (FP8) asm volatile("s_nop 15\n\ts_nop 15" ::: "memory");
        if constexpr (ALIGN_EPI) { if (wr == 0) PG8_BAR; }
        E(acc, cur, wr, wc, fr, fq);
        if (!has_next) break;
#pragma unroll
        for (int a = 0; a < 2; ++a)
#pragma unroll
            for (int b = 0; b < 2; ++b)
#pragma unroll
                for (int m = 0; m < 4; ++m)
#pragma unroll
                    for (int n = 0; n < 2; ++n) acc[a][b][m][n] = (f32x4){0.f, 0.f, 0.f, 0.f};
        cur = nxt; cA = nA; cB = nB; ++ui;
#pragma unroll
        for (int h_ = 0; h_ < 2; ++h_)
#pragma unroll
            for (int i_ = 0; i_ < 2; ++i_) cva[h_][i_] = nva[h_][i_];
        if constexpr (ALIGN_EPI) { if (wr == 1) PG8_BAR; }
    }
    PG8_WAIT_V(0);
    if constexpr (!ALIGN_EPI) { if (wr == 0) PG8_BAR; }
    PG8_BAR;
#undef PG8_SA
#undef PG8_SB
#undef PG8_STAGE
#undef PG8_STAGE_B
#undef PG8_LDA
#undef PG8_LDB
#undef PG8_MMA
#undef PG8_LD8
#undef PG8_LO
#undef PG8_HI
#undef PG8_WAIT_V
#undef PG8_WAIT_L
#undef PG8_BAR
#undef PG8_SCHED
#undef PG8_AOFF
}

struct EpiBf16 {
    static constexpr bool PERM = true;
    bf16* O; int ldc; const float* rowscale; float oscale;
    __device__ __forceinline__ void operator()(const f32x4 (&acc)[2][2][4][2], const Unit& u, int wr, int wc, int fr, int fq) const {
        const int row0 = u.pm * BM + wr * 64 + fr, col0 = u.pn * BM + wc * 32 + 8 * fq;
#pragma unroll
        for (int ai = 0; ai < 2; ++ai)
#pragma unroll
            for (int m = 0; m < 4; ++m) { const int row = row0 + ai * HALF + m * 16; bf16* rowp = O + (size_t)row * ldc + col0; const float s = rowscale ? rowscale[row] * oscale : oscale;
#pragma unroll
                for (int bj = 0; bj < 2; ++bj) { const f32x4 v0 = acc[ai][bj][m][0] * s, v1 = acc[ai][bj][m][1] * s;
                    u32x4 w; w.x = cvt_pk_bf16(v0[0], v0[1]); w.y = cvt_pk_bf16(v0[2], v0[3]); w.z = cvt_pk_bf16(v1[0], v1[1]); w.w = cvt_pk_bf16(v1[2], v1[3]);
                    *(u32x4*)(rowp + bj * HALF) = w; } }
    }
};
struct EpiFp8 {
    static constexpr bool PERM = true;
    unsigned char* O; int ldc; float oscale;
    __device__ __forceinline__ void operator()(const f32x4 (&acc)[2][2][4][2], const Unit& u, int wr, int wc, int fr, int fq) const {
        const int row0 = u.pm * BM + wr * 64 + fr, col0 = u.pn * BM + wc * 32 + 8 * fq;
#pragma unroll
        for (int ai = 0; ai < 2; ++ai)
#pragma unroll
            for (int m = 0; m < 4; ++m) { unsigned char* rowp = O + (size_t)(row0 + ai * HALF + m * 16) * ldc + col0;
#pragma unroll
                for (int bj = 0; bj < 2; ++bj) { const f32x4 v0 = acc[ai][bj][m][0] * oscale, v1 = acc[ai][bj][m][1] * oscale; u32x2 w;
                    { int p = __builtin_amdgcn_cvt_pk_fp8_f32(v0[0], v0[1], 0, false); p = __builtin_amdgcn_cvt_pk_fp8_f32(v0[2], v0[3], p, true); w.x = (unsigned)p; }
                    { int p = __builtin_amdgcn_cvt_pk_fp8_f32(v1[0], v1[1], 0, false); p = __builtin_amdgcn_cvt_pk_fp8_f32(v1[2], v1[3], p, true); w.y = (unsigned)p; }
                    *(u32x2*)(rowp + bj * HALF) = w; } }
    }
};
struct EpiResid {
    static constexpr bool PERM = true;
    const float* X; bf16* X1; const float* gate;
    __device__ __forceinline__ void operator()(const f32x4 (&acc)[2][2][4][2], const Unit& u, int wr, int wc, int fr, int fq) const {
        const int row0 = u.pm * BM + wr * 64 + fr, col0 = u.pn * BM + wc * 32 + 8 * fq;
        const float* gp = gate + (size_t)((u.pm * BM) / SEQ) * (6 * DM) + col0;
        f32x4 gv[2][2];
#pragma unroll
        for (int bj = 0; bj < 2; ++bj)
#pragma unroll
            for (int n = 0; n < 2; ++n) gv[bj][n] = *(const f32x4*)(gp + bj * HALF + n * 4);
#pragma unroll
        for (int ai = 0; ai < 2; ++ai) {
            f32x4 xv[4][2][2];
#pragma unroll
            for (int m = 0; m < 4; ++m) { const size_t ro = (size_t)(row0 + ai * HALF + m * 16) * DM + col0;
#pragma unroll
                for (int bj = 0; bj < 2; ++bj) { xv[m][bj][0] = *(const f32x4*)(X + ro + bj * HALF); xv[m][bj][1] = *(const f32x4*)(X + ro + bj * HALF + 4); } }
#pragma unroll
            for (int m = 0; m < 4; ++m) { const size_t ro = (size_t)(row0 + ai * HALF + m * 16) * DM + col0;
#pragma unroll
                for (int bj = 0; bj < 2; ++bj) {
                    const f32x4 v0 = xv[m][bj][0] + gv[bj][0] * acc[ai][bj][m][0], v1 = xv[m][bj][1] + gv[bj][1] * acc[ai][bj][m][1];
                    u32x4 w; w.x = cvt_pk_bf16(v0[0], v0[1]); w.y = cvt_pk_bf16(v0[2], v0[3]); w.z = cvt_pk_bf16(v1[0], v1[1]); w.w = cvt_pk_bf16(v1[2], v1[3]);
                    *(u32x4*)(X1 + ro + bj * HALF) = w; } }
        }
    }
};
struct EpiGateUp {
    static constexpr bool PERM = true;
    unsigned char* O; float isc;
    __device__ __forceinline__ void operator()(const f32x4 (&acc)[2][2][4][2], const Unit& u, int wr, int wc, int fr, int fq) const {
        const int row0 = u.pm * BM + wr * 64 + fr, col0 = u.pn * HALF + wc * 32 + 8 * fq;
#pragma unroll
        for (int ai = 0; ai < 2; ++ai)
#pragma unroll
            for (int m = 0; m < 4; ++m) { unsigned char* rowp = O + (size_t)(row0 + ai * HALF + m * 16) * DEXP + col0; float r[8];
#pragma unroll
                for (int n = 0; n < 2; ++n)
#pragma unroll
                    for (int j = 0; j < 4; ++j) { const float gt = acc[ai][0][m][n][j] * isc, up = acc[ai][1][m][n][j] * isc;
                        r[n * 4 + j] = gt * __builtin_amdgcn_rcpf(1.f + __builtin_amdgcn_exp2f(-1.4426950408889634f * gt)) * up; }
                u32x2 w; { int p = __builtin_amdgcn_cvt_pk_fp8_f32(r[0], r[1], 0, false); p = __builtin_amdgcn_cvt_pk_fp8_f32(r[2], r[3], p, true); w.x = (unsigned)p; }
                { int p = __builtin_amdgcn_cvt_pk_fp8_f32(r[4], r[5], 0, false); p = __builtin_amdgcn_cvt_pk_fp8_f32(r[6], r[7], p, true); w.y = (unsigned)p; }
                *(u32x2*)rowp = w; }
    }
};
}

constexpr int MISC_BASE = 139264;
constexpr int LDS_TOTAL = 159744;
constexpr int MO_BARW = 0;
constexpr int MO_TB = 256;
constexpr int MO_CNT = 768;
constexpr int MO_ROWTAB = 1024;
constexpr int MO_BIAS = 10240;
constexpr int MAXU = 8;
static_assert(MISC_BASE + MO_BIAS + 304 * 4 <= LDS_TOTAL, "lds map");

#define XB_TMO      128
#define XB_XCNT(j)  (256  + 64 * (j))
#define XB_XSUB(j)  (1280 + 64 * (j))
#define XB_XGEN(j)  (2304 + 64 * (j))
#define XB_TOP      3328
#define XB_TOPGEN   3392
#define XCD_BAR_WORDS 3456
#define XB_SPIN_CAP (1u << 18)
__device__ __forceinline__ unsigned xb_ld(unsigned* p)              { return __hip_atomic_load(p, __ATOMIC_RELAXED, __HIP_MEMORY_SCOPE_AGENT); }
__device__ __forceinline__ unsigned xb_add(unsigned* p, unsigned v) { return __hip_atomic_fetch_add(p, v, __ATOMIC_RELAXED, __HIP_MEMORY_SCOPE_AGENT); }
__device__ __forceinline__ unsigned xb_xcc_id() { return (unsigned)__builtin_amdgcn_s_getreg((3 << 11) | 20) & 0xFu; }
#define XB_SPIN(cond, bar) do { unsigned _sp = 0; while (cond) { __builtin_amdgcn_s_sleep(1); \
    if ((++_sp & 255u) == 0u) { if (xb_ld(&(bar)[XB_TMO])) break; if (_sp > XB_SPIN_CAP) { atomicAdd(&(bar)[XB_TMO], 1u); break; } } } } while (0)
struct XcdBarrier { unsigned* bar; unsigned x; volatile LAS unsigned* st; int wave; };
__device__ __forceinline__ XcdBarrier xcd_barrier_post(unsigned* bar, volatile LAS unsigned* st, int wave) {
    XcdBarrier b; b.bar = bar; b.x = xb_xcc_id(); b.st = st; b.wave = wave;
    if (wave == 0 && lane_now() == 0) (void)xb_add(&bar[XB_XCNT(b.x)], 1u);
    return b;
}
__device__ __forceinline__ void xcd_barrier_complete(unsigned* bar, unsigned x, unsigned& nloc, unsigned& nx) {
    const unsigned G = gridDim.x * gridDim.y * gridDim.z;
    unsigned sum, cnt, mine, sp = 0u;
    for (;;) {
        sum = 0u; cnt = 0u; mine = 0u;
#pragma unroll
        for (unsigned j = 0; j < 16; ++j) { const unsigned c = xb_ld(&bar[XB_XCNT(j)]); sum += c; cnt += (c > 0u) ? 1u : 0u; mine = (j == x) ? c : mine; }
        if (sum == G) break;
        __builtin_amdgcn_s_sleep(1);
        if ((++sp & 255u) == 0u) { if (xb_ld(&bar[XB_TMO])) break; if (sp > XB_SPIN_CAP) { atomicAdd(&bar[XB_TMO], 1u); break; } }
    }
    nloc = mine > 0u ? mine : 1u; nx = cnt > 0u ? cnt : 1u;
}
__device__ __forceinline__ void xcd_barrier(const XcdBarrier& b) {
    asm volatile("s_waitcnt vmcnt(0)" ::: "memory");
    __syncthreads();
    if (b.wave == 0 && lane_now() == 0) {
        unsigned* bar = b.bar;
        __builtin_amdgcn_s_waitcnt(0);
        unsigned nloc = b.st[0], nx = b.st[1];
        if (nloc == 0u) { xcd_barrier_complete(bar, b.x, nloc, nx); b.st[0] = nloc; b.st[1] = nx; }
        const unsigned old = xb_add(&bar[XB_XSUB(b.x)], 1u);
        const unsigned gen = old / nloc;
        if (old + 1u == (gen + 1u) * nloc) {
            __builtin_amdgcn_fence(__ATOMIC_RELEASE, "agent");
            asm volatile("s_waitcnt vmcnt(0)" ::: "memory");
            const unsigned og = xb_add(&bar[XB_TOP], 1u);
            const unsigned tg = og / nx;
            if (og + 1u == (tg + 1u) * nx) xb_add(&bar[XB_TOPGEN], 1u);
            else XB_SPIN(xb_ld(&bar[XB_TOPGEN]) == tg, bar);
            __builtin_amdgcn_fence(__ATOMIC_ACQUIRE, "agent");
            xb_add(&bar[XB_XGEN(b.x)], 1u);
            asm volatile("s_waitcnt vmcnt(0)" ::: "memory");
        } else {
            XB_SPIN(xb_ld(&bar[XB_XGEN(b.x)]) == gen, bar);
            __builtin_amdgcn_fence(__ATOMIC_ACQUIRE, "agent");
            asm volatile("s_waitcnt vmcnt(0)" ::: "memory");
        }
    }
    __syncthreads();
}

struct Frame {
    LAS unsigned char* lds;
    unsigned* ctl;
    int tid, lane, wave, G, bid, vcu;
    const float *x, *c, *w_ada, *b_ada, *g_mix, *w_in, *w_pool, *pool_scale, *rel_bias, *w_out, *g_ffn, *w_group, *b_group, *w_router, *b_router, *w_gate, *w_up, *w_down, *g_final;
    float* out; float* mod;
    bf16 *RW, *WpT, *WinP, *Win, *Wout, *Wgu, *Wd, *H, *P, *CAT, *Y, *A, *X1;
    unsigned* MASK; int* TOKLIST; unsigned* TOKINFO;
};

constexpr float Y_SCALE = 8.f;
constexpr float WD_SCALE = 16.f;
constexpr float WGU_SCALE = 32.f;
__device__ __forceinline__ unsigned pk4_fp8(float a, float b, float c, float d) { int p = __builtin_amdgcn_cvt_pk_fp8_f32(a, b, 0, false); p = __builtin_amdgcn_cvt_pk_fp8_f32(c, d, p, true); return (unsigned)p; }
struct P0Tile { const float* src; unsigned char* dst; int ld_src, k0, n0, nvalid, ld_dst, himul, radd, fp8; float scale; };
constexpr int P0_R0 = 32 * 44, P0_R1 = 32 * 32, P0_R2 = 32 * 256, P0_R5 = 64, P0_R6 = 512, P0_R7 = 32;
constexpr int P0_TILES = P0_R0 + P0_R1 + 3 * P0_R2 + P0_R5;
constexpr int P0_ITEMS = P0_TILES + P0_R6 + P0_R7;
constexpr int P0_OFF_START = P0_R0 + P0_R1 + 2 * P0_R2 + 24 * 256, P0_OFF_LEN = 8 * 256;
__device__ __forceinline__ P0Tile p0_decode(Frame& F, int it) {
    P0Tile t; t.fp8 = 0; t.scale = 1.f; t.himul = 128; t.radd = 0;
    if (it < P0_R0) { const int kb = it / 44, nb = it % 44; t.src = F.w_in; t.ld_src = PIN; t.k0 = 64 * kb; t.n0 = 1024 + 64 * nb; t.nvalid = PIN; t.dst = (unsigned char*)F.Win; t.ld_dst = DM * 2; return t; } it -= P0_R0;
    if (it < P0_R1) { const int kb = it >> 5, nb = it & 31; t.src = F.w_out; t.ld_src = DM; t.k0 = 64 * kb; t.n0 = 64 * nb; t.nvalid = DM; t.dst = (unsigned char*)F.Wout; t.ld_dst = DM * 2; return t; } it -= P0_R1;
    if (it < 2 * P0_R2) { const int up = it >= P0_R2; if (up) it -= P0_R2; const int e = it >> 8, r = it & 255, kb = r >> 3, nb = r & 7;
        t.src = (up ? F.w_up : F.w_gate) + (size_t)e * DM * DEXP; t.ld_src = DEXP; t.k0 = 64 * kb; t.n0 = 64 * nb; t.nvalid = DEXP; t.dst = (unsigned char*)F.Wgu + (size_t)e * 1024 * DM; t.ld_dst = DM;
        t.himul = 256; t.radd = up ? 128 : 0; t.fp8 = 1; t.scale = WGU_SCALE; return t; } it -= 2 * P0_R2;
    if (it < P0_R2) { const int e = it >> 8, r = it & 255, kb = r >> 5, nb = r & 31;
        t.src = F.w_down + (size_t)e * DEXP * DM; t.ld_src = DM; t.k0 = 64 * kb; t.n0 = 64 * nb; t.nvalid = DM; t.dst = (unsigned char*)F.Wd + (size_t)e * DM * DEXP; t.ld_dst = DEXP; t.fp8 = 1; t.scale = WD_SCALE; return t; } it -= P0_R2;
    { const int g = it >> 4, r = it & 15, kb = r >> 2, nb = r & 3; t.src = F.w_pool + (size_t)g * 65536; t.ld_src = 256; t.k0 = 64 * kb; t.n0 = 64 * nb; t.nvalid = 256; t.dst = (unsigned char*)(F.WpT + (size_t)g * 65536); t.ld_dst = 512; return t; }
}
__device__ __forceinline__ void p0_tile_load(const P0Tile& t, f32x4 (&v)[16], int lane) {
    const int nn = (lane & 15) * 4, kr = lane >> 4;
#pragma unroll
    for (int i = 0; i < 16; ++i) { v[i] = (f32x4){0.f, 0.f, 0.f, 0.f}; if (t.n0 + nn < t.nvalid) v[i] = *(const f32x4*)(t.src + (size_t)(t.k0 + 16 * kr + i) * t.ld_src + t.n0 + nn); }
}
__device__ __forceinline__ void p0_tile_pack(const P0Tile& t, const f32x4 (&v)[16], u32x4 (&o)[8]) {
    if (t.fp8) {
        const float sc = t.scale;
#pragma unroll
        for (int j = 0; j < 4; ++j) { u32x4 p; p.x = pk4_fp8(v[0][j] * sc, v[1][j] * sc, v[2][j] * sc, v[3][j] * sc); p.y = pk4_fp8(v[4][j] * sc, v[5][j] * sc, v[6][j] * sc, v[7][j] * sc);
            p.z = pk4_fp8(v[8][j] * sc, v[9][j] * sc, v[10][j] * sc, v[11][j] * sc); p.w = pk4_fp8(v[12][j] * sc, v[13][j] * sc, v[14][j] * sc, v[15][j] * sc); o[2 * j] = p; o[2 * j + 1] = p; }
    } else {
#pragma unroll
        for (int j = 0; j < 4; ++j) {
            o[2 * j].x = cvt_pk_bf16(v[0][j], v[1][j]); o[2 * j].y = cvt_pk_bf16(v[2][j], v[3][j]); o[2 * j].z = cvt_pk_bf16(v[4][j], v[5][j]); o[2 * j].w = cvt_pk_bf16(v[6][j], v[7][j]);
            o[2 * j + 1].x = cvt_pk_bf16(v[8][j], v[9][j]); o[2 * j + 1].y = cvt_pk_bf16(v[10][j], v[11][j]); o[2 * j + 1].z = cvt_pk_bf16(v[12][j], v[13][j]); o[2 * j + 1].w = cvt_pk_bf16(v[14][j], v[15][j]); }
    }
}
__device__ __forceinline__ void p0_tile_store(const P0Tile& t, const u32x4 (&o)[8], int lane) {
    const int nn = (lane & 15) * 4, kr = lane >> 4;
#pragma unroll
    for (int j = 0; j < 4; ++j) { const int ng = t.n0 + nn + j, row = (ng >> 7) * t.himul + (ng & 127) + t.radd;
        unsigned char* d = t.dst + (size_t)row * t.ld_dst;
        const int ko = (t.k0 + 16 * kr) << (t.fp8 ? 0 : 1);
        *(u32x4*)(d + ko) = o[2 * j];
        if (!t.fp8) *(u32x4*)(d + ko + 16) = o[2 * j + 1]; }
}
__device__ __forceinline__ void p0_small_item(Frame& F, int it) {
    const int lane = F.lane;
    if (it < P0_R6) {
        f32x4 v[4][4];
#pragma unroll
        for (int rr = 0; rr < 4; ++rr)
#pragma unroll
            for (int j = 0; j < 4; ++j) v[rr][j] = *(const f32x4*)(F.w_in + (size_t)(it * 4 + rr) * PIN + j * 256 + lane * 4);
#pragma unroll
        for (int rr = 0; rr < 4; ++rr)
#pragma unroll
            for (int j = 0; j < 4; ++j) { u32x2 o; o.x = cvt_pk_bf16(v[rr][j][0], v[rr][j][1]); o.y = cvt_pk_bf16(v[rr][j][2], v[rr][j][3]);
                *(u32x2*)(F.WinP + (size_t)(it * 4 + rr) * 1024 + j * 256 + lane * 4) = o; }
        return; } it -= P0_R6;
    {
        const int k = it * 64 + lane;
        const f32x4 g = *(const f32x4*)(F.w_group + (size_t)k * 4);
        f32x4 r[8];
#pragma unroll
        for (int q = 0; q < 8; ++q) r[q] = *(const f32x4*)(F.w_router + (size_t)k * 32 + 4 * q);
#pragma unroll
        for (int j = 0; j < 48; ++j) { float v = 0.f; if (j < 4) v = g[j]; else if (j < 36) v = r[(j - 4) >> 2][(j - 4) & 3];
            F.RW[(size_t)j * DM + k] = (bf16)(cvt_pk_bf16(v, 0.f) & 0xffffu); }
    }
}
__device__ __forceinline__ void p0_mod_item(Frame& F, int m) {
    LAS float* sil = (LAS float*)F.lds;
    LAS float* part = (LAS float*)(F.lds + 65536);
    { float cv[NB * DM / NTHR];
#pragma unroll
      for (int q = 0; q < NB * DM / NTHR; ++q) cv[q] = F.c[F.tid + q * NTHR];
#pragma unroll
      for (int q = 0; q < NB * DM / NTHR; ++q) sil[F.tid + q * NTHR] = cv[q] / (1.f + __expf(-cv[q])); }
    __syncthreads();
    const int lane = F.lane, cq = lane & 15, rs = lane >> 4, j0 = 64 * m + 4 * cq;
    f32x4 acc[NB];
#pragma unroll
    for (int b = 0; b < NB; ++b) acc[b] = (f32x4){0.f, 0.f, 0.f, 0.f};
#pragma unroll 1
    for (int i0 = 0; i0 < 64; i0 += 16) {
        f32x4 w[16];
#pragma unroll
        for (int u = 0; u < 16; ++u) w[u] = *(const f32x4*)(F.w_ada + (size_t)(256 * F.wave + 4 * (i0 + u) + rs) * (6 * DM) + j0);
        __builtin_amdgcn_sched_barrier(0);
#pragma unroll
        for (int u = 0; u < 16; ++u) { const int k = 256 * F.wave + 4 * (i0 + u) + rs;
#pragma unroll
            for (int b = 0; b < NB; ++b) acc[b] += w[u] * sil[b * DM + k];
            if ((u & 1) == 1) __builtin_amdgcn_sched_barrier(0); }
    }
#pragma unroll
    for (int b = 0; b < NB; ++b)
#pragma unroll
        for (int j = 0; j < 4; ++j) { float v = acc[b][j]; v += __shfl_xor(v, 16); v += __shfl_xor(v, 32); acc[b][j] = v; }
    if (rs == 0) {
#pragma unroll
        for (int b = 0; b < NB; ++b) *(LAS f32x4*)(part + (F.wave * NB + b) * 64 + 4 * cq) = acc[b]; }
    __syncthreads();
    { const int b = F.tid >> 6, col = F.tid & 63; float s = F.b_ada[64 * m + col];
#pragma unroll
        for (int w = 0; w < NWAVES; ++w) s += part[(w * NB + b) * 64 + col];
        F.mod[(size_t)b * (6 * DM) + 64 * m + col] = s; }
    __syncthreads();
}
__device__ __forceinline__ void p0_run(Frame& F, int r, int stride, int a0, int lenA, int b0, int lenB) {
    const int total = lenA + lenB;
#define P0_MAP(d) ((d) < lenA ? a0 + (d) : b0 + ((d) - lenA))
    f32x4 v[16]; u32x4 o[8]; bool loaded = false; P0Tile cur, nxt;
    if (r < total && P0_MAP(r) < P0_TILES) { cur = p0_decode(F, P0_MAP(r)); p0_tile_load(cur, v, F.lane); loaded = true; }
    for (int d = r; d < total; d += stride) {
        const int it = P0_MAP(d);
        if (it < P0_TILES) {
            if (!loaded) { cur = p0_decode(F, it); p0_tile_load(cur, v, F.lane); }
            p0_tile_pack(cur, v, o);
            const int dn = d + stride; loaded = false;
            if (dn < total && P0_MAP(dn) < P0_TILES) { nxt = p0_decode(F, P0_MAP(dn)); p0_tile_load(nxt, v, F.lane); loaded = true; }
            p0_tile_store(cur, o, F.lane);
            cur = nxt;
        } else p0_small_item(F, it - P0_TILES);
    }
#undef P0_MAP
}
constexpr int P0_EARLY_A = P0_R0 + P0_R1, P0_EARLY_B0 = P0_R0 + P0_R1 + 3 * P0_R2, P0_EARLY_BLEN = P0_ITEMS - P0_EARLY_B0;
__device__ __forceinline__ void p0_prologue(Frame& F, int qword) {
    (void)qword;
    __syncthreads();
    for (int m = F.bid; m < 192; m += F.G) p0_mod_item(F, m);
    const int gw = F.bid * NWAVES + F.wave;
    const int r = (F.G == 256) ? ((F.bid >= 192) ? gw - 192 * NWAVES : gw + 64 * NWAVES) : gw;
    p0_run(F, r, F.G * NWAVES, 0, P0_EARLY_A, P0_EARLY_B0, P0_EARLY_BLEN);
}
__device__ __forceinline__ void p0_late(Frame& F) {
    __syncthreads();
    const int end = (F.G == 256) ? P0_OFF_START : P0_EARLY_B0;
    p0_run(F, F.bid * NWAVES + F.wave, F.G * NWAVES, P0_EARLY_A + P0_R2, end - P0_EARLY_A - P0_R2, 0, 0);
}
__device__ __forceinline__ void p0_deferred(Frame& F) {
    if (F.G != 256 || F.bid < 192) return;
    f32x4 v[16]; u32x4 o[8]; P0Tile cur, nxt; const int w0 = (F.bid - 192) * NWAVES + F.wave;
    cur = p0_decode(F, P0_OFF_START + w0); p0_tile_load(cur, v, F.lane);
    for (int j = w0; j < P0_OFF_LEN; j += 64 * NWAVES) {
        p0_tile_pack(cur, v, o);
        if (j + 64 * NWAVES < P0_OFF_LEN) { nxt = p0_decode(F, P0_OFF_START + j + 64 * NWAVES); p0_tile_load(nxt, v, F.lane); }
        p0_tile_store(cur, o, F.lane);
        cur = nxt;
    }
}

__device__ __forceinline__ void p1_norm_rows(Frame& F, const float* xin, const float* gvec, int sh_off, int sc_off, bf16* hout) {
    const int gw = F.bid * NWAVES + F.wave, NGW = F.G * NWAVES, lane = F.lane;
    for (int grp = gw; grp < NTOK / 8; grp += NGW) {
        const int m0 = grp * 8, b = m0 / SEQ;
        const float* modb = F.mod + (size_t)b * (6 * DM);
        f32x4 gs[8], sh[8];
#pragma unroll
        for (int j = 0; j < 8; ++j) { const int col = 256 * j + 4 * lane; const f32x4 g = *(const f32x4*)(gvec + col), sc = *(const f32x4*)(modb + sc_off + col);
            gs[j] = g * (sc + 1.f); sh[j] = *(const f32x4*)(modb + sh_off + col); }
        f32x4 xa[8], xb[8];
#pragma unroll
        for (int j = 0; j < 8; ++j) xa[j] = *(const f32x4*)(xin + (size_t)m0 * DM + 256 * j + 4 * lane);
#define P1_ROW(CUR, NXT, r) do { \
            if ((r) + 1 < 8) { _Pragma("unroll") for (int j = 0; j < 8; ++j) NXT[j] = *(const f32x4*)(xin + (size_t)(m0 + (r) + 1) * DM + 256 * j + 4 * lane); } \
            float s = 0.f; \
            _Pragma("unroll") for (int j = 0; j < 8; ++j) s += (CUR[j][0] * CUR[j][0] + CUR[j][1] * CUR[j][1]) + (CUR[j][2] * CUR[j][2] + CUR[j][3] * CUR[j][3]); \
            const float rstd = 1.f / sqrtf(wave_sum(s) * (1.f / DM) + EPS); \
            bf16* orow = hout + (size_t)(m0 + (r)) * DM; \
            _Pragma("unroll") for (int j = 0; j < 8; ++j) { const f32x4 y = CUR[j] * rstd * gs[j] + sh[j]; \
                u32x2 o; o.x = cvt_pk_bf16(y[0], y[1]); o.y = cvt_pk_bf16(y[2], y[3]); *(u32x2*)(orow + 256 * j + 4 * lane) = o; } } while (0)
#pragma unroll 1
        for (int rp = 0; rp < 4; ++rp) { P1_ROW(xa, xb, 2 * rp); P1_ROW(xb, xa, 2 * rp + 1); }
#undef P1_ROW
    }
}

template <int W>
__device__ __forceinline__ void p3_window_load(Frame& F, int g, int tp, int lane, bf16x8 (&v)[W]) {
    const int m = 2 * tp + (lane >> 5), t = m & (SEQ - 1), c0 = g * 256 + 8 * (lane & 31);
    const char* up = (const char*)(F.P + (size_t)m * PLD + C_U + c0);
#pragma unroll
    for (int tau = 0; tau < W; ++tau) { const int back = (t - tau >= 0) ? tau : 0; v[tau] = *(const bf16x8*)(up - (size_t)back * (PLD * 2)); }
}
template <int W>
__device__ __forceinline__ void p3_window_finish(Frame& F, int g, int tp, int lane, const bf16x8 (&v)[W]) {
    const int m = 2 * tp + (lane >> 5), t = m & (SEQ - 1), c0 = g * 256 + 8 * (lane & 31);
    float sum[8], self[8];
#pragma unroll
    for (int j = 0; j < 8; ++j) { self[j] = bf2f((bf16)v[0][j]); sum[j] = self[j]; }
#pragma unroll
    for (int tau = 1; tau < W; ++tau) { const float wgt = (t - tau >= 0) ? 1.f : 0.f;
#pragma unroll
        for (int j = 0; j < 8; ++j) sum[j] = fmaf(wgt, bf2f((bf16)v[tau][j]), sum[j]); }
    const float inv = 1.f / (float)((t + 1) < W ? (t + 1) : W);
    u32x4 o; o.x = cvt_pk_bf16(sum[0] * inv - self[0], sum[1] * inv - self[1]); o.y = cvt_pk_bf16(sum[2] * inv - self[2], sum[3] * inv - self[3]);
    o.z = cvt_pk_bf16(sum[4] * inv - self[4], sum[5] * inv - self[5]); o.w = cvt_pk_bf16(sum[6] * inv - self[6], sum[7] * inv - self[7]);
    *(u32x4*)(F.CAT + (size_t)m * DM + c0) = o;
}
__device__ __forceinline__ void p3_window(Frame& F) {
    const int gw = F.bid * NWAVES + F.wave, NGW = F.G * NWAVES, lane = F.lane;
    for (int tp = gw; tp < NTOK / 2; tp += NGW) {
        bf16x8 v2[2], v4[4], v8[8], v16[16];
        p3_window_load<2>(F, 0, tp, lane, v2); p3_window_load<4>(F, 1, tp, lane, v4); p3_window_load<8>(F, 2, tp, lane, v8); p3_window_load<16>(F, 3, tp, lane, v16);
        p3_window_finish<2>(F, 0, tp, lane, v2); p3_window_finish<4>(F, 1, tp, lane, v4); p3_window_finish<8>(F, 2, tp, lane, v8); p3_window_finish<16>(F, 3, tp, lane, v16);
    }
}
__device__ __forceinline__ int half_sum32(int v) {
    v += __builtin_amdgcn_update_dpp(0, v, 0x128, 0xf, 0xf, false);
    v += __builtin_amdgcn_update_dpp(0, v, 0x124, 0xf, 0xf, false);
    v += __builtin_amdgcn_update_dpp(0, v, 0x122, 0xf, 0xf, false);
    v += __builtin_amdgcn_update_dpp(0, v, 0x121, 0xf, 0xf, false);
    v += __shfl_xor(v, 16);
    return v;
}
__device__ __forceinline__ float relu_asm(float x) { const int i = __builtin_bit_cast(int, x); return __builtin_bit_cast(float, i > 0 ? i : 0); }
constexpr int IDX_CH = 512;
__device__ __forceinline__ void p3_indexer_item(Frame& F, int conv_it, const bf16* Pb, unsigned* Mb, int tb, LAS unsigned char* kl, int tid, int wave, int lane) {
    const int r = lane & 31, hi = lane >> 5, t0 = tb + 2 * wave, ktd = t0 >> 5, tq = t0 + hi;
    const int nch = ((tb + 15) / IDX_CH) + 1;
    const GAS char* Pc = (const GAS char*)Pb;
    const unsigned srow = (unsigned)(tid >> 3), sch = (unsigned)(tid & 7);
    const unsigned sgo = (srow * PLD + C_KI + sch * 8) * 2u;
    const unsigned slo = srow * 128u + ((sch ^ ((srow >> 1) & 7u)) * 16u);
    bf16x8 stg[8];
#define IDX_LOAD(c) do { _Pragma("unroll") for (int i = 0; i < 8; ++i) { const GAS char* bp_ = Pc + (size_t)((c) * IDX_CH + 64 * i) * (PLD * 2); asm volatile("" : "+s"(bp_)); \
        stg[i] = *(const GAS bf16x8*)(bp_ + sgo); } } while (0)
    IDX_LOAD(0);
    bf16x8 aq[4];
    { const unsigned qoff = (unsigned)((t0 + (r >> 4)) * PLD + C_QI + (r & 15) * 64 + 8 * hi) * 2u;
#pragma unroll
      for (int j = 0; j < 4; ++j) aq[j] = *(const GAS bf16x8*)(Pc + qoff + 32 * j); }
    bf16x8 a0, a1;
    { const GAS char* w0p = Pc + (size_t)t0 * (PLD * 2) + (C_WI + 4 * hi) * 2; const GAS char* w1p = w0p + PLD * 2;
      const u32x2 x0 = *(const GAS u32x2*)w0p, x1 = *(const GAS u32x2*)(w0p + 16), y0 = *(const GAS u32x2*)w1p, y1 = *(const GAS u32x2*)(w1p + 16);
      u32x4 wa = {x0.x, x0.y, x1.x, x1.y}, wb = {y0.x, y0.y, y1.x, y1.y};
      if (r != 0) wa = (u32x4){0u, 0u, 0u, 0u};
      if (r != 4) wb = (u32x4){0u, 0u, 0u, 0u};
      a0 = *reinterpret_cast<bf16x8*>(&wa); a1 = *reinterpret_cast<bf16x8*>(&wb); }
    float key[64];
    float vmax = -__builtin_inff(), vmin = __builtin_inff(), s1 = 0.f, s2 = 0.f;
    unsigned kro[4];
#pragma unroll
    for (int j = 0; j < 4; ++j) kro[j] = (unsigned)r * 128u + ((((unsigned)(2 * j + hi)) ^ (((unsigned)r >> 1) & 7u)) * 16u);
    for (int crep = 0; crep < ((PROBE_DUP == 32) ? 2 : 1); ++crep) {
    if (crep) { IDX_LOAD(0); }
#pragma unroll
    for (int c = 0; c < SEQ / IDX_CH; ++c) {
        if (c < nch) {
            __syncthreads();
#pragma unroll
            for (int i = 0; i < 8; ++i) *(LAS bf16x8*)(kl + slo + i * 8192) = stg[i];
            __syncthreads();
            if (c + 1 < nch) IDX_LOAD(c + 1);
#pragma unroll
            for (int g = 0; g < IDX_CH / 128; ++g) {
                const int kt0 = c * (IDX_CH / 32) + 4 * g;
                if (kt0 <= ktd) {
#pragma unroll
                    for (int q = 0; q < 4; ++q) {
                        const int kt = kt0 + q; const LAS unsigned char* tl = kl + (4 * g + q) * 4096;
                        f32x16 d = {};
#pragma unroll
                        for (int j = 0; j < 4; ++j) d = __builtin_amdgcn_mfma_f32_32x32x16_bf16(aq[j], *(const LAS bf16x8*)(tl + kro[j]), d, 0, 0, 0);
                        u32x4 b0, b1;
                        b0.x = cvt_pk_bf16(relu_asm(d[0]), relu_asm(d[1])); b0.y = cvt_pk_bf16(relu_asm(d[2]), relu_asm(d[3]));
                        b0.z = cvt_pk_bf16(relu_asm(d[4]), relu_asm(d[5])); b0.w = cvt_pk_bf16(relu_asm(d[6]), relu_asm(d[7]));
                        b1.x = cvt_pk_bf16(relu_asm(d[8]), relu_asm(d[9])); b1.y = cvt_pk_bf16(relu_asm(d[10]), relu_asm(d[11]));
                        b1.z = cvt_pk_bf16(relu_asm(d[12]), relu_asm(d[13])); b1.w = cvt_pk_bf16(relu_asm(d[14]), relu_asm(d[15]));
                        asm volatile("s_nop 1" ::: "memory");
                        f32x16 e = {};
                        e = __builtin_amdgcn_mfma_f32_32x32x16_bf16(a0, *reinterpret_cast<bf16x8*>(&b0), e, 0, 0, 0);
                        e = __builtin_amdgcn_mfma_f32_32x32x16_bf16(a1, *reinterpret_cast<bf16x8*>(&b1), e, 0, 0, 0);
                        const bool ok = (kt * 32 + r <= tq);
                        const float sv = ok ? e[0] : -__builtin_inff();
                        key[kt] = sv; vmax = fmaxf(vmax, sv); vmin = fminf(vmin, ok ? e[0] : __builtin_inff());
                        { const float z0 = ok ? e[0] : 0.f; s1 += z0; s2 = fmaf(z0, z0, s2); }
                    }
                } else {
#pragma unroll
                    for (int q = 0; q < 4; ++q) key[kt0 + q] = -__builtin_inff();
                }
            }
        } else {
#pragma unroll
            for (int q = 0; q < IDX_CH / 32; ++q) key[c * (IDX_CH / 32) + q] = -__builtin_inff();
        }
    }
    }
#undef IDX_LOAD
    f32x4 cv[16];
    { const int r = conv_it & 255; const float* gsrc = F.w_gate + (size_t)(conv_it >> 8) * DM * DEXP + (size_t)(64 * (r >> 3)) * DEXP + 64 * (r & 7) + (size_t)(16 * (lane >> 4)) * DEXP + (lane & 15) * 4;
#pragma unroll
      for (int i = 0; i < 16; ++i) cv[i] = *(const f32x4*)(gsrc + (size_t)i * DEXP); }
    float T = -3.0e38f;
    const bool need = (tq + 1) > TOPK;
    for (int srep = 0; srep < ((PROBE_DUP == 31) ? 2 : 1); ++srep)
    if (__any(need)) {
#pragma unroll
        for (int o = 1; o < 32; o <<= 1) { vmax = fmaxf(vmax, __shfl_xor(vmax, o)); vmin = fminf(vmin, __shfl_xor(vmin, o)); s1 += __shfl_xor(s1, o); s2 += __shfl_xor(s2, o); }
        const float nf = (float)(tq + 1), mu = s1 / nf, sd = sqrtf(fmaxf(s2 / nf - mu * mu, 1e-20f));
        float zq; { const float pu = (float)TOPK / nf;
            const float q = fminf(pu, 1.f - pu), t = sqrtf(-2.f * __logf(fmaxf(q, 1e-6f)));
            const float zz = t - (2.515517f + t * (0.802853f + t * 0.010328f)) / (1.f + t * (1.432788f + t * (0.189269f + t * 0.001308f)));
            zq = (pu < 0.5f) ? zz : -zz; }
        const float dens = nf * 0.3989423f * __expf(-0.5f * zq * zq) / sd;
        float lo = vmin, hi = vmax, prev = mu + zq * sd, flo = (float)(tq + 1) - 255.5f, fhi = 1.f - 255.5f; int pcnt = TOPK, side = 0; bool done = !need;
        for (int it = 0; it < 96; ++it) {
            const float mid = 0.5f * lo + 0.5f * hi;
            float cand = ((it & 3) == 3) ? mid : lo + (hi - lo) * flo / (flo - fhi);
            if (it == 0) cand = prev;
            if (it == 1) cand = prev + ((float)(pcnt - TOPK) + 0.5f) / dens;
            if (!(cand > lo && cand < hi)) cand = mid;
            if (!(cand > lo && cand < hi)) done = true;
            if (__all(done)) break;
            int cnt = 0;
#pragma unroll
            for (int g = 0; g < 8; ++g) {
                if (8 * g <= ktd) {
#define CNT4(k0, k1, k2, k3) asm volatile("v_cmp_ge_f32_e64 s[88:89], %1, %5\n\tv_cmp_ge_f32_e64 s[90:91], %2, %5\n\tv_cmp_ge_f32_e64 s[92:93], %3, %5\n\tv_cmp_ge_f32_e64 s[94:95], %4, %5\n\t" \
                        "v_addc_co_u32_e64 %0, s[88:89], 0, %0, s[88:89]\n\tv_addc_co_u32_e64 %0, s[90:91], 0, %0, s[90:91]\n\tv_addc_co_u32_e64 %0, s[92:93], 0, %0, s[92:93]\n\tv_addc_co_u32_e64 %0, s[94:95], 0, %0, s[94:95]" \
                        : "+v"(cnt) : "v"(k0), "v"(k1), "v"(k2), "v"(k3), "v"(cand) : "s88", "s89", "s90", "s91", "s92", "s93", "s94", "s95")
                    CNT4(key[8 * g + 0], key[8 * g + 1], key[8 * g + 2], key[8 * g + 3]);
                    CNT4(key[8 * g + 4], key[8 * g + 5], key[8 * g + 6], key[8 * g + 7]);
#undef CNT4
                }
            }
            cnt = half_sum32(cnt);
            if (!done) {
                if (cnt >= TOPK) { lo = cand; flo = (float)cnt - 255.5f; if (side == 1) fhi *= 0.5f; side = 1; }
                else { hi = cand; fhi = (float)cnt - 255.5f; if (side == 2) flo *= 0.5f; side = 2; }
                if (cnt == TOPK) done = true; }
            prev = cand; pcnt = cnt;
        }
        if (need) T = lo;
    }
    unsigned mw0 = 0u, mw1 = 0u;
#pragma unroll
    for (int kt = 0; kt < 64; ++kt) {
        if (kt <= ktd) { const unsigned long long bal = __ballot(key[kt] >= T);
            const unsigned blo = (unsigned)bal, bhi = (unsigned)(bal >> 32);
            asm volatile("s_nop 4\n\tv_writelane_b32 %0, %2, %4\n\tv_writelane_b32 %1, %3, %4" : "+v"(mw0), "+v"(mw1) : "s"(blo), "s"(bhi), "n"(kt)); }
    }
    Mb[(size_t)t0 * 64 + lane] = mw0; Mb[(size_t)(t0 + 1) * 64 + lane] = mw1;
    { P0Tile t; const int r = conv_it & 255; t.src = nullptr; t.ld_src = DEXP; t.k0 = 64 * (r >> 3); t.n0 = 64 * (r & 7); t.nvalid = DEXP; t.dst = (unsigned char*)F.Wgu + (size_t)(conv_it >> 8) * 1024 * DM; t.ld_dst = DM;
      t.himul = 256; t.radd = 0; t.fp8 = 1; t.scale = WGU_SCALE;
      u32x4 co[8]; p0_tile_pack(t, cv, co); p0_tile_store(t, co, lane); }
}
__device__ __forceinline__ void p3_indexer(Frame& F) {
    for (int wgi = F.vcu; wgi < 256; wgi += F.G) {
        const int b = wgi >> 5, j = wgi & 31;
#pragma unroll 1
        for (int s = 0; s < 4; ++s) { const int q16 = (s == 0) ? j : (s == 1) ? 63 - j : (s == 2) ? 64 + j : 127 - j;
            p3_indexer_item(F, (wgi * 4 + s) * NWAVES + F.wave, F.P + (size_t)b * SEQ * PLD, F.MASK + (size_t)b * SEQ * 64, q16 * 16, F.lds, F.tid, F.wave, F.lane); }
    }
}

namespace att {
constexpr int D = 128, QBLK = 32, KVBLK = 64, QB = 256;
constexpr int SHM_V = KVBLK * D * 2, SHM_K = KVBLK * D * 2;
constexpr int ATT_LDS = 2 * SHM_V + 2 * SHM_K + NWAVES * 64 * 4;
constexpr float SCALE = 0.08838834764831845f, THR = 8.f;
constexpr int RMAX = 207, NBIAS = 304;
#define KSWZ(row, colB) ((row) * 256 + ((colB) ^ (((row) & 7) << 4)))
#define SBAR() __builtin_amdgcn_sched_barrier(0)
__device__ __forceinline__ int v_st(int k, int c) { const int kk = (k & ~0xC) | ((k & 4) << 1) | ((k & 8) >> 1); return ((kk >> 3) * 4 + (c >> 5)) * 512 + ((kk & 7) * 32 + (c & 31)) * 2; }
__device__ __forceinline__ int v_rd_base(int lane) { return ((lane & 3) << 3) | (((lane >> 2) & 3) << 6) | (((lane >> 4) & 1) << 5) | (((lane >> 5) & 1) << 8); }
constexpr int v_rd_off(int d0, int ks, int half) { return d0 * 512 + ks * 4096 + half * 2048; }
__device__ __forceinline__ int crow(int r, int hi) { return (r & 3) + 8 * (r >> 2) + 4 * hi; }

__device__ __forceinline__ void mask_bias_tile(f32x16& p0, f32x16& p1, u32x2 mk, int hi, bool near, const LAS float* tb) {
    const float NEG = -__builtin_inff();
    const unsigned w0 = mk.x >> (4 * hi), w1 = mk.y >> (4 * hi);
    if (near) {
#pragma unroll
        for (int r = 0; r < 16; ++r) { const int c = (r & 3) + 8 * (r >> 2); p0[r] += tb[c]; p1[r] += tb[c + 32]; }
    }
    const int negb = __float_as_int(NEG);
#pragma unroll
    for (int r = 0; r < 16; ++r) { const int c = (r & 3) + 8 * (r >> 2);
        const int m0 = __builtin_amdgcn_sbfe((int)w0, c, 1), m1 = __builtin_amdgcn_sbfe((int)w1, c, 1);
        const float x0 = p0[r], x1 = p1[r];
        p0[r] = __int_as_float((__float_as_int(x0) & m0) | (negb & ~m0));
        p1[r] = __int_as_float((__float_as_int(x1) & m1) | (negb & ~m1)); }
}
__device__ __forceinline__ void partialSM(f32x16& p0, f32x16& p1, float& m_reg, float& mn, float& alpha) {
    float pmax = p0[0];
#pragma unroll
    for (int r = 1; r < 16; ++r) pmax = fmaxf(pmax, p0[r]);
#pragma unroll
    for (int r = 0; r < 16; ++r) pmax = fmaxf(pmax, p1[r]);
    { auto rr = __builtin_amdgcn_permlane32_swap(__float_as_uint(pmax), __float_as_uint(pmax), false, false);
      pmax = fmaxf(__uint_as_float(rr[0]), __uint_as_float(rr[1])); }
    constexpr float C2 = 1.4426950408889634f * SCALE;
    if (__builtin_expect(__all((pmax - m_reg) * SCALE <= THR), 1)) { mn = m_reg; alpha = 1.f; }
    else { mn = fmaxf(m_reg, pmax); alpha = __builtin_amdgcn_exp2f((m_reg - mn) * C2); m_reg = mn; }
    const float mnL = -mn * C2;
#pragma unroll
    for (int r = 0; r < 16; ++r) p0[r] = fmaf(p0[r], C2, mnL);
#pragma unroll
    for (int r = 0; r < 16; ++r) p1[r] = fmaf(p1[r], C2, mnL);
#pragma unroll
    for (int r = 0; r < 16; ++r) p0[r] = __builtin_amdgcn_exp2f(p0[r]);
}
__device__ __forceinline__ void finishSM(f32x16& p0, f32x16& p1, float alpha, float& l_reg, bf16x8& pa0, bf16x8& pa1, bf16x8& pa2, bf16x8& pa3) {
#pragma unroll
    for (int r = 0; r < 16; ++r) p1[r] = __builtin_amdgcn_exp2f(p1[r]);
    float ps = 0;
#pragma unroll
    for (int r = 0; r < 16; ++r) ps += p0[r];
#pragma unroll
    for (int r = 0; r < 16; ++r) ps += p1[r];
    { auto rr = __builtin_amdgcn_permlane32_swap(__float_as_uint(ps), __float_as_uint(ps), false, false);
      ps = __uint_as_float(rr[0]) + __uint_as_float(rr[1]); }
    l_reg = l_reg * alpha + ps;
#define PK4(P, B_, OUT) do { unsigned a0 = cvt_pk_bf16(P[B_+0], P[B_+1]), a1 = cvt_pk_bf16(P[B_+2], P[B_+3]);                          \
        unsigned b0 = cvt_pk_bf16(P[B_+4], P[B_+5]), b1 = cvt_pk_bf16(P[B_+6], P[B_+7]);                                             \
        auto r0 = __builtin_amdgcn_permlane32_swap(a0, b0, false, false); auto r1 = __builtin_amdgcn_permlane32_swap(a1, b1, false, false); \
        u32x4 w = {r0[0], r1[0], r0[1], r1[1]}; OUT = *reinterpret_cast<bf16x8*>(&w); } while (0)
    PK4(p0, 0, pa0); PK4(p0, 8, pa1); PK4(p1, 0, pa2); PK4(p1, 8, pa3);
#undef PK4
}
template <int KB>
__device__ __forceinline__ void qkt(f32x16& p0, f32x16& p1, const char* K_lds, const char* Qw, int r32, int hi) {
    p0 = f32x16{}; p1 = f32x16{};
    const char* kb[4]; const char* qb[4];
#pragma unroll
    for (int dd = 0; dd < 4; ++dd) { kb[dd] = K_lds + KB * SHM_K + KSWZ(r32, (dd * 16 + hi * 8) * 2); qb[dd] = Qw + KSWZ(r32, (dd * 16 + hi * 8) * 2); }
#pragma unroll
    for (int d0 = 0; d0 < 8; ++d0) { const char* a = kb[d0 & 3] + (d0 >> 2) * 128;
        bf16x8 b0 = *reinterpret_cast<const bf16x8*>(a);
        bf16x8 b1 = *reinterpret_cast<const bf16x8*>(a + 32 * 256);
        bf16x8 q = *reinterpret_cast<const bf16x8*>(qb[d0 & 3] + (d0 >> 2) * 128);
        p0 = __builtin_amdgcn_mfma_f32_32x32x16_bf16(b0, q, p0, 0, 0, 0);
        p1 = __builtin_amdgcn_mfma_f32_32x32x16_bf16(b1, q, p1, 0, 0, 0); }
    __builtin_amdgcn_sched_group_barrier(0x100, 3, 0);
#pragma unroll
    for (int d0 = 0; d0 < 7; ++d0) { __builtin_amdgcn_sched_group_barrier(0x100, 3, 0); __builtin_amdgcn_sched_group_barrier(0x008, 2, 0); }
    __builtin_amdgcn_sched_group_barrier(0x008, 2, 0);
}
template <int VB>
__device__ __forceinline__ void pv_tile(f32x16* o, int vb0, bf16x8 pa0, bf16x8 pa1, bf16x8 pa2, bf16x8 pa3) {
#define TRRD(dst, off) asm volatile("ds_read_b64_tr_b16 %0, %1 offset:%2" : "=&v"(dst) : "v"(vb0), "i"(off) : "memory")
#define PV_D0(d0) do { s16x4 l0, l1, l2, l3, h0, h1, h2, h3; constexpr int b_ = VB * SHM_V + v_rd_off(d0, 0, 0); \
        TRRD(l0, b_); TRRD(h0, b_ + 2048); TRRD(l1, b_ + 4096); TRRD(h1, b_ + 6144); TRRD(l2, b_ + 8192); TRRD(h2, b_ + 10240); TRRD(l3, b_ + 12288); TRRD(h3, b_ + 14336); \
        asm volatile("s_waitcnt lgkmcnt(0)" ::: "memory"); SBAR();   \
        o[d0] = __builtin_amdgcn_mfma_f32_32x32x16_bf16(pa0, (bf16x8){l0[0], l0[1], l0[2], l0[3], h0[0], h0[1], h0[2], h0[3]}, o[d0], 0, 0, 0);   \
        o[d0] = __builtin_amdgcn_mfma_f32_32x32x16_bf16(pa1, (bf16x8){l1[0], l1[1], l1[2], l1[3], h1[0], h1[1], h1[2], h1[3]}, o[d0], 0, 0, 0);   \
        o[d0] = __builtin_amdgcn_mfma_f32_32x32x16_bf16(pa2, (bf16x8){l2[0], l2[1], l2[2], l2[3], h2[0], h2[1], h2[2], h2[3]}, o[d0], 0, 0, 0);   \
        o[d0] = __builtin_amdgcn_mfma_f32_32x32x16_bf16(pa3, (bf16x8){l3[0], l3[1], l3[2], l3[3], h3[0], h3[1], h3[2], h3[3]}, o[d0], 0, 0, 0); } while (0)
    PV_D0(0); PV_D0(1); PV_D0(2); PV_D0(3);
#undef PV_D0
#undef TRRD
}
struct BlockRef { const bf16* Q; const bf16* K; bf16* O; const unsigned* M; int P0; };
struct Seam { bf16x8 st_v0, st_v1, st_k0, st_k1; u32x2 mkA; };
constexpr int Q_OFF = 2 * SHM_V + 2 * SHM_K + NWAVES * 64 * 4;
constexpr int ATT_LDS_ALL = Q_OFF + NWAVES * 8192;
#define VMW() asm volatile("s_waitcnt vmcnt(0)" ::: "memory")
#define KVROW (PLD * 2)
#define SLOAD_H(Kp, k0) do { const char* kt_ = (const char*)(Kp) + (size_t)(k0) * KVROW; \
        S.st_k0 = *(const bf16x8*)(kt_ + kvo); S.st_k1 = *(const bf16x8*)(kt_ + 32 * KVROW + kvo); \
        S.st_v0 = *(const bf16x8*)(kt_ + (C_V - C_K) * 2 + kvo); S.st_v1 = *(const bf16x8*)(kt_ + 32 * KVROW + (C_V - C_K) * 2 + kvo); } while (0)
#define SWRITE_HK(bf) do { *(bf16x8*)(K_lds + (bf) * SHM_K + kws) = S.st_k0; *(bf16x8*)(K_lds + (bf) * SHM_K + kws + 32 * 256) = S.st_k1; } while (0)
#define SWRITE_HV(bf) do { *(bf16x8*)(V_lds + (bf) * SHM_V + vst0) = S.st_v0; *(bf16x8*)(V_lds + (bf) * SHM_V + vst1) = S.st_v1; } while (0)
#define SWRITE_H(bf) do { SWRITE_HV(bf); SWRITE_HK(bf); } while (0)
#define MLOAD(ref, tile) (*(const u32x2*)((const char*)((ref).M + (size_t)wid * QBLK * 64 + 2 * (tile)) + mro))
__device__ __forceinline__ void attn_prime(const BlockRef& cur, char* lds, Seam& S, const int wid, const int lane) {
    const int tid = wid * 64 + lane, r32 = lane & 31;
    const int sr = tid >> 4, sc = (tid & 15) * 8, kws = KSWZ(sr, sc * 2); char* K_lds = lds + 2 * SHM_V;
    const unsigned kvo = (unsigned)(sr * PLD + sc) * 2u, mro = (unsigned)r32 * 256u;
    SLOAD_H(cur.K, 0); S.mkA = MLOAD(cur, 0); VMW(); SWRITE_HK(0);
    __syncthreads();
}
__device__ __forceinline__ void attn_block(const BlockRef& cur, const BlockRef& nxt, char* lds, const LAS float* btab, Seam& S, const int wid, const int lane) {
    const int tid = wid * 64 + lane, r32 = lane & 31, hi = lane >> 5;
    const int NT = (cur.P0 + QB - 1) / KVBLK + 1;
    const int qlo = cur.P0 + wid * QBLK, pos = qlo + r32;
    char* V_lds = lds; char* K_lds = lds + 2 * SHM_V; char* Qw = lds + Q_OFF + wid * 8192;
    float* ws = (float*)(lds + 2 * SHM_V + 2 * SHM_K) + wid * 64; float* li_l = ws, * al_l = ws + 32;
    float m_reg = -1e30f, l_reg = 0; f32x16 o[4] = {};
    const int sr = tid >> 4, sc = (tid & 15) * 8, vst0 = v_st(sr, sc), vst1 = v_st(32 + sr, sc), kws = KSWZ(sr, sc * 2);
    const unsigned kvo = (unsigned)(sr * PLD + sc) * 2u, mro = (unsigned)r32 * 256u;
    const int vb0 = (int)(uintptr_t)V_lds + v_rd_base(lane);
    const bf16* Kh = cur.K;
    u32x2 mkA = S.mkA, mkB = (u32x2){0u, 0u};
    {
        const char* qg = (const char*)(cur.Q + (size_t)wid * QBLK * PLD) + (unsigned)(r32 * PLD + hi * 8) * 2u;
        bf16x8 qv[8];
#pragma unroll
        for (int d0 = 0; d0 < 8; ++d0) qv[d0] = *(const bf16x8*)(qg + d0 * 32);
#pragma unroll
        for (int d0 = 0; d0 < 8; ++d0) *(bf16x8*)(Qw + KSWZ(r32, (d0 * 16 + hi * 8) * 2)) = qv[d0];
        asm volatile("s_waitcnt lgkmcnt(0)" ::: "memory");
    }
#define RESC(a) do { if (__any((a) < 1.f)) { if (hi == 0) al_l[r32] = (a); asm volatile("s_waitcnt lgkmcnt(0)" ::: "memory");              \
                     for (int d_ = 0; d_ < 4; ++d_) for (int r = 0; r < 16; ++r) o[d_][r] *= al_l[crow(r, hi)]; } } while (0)
#define KBASE(t) ((t) * KVBLK)
#define MASKT(P0_, P1_, mk, t) do { const int kb_ = KBASE(t); const bool near_ = (kb_ <= qlo + QBLK - 1) && (kb_ > qlo - 176); \
        mask_bias_tile(P0_, P1_, mk, hi, near_, btab + (RMAX - (pos - kb_ - 4 * hi))); } while (0)
    f32x16 pA0, pA1, pB0, pB1; float mnA, mnB, alA, alB; bf16x8 pa0, pa1, pa2, pa3;
    SWRITE_HV(0); SBAR();
    if (NT > 1) { SLOAD_H(Kh, KBASE(1)); mkB = MLOAD(cur, 1); }
    SBAR(); qkt<0>(pA0, pA1, K_lds, Qw, r32, hi);
    MASKT(pA0, pA1, mkA, 0); partialSM(pA0, pA1, m_reg, mnA, alA);
    if (NT > 1) { VMW(); SWRITE_H(1); }
    __syncthreads();
#define HALF_STEP(PX0, PX1, mnX, alX, mkX, PY0, PY1, alY, mkY, t, KB, VB, SB) do {                                                      \
        SBAR(); qkt<KB>(PX0, PX1, K_lds, Qw, r32, hi);                                             \
        finishSM(PY0, PY1, alY, l_reg, pa0, pa1, pa2, pa3); SBAR();                                                           \
        if ((t) + 1 < NT) { SLOAD_H(Kh, KBASE((t) + 1)); mkY = MLOAD(cur, (t) + 1); SBAR(); }                                               \
        pv_tile<VB>(o, vb0, pa0, pa1, pa2, pa3); MASKT(PX0, PX1, mkX, (t)); partialSM(PX0, PX1, m_reg, mnX, alX);                                        \
        __syncthreads();                                                                                                      \
        if ((t) + 1 < NT) { VMW(); SWRITE_H(SB); }                                                                          \
        RESC(alX); __syncthreads(); } while (0)
    for (int t = 1; t + 1 < NT; t += 2) {
        HALF_STEP(pB0, pB1, mnB, alB, mkB, pA0, pA1, alA, mkA, t, 1, 0, 0);
        HALF_STEP(pA0, pA1, mnA, alA, mkA, pB0, pB1, alB, mkB, t + 1, 0, 1, 1);
    }
    const bool even = (NT & 1) == 0;
    if (even) { SBAR(); qkt<1>(pB0, pB1, K_lds, Qw, r32, hi); SBAR(); }
    SLOAD_H(nxt.K, 0); mkA = MLOAD(nxt, 0); SBAR();
    finishSM(pA0, pA1, alA, l_reg, pa0, pa1, pa2, pa3); SBAR();
    pv_tile<0>(o, vb0, pa0, pa1, pa2, pa3);
    if (even) { MASKT(pB0, pB1, mkB, NT - 1); partialSM(pB0, pB1, m_reg, mnB, alB); __syncthreads(); RESC(alB);
        finishSM(pB0, pB1, alB, l_reg, pa0, pa1, pa2, pa3); SBAR(); pv_tile<1>(o, vb0, pa0, pa1, pa2, pa3); }
    SBAR(); VMW(); SWRITE_HK(0); SBAR();
    S.mkA = mkA;
    if (hi == 0) li_l[r32] = l_reg; asm volatile("s_waitcnt lgkmcnt(0)" ::: "memory");
    float rli[16];
#pragma unroll
    for (int r = 0; r < 16; ++r) rli[r] = __builtin_amdgcn_rcpf(li_l[crow(r, hi)]);
    {
        bf16* ol = (bf16*)Qw;
#pragma unroll
        for (int r = 0; r < 16; ++r) { const int orow = crow(r, hi);
#pragma unroll
            for (int d0 = 0; d0 < 4; ++d0) ol[orow * D + d0 * 32 + r32] = (bf16)(cvt_pk_bf16(o[d0][r] * rli[r], 0.f) & 0xffffu); }
        asm volatile("s_waitcnt lgkmcnt(0)" ::: "memory");
        char* Ob = (char*)(cur.O + (size_t)(wid * QBLK) * DM);
        const unsigned ovo = (unsigned)((lane >> 4) * (DM * 2) + (lane & 15) * 16);
#pragma unroll
        for (int i = 0; i < 8; ++i) { const u32x4 w = *(const u32x4*)(Qw + i * 1024 + lane * 16);
            GAS char* Obi = (GAS char*)(Ob + (size_t)i * (4 * DM * 2)); asm volatile("" : "+s"(Obi));
            *(GAS u32x4*)(Obi + ovo) = w; }
        asm volatile("s_waitcnt lgkmcnt(0)" ::: "memory");
    }
    __syncthreads();
#undef RESC
#undef KBASE
#undef MASKT
#undef HALF_STEP
}
#undef VMW
#undef SLOAD_H
#undef SWRITE_HK
#undef SWRITE_HV
#undef SWRITE_H
#undef MLOAD
#undef KVROW
}

__device__ __forceinline__ int t5_bucket(int rel) {
    if (rel < 16) return rel;
    int v = 16 + (int)(logf((float)rel / 16.f) / logf(8.f) * 16.f);
    return v < 31 ? v : 31;
}
__device__ __forceinline__ att::BlockRef p4_ref(Frame& F, int it, int pass) {
    const int b = it >> 5, h = (it >> 2) & 7, p = it & 3, kvh = h >> 2, qb = pass ? 7 - p : p;
    const bf16* Pb = F.P + (size_t)b * SEQ * PLD;
    att::BlockRef r; r.P0 = qb * 256;
    r.Q = Pb + (size_t)r.P0 * PLD + C_Q + h * HD; r.K = Pb + C_K + kvh * HD;
    r.O = F.CAT + (size_t)(b * SEQ + r.P0) * DM + POOLW + h * HD; r.M = F.MASK + (size_t)(b * SEQ + r.P0) * 64;
    return r;
}
__device__ __forceinline__ void p4_attention(Frame& F, int nitems) {
    LAS float* btab = (LAS float*)(F.lds + MISC_BASE + MO_BIAS);
    char* lds = (char*)F.lds;
    int it = F.vcu, pass = 0;
    if (it >= nitems) return;
    att::Seam S;
    { const att::BlockRef c0 = p4_ref(F, it & 255, 0); att::attn_prime(c0, lds, S, F.wave, F.lane); }
    for (;;) {
        if (pass == 0) {
            const int h = (it >> 2) & 7;
            __syncthreads();
            for (int i = F.tid; i < att::NBIAS; i += NTHR) { const int rel = att::RMAX - i; float v = 0.f;
                if (rel >= 0) v = (F.rel_bias[t5_bucket(rel) * NHEAD + h] - F.rel_bias[31 * NHEAD + h]) * (1.f / att::SCALE);
                btab[i] = v; }
            __syncthreads();
        }
        const bool more_item = it + F.G < nitems, last = (pass == 1) && !more_item;
        const int itn = (pass == 0) ? it : (more_item ? it + F.G : it), passn = (pass == 0) ? 1 : (more_item ? 0 : 1);
        const att::BlockRef cur = p4_ref(F, it & 255, pass), nxt = p4_ref(F, itn & 255, passn);
        att::attn_block(cur, nxt, lds, btab, S, F.wave, F.lane);
        if (last) break;
        it = itn; pass = passn;
    }
}

constexpr int P6_ROWS = 32, P6_PITCH = 4112;
constexpr int P6_LOG = P6_ROWS * P6_PITCH;
static_assert(P6_LOG + P6_ROWS * 48 * 4 <= MISC_BASE, "P6 LDS");
__device__ __forceinline__ void p6_route(Frame& F, const LAS float* lg, int m) {
    float gmax = lg[0] + F.b_group[0]; int gsel = 0;
#pragma unroll
    for (int i = 1; i < NGRP; ++i) { const float v = lg[i] + F.b_group[i]; if (v > gmax) { gmax = v; gsel = i; } }
    float gz = 0.f;
#pragma unroll
    for (int i = 0; i < NGRP; ++i) gz += __expf(lg[i] + F.b_group[i] - gmax);
    const float pg = 1.f / gz;
    float e1v = -3.0e38f, e2v = -3.0e38f; int i1 = 0, i2 = 0;
#pragma unroll
    for (int i = 0; i < EPG; ++i) { const float v = lg[4 + gsel * EPG + i] + F.b_router[gsel * EPG + i];
        if (v > e1v) { e2v = e1v; i2 = i1; e1v = v; i1 = i; } else if (v > e2v) { e2v = v; i2 = i; } }
    const float w1 = 1.f / (1.f + __expf(e2v - e1v)), w2 = 1.f - w1;
    const int ex1 = gsel * EPG + i1, ex2 = gsel * EPG + i2;
    const unsigned p1 = atomicAdd(F.ctl + CW_ECNT + 16 * ex1, 1u), p2 = atomicAdd(F.ctl + CW_ECNT + 16 * ex2, 1u);
    F.TOKLIST[ex1 * NTOK + (int)p1] = m; F.TOKLIST[ex2 * NTOK + (int)p2] = m;
    unsigned* ti = F.TOKINFO + (size_t)m * 8;
    ti[0] = (unsigned)ex1; ti[1] = p1; ti[2] = (unsigned)ex2; ti[3] = p2; ti[4] = __float_as_uint(pg * w1); ti[5] = __float_as_uint(pg * w2);
}
__device__ __forceinline__ void p6_norm_router(Frame& F, bool route) {
    LAS unsigned char* tile = F.lds;
    LAS float* logit = (LAS float*)(F.lds + P6_LOG);
    const int lane = F.lane, wave = F.wave, fr = lane & 15, fq = lane >> 4;
    int prev_m0 = -1;
    for (int grp = F.bid; grp < NTOK / P6_ROWS; grp += F.G) {
        const int m0 = grp * P6_ROWS, b = m0 / SEQ;
        const float* modb = F.mod + (size_t)b * (6 * DM);
        u32x2 xb[4][8];
#pragma unroll
        for (int rr = 0; rr < 4; ++rr)
#pragma unroll
            for (int j = 0; j < 8; ++j) xb[rr][j] = *(const u32x2*)(F.X1 + (size_t)(m0 + 4 * wave + rr) * DM + 256 * j + 4 * lane);
        f32x4 gs[8], sh[8];
#pragma unroll
        for (int j = 0; j < 8; ++j) { const int col = 256 * j + 4 * lane; const f32x4 g = *(const f32x4*)(F.g_ffn + col), sc = *(const f32x4*)(modb + 4 * DM + col);
            gs[j] = g * (sc + 1.f); sh[j] = *(const f32x4*)(modb + 3 * DM + col); }
        if (route && prev_m0 >= 0 && lane < 4) p6_route(F, logit + (4 * wave + lane) * 48, prev_m0 + 4 * wave + lane);
#pragma unroll
        for (int rr = 0; rr < 4; ++rr) {
            const int lr = 4 * wave + rr, m = m0 + lr;
            f32x4 v[8]; float s = 0.f;
#pragma unroll
            for (int j = 0; j < 8; ++j) { const u32x2 q = xb[rr][j];
                v[j][0] = __uint_as_float(q.x << 16); v[j][1] = __uint_as_float(q.x & 0xffff0000u); v[j][2] = __uint_as_float(q.y << 16); v[j][3] = __uint_as_float(q.y & 0xffff0000u);
                s += (v[j][0] * v[j][0] + v[j][1] * v[j][1]) + (v[j][2] * v[j][2] + v[j][3] * v[j][3]); }
            const float rstd = 1.f / sqrtf(wave_sum(s) * (1.f / DM) + EPS);
            unsigned char* orow = (unsigned char*)F.H + (size_t)m * DM;
#pragma unroll
            for (int j = 0; j < 8; ++j) { const f32x4 y = v[j] * rstd * gs[j] + sh[j];
                u32x2 o; o.x = cvt_pk_bf16(y[0], y[1]); o.y = cvt_pk_bf16(y[2], y[3]);
                *(unsigned*)(orow + 256 * j + 4 * lane) = pk4_fp8(y[0], y[1], y[2], y[3]);
                *(LAS u32x2*)(tile + lr * P6_PITCH + (256 * j + 4 * lane) * 2) = o; }
        }
        __syncthreads();
        if (wave < 6) {
            const int rb = wave / 3, nb = wave - 3 * rb;
            f32x4 acc = (f32x4){0.f, 0.f, 0.f, 0.f};
            const LAS unsigned char* ap = tile + (rb * 16 + fr) * P6_PITCH + 16 * fq;
            const bf16* bp = F.RW + (size_t)(nb * 16 + fr) * DM + 8 * fq;
#pragma unroll 16
            for (int ks = 0; ks < 64; ++ks) acc = __builtin_amdgcn_mfma_f32_16x16x32_bf16(*(const LAS bf16x8*)(ap + 64 * ks), *(const bf16x8*)(bp + 32 * ks), acc, 0, 0, 0);
#pragma unroll
            for (int j = 0; j < 4; ++j) logit[(rb * 16 + 4 * fq + j) * 48 + nb * 16 + fr] = acc[j];
        }
        __syncthreads();
        prev_m0 = m0;
    }
    if (route && prev_m0 >= 0 && lane < 4) p6_route(F, logit + (4 * wave + lane) * 48, prev_m0 + 4 * wave + lane);
}
constexpr int S6_ROWS = 16, S6_LOG = S6_ROWS * P6_PITCH, S6_CTR = 69120, S6_SCR_HI = 69632;
static_assert(S6_LOG + S6_ROWS * 48 * 4 <= S6_CTR && S6_SCR_HI + 4 * 16640 <= MISC_BASE, "side-by-side LDS map");
__device__ __forceinline__ void bar4(volatile LAS unsigned* cnt, unsigned& target, int lane) {
    asm volatile("s_waitcnt lgkmcnt(0)" ::: "memory");
    target += 4u;
    if (lane == 0) (void)__hip_atomic_fetch_add((LAS unsigned*)cnt, 1u, __ATOMIC_RELAXED, __HIP_MEMORY_SCOPE_WORKGROUP);
    while (*cnt < target) __builtin_amdgcn_s_sleep(1);
    asm volatile("" ::: "memory");
}
__device__ __forceinline__ void s6_router(Frame& F, volatile LAS unsigned* bcnt) {
    LAS unsigned char* tile = F.lds;
    LAS float* logit = (LAS float*)(F.lds + S6_LOG);
    const int lane = F.lane, wave = F.wave, fr = lane & 15, fq = lane >> 4;
    unsigned btarget = 0u; int prev_m0 = -1;
    for (int grp = F.bid; grp < NTOK / S6_ROWS; grp += F.G) {
        const int m0 = grp * S6_ROWS, b = m0 / SEQ;
        const float* modb = F.mod + (size_t)b * (6 * DM);
        u32x2 xb[4][8];
#pragma unroll
        for (int rr = 0; rr < 4; ++rr)
#pragma unroll
            for (int j = 0; j < 8; ++j) xb[rr][j] = *(const u32x2*)(F.X1 + (size_t)(m0 + 4 * wave + rr) * DM + 256 * j + 4 * lane);
        f32x4 gs[8], sh[8];
#pragma unroll
        for (int j = 0; j < 8; ++j) { const int col = 256 * j + 4 * lane; const f32x4 g = *(const f32x4*)(F.g_ffn + col), sc = *(const f32x4*)(modb + 4 * DM + col);
            gs[j] = g * (sc + 1.f); sh[j] = *(const f32x4*)(modb + 3 * DM + col); }
        if (prev_m0 >= 0 && lane < 4) p6_route(F, logit + (4 * wave + lane) * 48, prev_m0 + 4 * wave + lane);
        bar4(bcnt, btarget, lane);
#pragma unroll
        for (int rr = 0; rr < 4; ++rr) {
            const int lr = 4 * wave + rr, m = m0 + lr;
            f32x4 v[8]; float s = 0.f;
#pragma unroll
            for (int j = 0; j < 8; ++j) { const u32x2 q = xb[rr][j];
                v[j][0] = __uint_as_float(q.x << 16); v[j][1] = __uint_as_float(q.x & 0xffff0000u); v[j][2] = __uint_as_float(q.y << 16); v[j][3] = __uint_as_float(q.y & 0xffff0000u);
                s += (v[j][0] * v[j][0] + v[j][1] * v[j][1]) + (v[j][2] * v[j][2] + v[j][3] * v[j][3]); }
            const float rstd = 1.f / sqrtf(wave_sum(s) * (1.f / DM) + EPS);
            unsigned char* orow = (unsigned char*)F.H + (size_t)m * DM;
#pragma unroll
            for (int j = 0; j < 8; ++j) { const f32x4 y = v[j] * rstd * gs[j] + sh[j];
                u32x2 o; o.x = cvt_pk_bf16(y[0], y[1]); o.y = cvt_pk_bf16(y[2], y[3]);
                *(unsigned*)(orow + 256 * j + 4 * lane) = pk4_fp8(y[0], y[1], y[2], y[3]);
                *(LAS u32x2*)(tile + lr * P6_PITCH + (256 * j + 4 * lane) * 2) = o; }
        }
        bar4(bcnt, btarget, lane);
        if (wave < 3) {
            const int nb = wave;
            f32x4 acc = (f32x4){0.f, 0.f, 0.f, 0.f};
            const LAS unsigned char* ap = tile + fr * P6_PITCH + 16 * fq;
            const bf16* bp = F.RW + (size_t)(nb * 16 + fr) * DM + 8 * fq;
#pragma unroll 16
            for (int ks = 0; ks < 64; ++ks) acc = __builtin_amdgcn_mfma_f32_16x16x32_bf16(*(const LAS bf16x8*)(ap + 64 * ks), *(const bf16x8*)(bp + 32 * ks), acc, 0, 0, 0);
#pragma unroll
            for (int j = 0; j < 4; ++j) logit[(4 * fq + j) * 48 + nb * 16 + fr] = acc[j];
        }
        bar4(bcnt, btarget, lane);
        prev_m0 = m0;
    }
    if (prev_m0 >= 0 && lane < 4) p6_route(F, logit + (4 * wave + lane) * 48, prev_m0 + 4 * wave + lane);
    bar4(bcnt, btarget, lane);
}
__device__ __forceinline__ int lds_pop(LAS unsigned* ctr, int lane) {
    int v = 0; if (lane == 0) v = (int)__hip_atomic_fetch_add(ctr, 1u, __ATOMIC_RELAXED, __HIP_MEMORY_SCOPE_WORKGROUP);
    return __builtin_amdgcn_readfirstlane(v);
}
__device__ __forceinline__ void s6_convert(Frame& F, LAS unsigned* ctr, int a0, int total) {
    f32x4 v[16]; u32x4 o[8]; P0Tile cur, nxt;
    int d = F.bid + F.G * lds_pop(ctr, F.lane);
    if (d >= total) return;
    cur = p0_decode(F, a0 + d); p0_tile_load(cur, v, F.lane);
    for (;;) {
        p0_tile_pack(cur, v, o);
        const int dn = F.bid + F.G * lds_pop(ctr, F.lane); const bool more = dn < total;
        if (more) { nxt = p0_decode(F, a0 + dn); p0_tile_load(nxt, v, F.lane); }
        p0_tile_store(cur, o, F.lane);
        if (!more) break;
        cur = nxt;
    }
}
__device__ __forceinline__ void p6_side_by_side(Frame& F) {
    LAS unsigned* ctrs = (LAS unsigned*)(F.lds + S6_CTR);
    __syncthreads();
    if (F.tid == 0) { ctrs[0] = 0u; ctrs[1] = 0u; }
    __syncthreads();
    constexpr int A0 = P0_EARLY_A + P0_R2;
    const int total = ((F.G == 256) ? P0_OFF_START : P0_EARLY_B0) - A0;
    if (F.wave < 4) { s6_router(F, (volatile LAS unsigned*)ctrs); s6_convert(F, ctrs + 1, A0, total); }
    else s6_convert(F, ctrs + 1, A0, total);
}

__device__ __forceinline__ pg8::MoeTabs moe_tabs(Frame& F) {
    pg8::MoeTabs T; T.tb = (const LAS int*)(F.lds + MISC_BASE + MO_TB); T.tf = T.tb + 40; T.hl = T.tb + 80; return T;
}
__device__ __forceinline__ void moe_tables(Frame& F) {
    LAS int* tb = (LAS int*)(F.lds + MISC_BASE + MO_TB); LAS int* tf = tb + 40; LAS int* hl = tb + 80; LAS int* cnt = (LAS int*)(F.lds + MISC_BASE + MO_CNT);
    __syncthreads();
    if (F.tid < NEXP) cnt[F.tid] = (int)__hip_atomic_load(F.ctl + CW_ECNT + 16 * F.tid, __ATOMIC_RELAXED, __HIP_MEMORY_SCOPE_AGENT);
    __syncthreads();
    if (F.tid == 0) { int s = 0, f = 0, nh = 0;
        for (int e = 0; e < NEXP; ++e) { const int c = cnt[e], t = (c + 255) >> 8, rem = c - ((t - 1) << 8), h = (t > 0 && rem <= 128) ? 1 : 0;
            tb[e] = s; tf[e] = f; s += t; f += t - h; if (h) hl[nh++] = e; }
        tb[NEXP] = s; tf[NEXP] = f; hl[NEXP] = nh; }
    __syncthreads();
}
__device__ __forceinline__ void p7_rowtab(Frame& F, int reps) {
    const pg8::MoeTabs T = moe_tabs(F); const LAS int* cnt = (const LAS int*)(F.lds + MISC_BASE + MO_CNT);
    LAS unsigned* rowtab = (LAS unsigned*)(F.lds + MISC_BASE + MO_ROWTAB);
    unsigned off[MAXU * 256 / NTHR];
#pragma unroll
    for (int q = 0; q < MAXU * 256 / NTHR; ++q) { const int idx = F.tid + q * NTHR, ord = idx >> 8, r = idx & 255; int pm, pn, e, half; off[q] = 0u;
        if (pg8::moe_unit(T, 4, ord * F.G + F.vcu, reps, pm, pn, e, half)) {
            const int slot = (pm - T.tb[e]) * 256 + r; if (slot < cnt[e]) off[q] = (unsigned)F.TOKLIST[e * NTOK + slot] * (unsigned)DM; } }
#pragma unroll
    for (int q = 0; q < MAXU * 256 / NTHR; ++q) rowtab[F.tid + q * NTHR] = off[q];
    __syncthreads();
}
struct P9Row { u32x2 x[8]; int ya[8], yc[8]; };
__device__ __forceinline__ void p9_load(Frame& F, const LAS int* tb, int m, int e1, int p1, int e2, int p2, P9Row& R, int lane) {
    const bf16* x1r = F.X1 + (size_t)m * DM;
    const unsigned char* y1 = (const unsigned char*)F.Y + ((size_t)tb[e1] * 256 + p1) * DM; const unsigned char* y2 = (const unsigned char*)F.Y + ((size_t)tb[e2] * 256 + p2) * DM;
#pragma unroll
    for (int j = 0; j < 8; ++j) { const int col = 256 * j + 4 * lane; R.x[j] = *(const u32x2*)(x1r + col); R.ya[j] = *(const int*)(y1 + col); R.yc[j] = *(const int*)(y2 + col); }
}
__device__ __forceinline__ void p9_final(Frame& F) {
    const LAS int* tb = (const LAS int*)(F.lds + MISC_BASE + MO_TB);
    const int gw = F.bid * NWAVES + F.wave, NGW = F.G * NWAVES, lane = F.lane;
    for (int grp = gw; grp < NTOK / 8; grp += NGW) {
        const int m0 = grp * 8, b = m0 / SEQ;
        const unsigned tiw = (lane < 48) ? F.TOKINFO[(size_t)(m0 + lane / 6) * 8 + (lane % 6)] : 0u;
        f32x4 gt[8], gf[8];
#pragma unroll
        for (int j = 0; j < 8; ++j) { const int col = 256 * j + 4 * lane; gt[j] = *(const f32x4*)(F.mod + (size_t)b * (6 * DM) + 5 * DM + col); gf[j] = *(const f32x4*)(F.g_final + col); }
        P9Row R[2];
#define P9_TI(r, w) __builtin_amdgcn_readlane((int)tiw, 6 * (r) + (w))
        p9_load(F, tb, m0, P9_TI(0, 0), P9_TI(0, 1), P9_TI(0, 2), P9_TI(0, 3), R[0], lane);
#pragma unroll
        for (int r = 0; r < 8; ++r) {
            if (r + 1 < 8) p9_load(F, tb, m0 + r + 1, P9_TI(r + 1, 0), P9_TI(r + 1, 1), P9_TI(r + 1, 2), P9_TI(r + 1, 3), R[(r + 1) & 1], lane);
            const P9Row& C = R[r & 1];
            const float g1s = __uint_as_float((unsigned)P9_TI(r, 4)) * (1.f / Y_SCALE), g2s = __uint_as_float((unsigned)P9_TI(r, 5)) * (1.f / Y_SCALE);
            f32x4 v[8]; float s = 0.f;
#pragma unroll
            for (int j = 0; j < 8; ++j) { const u32x2 xb = C.x[j]; const int a = C.ya[j], c = C.yc[j];
                f32x4 xv; xv[0] = __uint_as_float(xb.x << 16); xv[1] = __uint_as_float(xb.x & 0xffff0000u); xv[2] = __uint_as_float(xb.y << 16); xv[3] = __uint_as_float(xb.y & 0xffff0000u);
                f32x4 ya, yc;
                { const f32x2 lo = __builtin_amdgcn_cvt_pk_f32_fp8(a, false), hi = __builtin_amdgcn_cvt_pk_f32_fp8(a, true); ya[0] = lo[0]; ya[1] = lo[1]; ya[2] = hi[0]; ya[3] = hi[1]; }
                { const f32x2 lo = __builtin_amdgcn_cvt_pk_f32_fp8(c, false), hi = __builtin_amdgcn_cvt_pk_f32_fp8(c, true); yc[0] = lo[0]; yc[1] = lo[1]; yc[2] = hi[0]; yc[3] = hi[1]; }
                v[j] = xv + gt[j] * (ya * g1s + yc * g2s);
                s += (v[j][0] * v[j][0] + v[j][1] * v[j][1]) + (v[j][2] * v[j][2] + v[j][3] * v[j][3]); }
            const float rstd = 1.f / sqrtf(wave_sum(s) * (1.f / DM) + EPS);
            float* xr = F.out + (size_t)(m0 + r) * DM;
#pragma unroll
            for (int j = 0; j < 8; ++j) *(f32x4*)(xr + 256 * j + 4 * lane) = v[j] * rstd * gf[j];
        }
#undef P9_TI
    }
}

struct Args { const float* in[19]; float* out; unsigned char* ws; int ph_lo, ph_hi; };
constexpr int N_PHASES = 10;
__global__ void __launch_bounds__(NTHR, 2) fwd(Args args) {
    extern __shared__ __attribute__((aligned(16))) unsigned char lds_raw[];
    Frame F;
    F.lds = (LAS unsigned char*)lds_raw;
    F.wave = __builtin_amdgcn_readfirstlane((int)threadIdx.x >> 6); F.lane = lane_now(); F.tid = F.wave * 64 + F.lane; F.G = gridDim.x; F.bid = blockIdx.x; F.vcu = (F.G % 8 == 0) ? (F.bid % 8) * (F.G / 8) + F.bid / 8 : F.bid;
    unsigned char* ws = args.ws;
    F.ctl = (unsigned*)(ws + WS_CTL);
    F.x = args.in[0]; F.c = args.in[1]; F.w_ada = args.in[2]; F.b_ada = args.in[3]; F.g_mix = args.in[4]; F.w_in = args.in[5]; F.w_pool = args.in[6]; F.pool_scale = args.in[7];
    F.rel_bias = args.in[8]; F.w_out = args.in[9]; F.g_ffn = args.in[10]; F.w_group = args.in[11]; F.b_group = args.in[12]; F.w_router = args.in[13]; F.b_router = args.in[14];
    F.w_gate = args.in[15]; F.w_up = args.in[16]; F.w_down = args.in[17]; F.g_final = args.in[18];
    F.out = args.out; F.mod = (float*)(ws + WS_MOD);
    F.RW = (bf16*)(ws + WS_RW); F.WpT = (bf16*)(ws + WS_WPT); F.WinP = (bf16*)(ws + WS_WINP); F.Win = (bf16*)(ws + WS_WIN); F.Wout = (bf16*)(ws + WS_WOUT);
    F.Wgu = (bf16*)(ws + WS_WGU); F.Wd = (bf16*)(ws + WS_WD); F.H = (bf16*)(ws + WS_H); F.P = (bf16*)(ws + WS_P); F.CAT = (bf16*)(ws + WS_CAT); F.Y = (bf16*)(ws + WS_Y); F.A = (bf16*)(ws + WS_A); F.X1 = (bf16*)(ws + WS_X1);
    F.MASK = (unsigned*)(ws + WS_MASK); F.TOKLIST = (int*)(ws + WS_TOKLIST); F.TOKINFO = (unsigned*)(ws + WS_TOKINFO);
    volatile LAS unsigned* barw = (volatile LAS unsigned*)(F.lds + MISC_BASE + MO_BARW);
    if (F.tid < 4) barw[F.tid] = 0u;
    __syncthreads();
    XcdBarrier bar; bar.bar = F.ctl + CW_BAR; bar.x = 0; bar.st = nullptr; bar.wave = F.wave;
    if (MK_N_LAUNCHES == 1) bar = xcd_barrier_post(F.ctl + CW_BAR, barw, F.wave);
    const int lo = args.ph_lo, hi = args.ph_hi;
#ifndef PH_MASK
#define PH_MASK 0x3ff
#endif
#define IN(k) (((PH_MASK >> (k)) & 1) && lo <= (k) && (k) < hi && (F.lane = lane_now(), F.tid = F.wave * 64 + F.lane, true))
#define SEAM(k) do { if (MK_N_LAUNCHES == 1 && IN(k) && IN((k) + 1)) xcd_barrier(bar); } while (0)
    LAS unsigned char* ring = F.lds;

#define REP(k) for (int rep_ = 0; rep_ < ((PROBE_DUP == (k) && ((k) == 0 || (k) == 6 || (k) == 9 || (k) == 11)) ? 2 : 1); ++rep_)
#define NREP(k) ((PROBE_DUP == (k)) ? 2 : 1)
    if (IN(0)) { REP(0) { p0_prologue(F, CW_Q0 + 64 * rep_); } SEAM(0); }
    if (IN(1)) {
        REP(1) {
        { pg8::Gemm g{F.WpT, F.WinP, 256, 256, 1024, nullptr}; pg8::FoldOrder S{F.G, F.bid}; pg8::EpiBf16 E{F.Win, DM, F.pool_scale, 1.f};
          pg8::gemm_phase<pg8::EpiBf16, pg8::FoldOrder, false, true>(ring, g, S, E, F.wave); }
        REP(11) { p1_norm_rows(F, F.x, F.g_mix, 0, DM, F.H); }
        }
        SEAM(1);
    }
    if (IN(2)) {
        REP(2) {
        pg8::Gemm g{F.H, F.Win, DM, DM, DM, nullptr}; pg8::StaticOrder S; S.init(NTOK, PLD, F.G, F.bid); S.reps = NREP(2); pg8::EpiBf16 E{F.P, PLD, nullptr, 1.f};
        pg8::gemm_phase<pg8::EpiBf16, pg8::StaticOrder, false, true>(ring, g, S, E, F.wave);
        }
        p0_deferred(F);
        SEAM(2);
    }
    if (IN(3)) { if (PROBE_DUP == 3) { p3_window(F); p3_indexer(F); } if (PROBE_DUP == 33) p3_window(F); p3_window(F); p3_indexer(F); SEAM(3); }
    if (IN(4)) { p4_attention(F, PROBE_DUP == 4 ? 512 : 256); SEAM(4); }
    if (IN(5)) {
        REP(5) {
        pg8::Gemm g{F.CAT, F.Wout, DM, DM, DM, nullptr}; pg8::StaticOrder S; S.init(NTOK, DM, F.G, F.bid); S.reps = NREP(5); pg8::EpiResid E{F.x, F.X1, F.mod + 2 * DM};
        pg8::gemm_phase<pg8::EpiResid, pg8::StaticOrder, false, true>(ring, g, S, E, F.wave);
        }
        SEAM(5);
    }
    if (IN(6)) { if (PROBE_DUP == 6) { REP(6) { p6_norm_router(F, rep_ == 0); } p0_late(F); } else p6_side_by_side(F); SEAM(6); }
    if (IN(7)) {
        moe_tables(F); p7_rowtab(F, NREP(7));
        REP(7) {
        pg8::Gemm g{F.H, F.Wgu, DM / 2, DM / 2, DM / 2, (const LAS unsigned*)(F.lds + MISC_BASE + MO_ROWTAB)};
        pg8::GroupedOrder S{moe_tabs(F), 4, F.G, F.vcu, 1024, NREP(7)}; pg8::EpiGateUp E{(unsigned char*)F.A, 1.f / WGU_SCALE};
        pg8::gemm_phase<pg8::EpiGateUp, pg8::GroupedOrder, true, true, true>(ring, g, S, E, F.wave);
        }
        SEAM(7);
    }
    if (IN(8)) {
        if (MK_N_LAUNCHES != 1) moe_tables(F);
        REP(8) {
        pg8::Gemm g{F.A, F.Wd, DEXP / 2, DEXP / 2, DEXP / 2, nullptr};
        pg8::GroupedOrder S{moe_tabs(F), 8, F.G, F.vcu, DM, NREP(8)}; pg8::EpiFp8 E{(unsigned char*)F.Y, DM, Y_SCALE / WD_SCALE};
        pg8::gemm_phase<pg8::EpiFp8, pg8::GroupedOrder, false, P8_ALIGN, true>(ring, g, S, E, F.wave);
        }
        SEAM(8);
    }
    if (IN(9)) { if (MK_N_LAUNCHES != 1) moe_tables(F); REP(9) { p9_final(F); } }
#undef REP
#undef NREP
#undef IN
#undef SEAM
}

extern "C" void kernel_launch(void* const* d_in, const int* in_sizes, int n_in, void* d_out, int out_size, void* d_ws, size_t ws_size, hipStream_t stream) {
    static int grid = 0;
    if (grid == 0) {
        if (n_in != 19 || in_sizes[0] != NTOK * DM || out_size != NTOK * DM || ws_size < WS_END) {
            fprintf(stderr, "kernel_launch: unexpected shapes (n_in %d, in0 %d, out %d, ws %zu); nothing launched\n", n_in, n_in > 0 ? in_sizes[0] : -1, out_size, ws_size); grid = -1; return; }
        int dev = 0, cus = 0;
        if (hipGetDevice(&dev) != hipSuccess || hipDeviceGetAttribute(&cus, hipDeviceAttributeMultiprocessorCount, dev) != hipSuccess || cus < 128) { fprintf(stderr, "kernel_launch: device query failed or too few CUs (%d)\n", cus); grid = -1; return; }
        if (hipFuncSetAttribute((const void*)fwd, hipFuncAttributeMaxDynamicSharedMemorySize, LDS_TOTAL) != hipSuccess) { fprintf(stderr, "kernel_launch: hipFuncSetAttribute failed\n"); grid = -1; return; }
        int per_cu = 0;
        if (hipOccupancyMaxActiveBlocksPerMultiprocessor(&per_cu, (const void*)fwd, NTHR, LDS_TOTAL) != hipSuccess || per_cu < 1) fprintf(stderr, "kernel_launch: note: occupancy query reports %d blocks per CU\n", per_cu);
        (void)hipGetLastError();
        grid = cus;
    }
    if (grid < 0) return;
    if (hipMemsetAsync((char*)d_ws + WS_CTL, 0, CTL_ZERO_BYTES, stream) != hipSuccess) { fprintf(stderr, "kernel_launch: memset failed\n"); return; }
    Args a{};
    for (int i = 0; i < 19; ++i) a.in[i] = (const float*)d_in[i];
    a.out = (float*)d_out; a.ws = (unsigned char*)d_ws;
    const int nl = MK_N_LAUNCHES;
    for (int li = 0; li < nl; ++li) {
        a.ph_lo = (nl == 1) ? 0 : li; a.ph_hi = (nl == 1) ? N_PHASES : li + 1;
        hipLaunchKernelGGL(fwd, dim3(grid), dim3(NTHR), LDS_TOTAL, stream, a);
        const hipError_t le = hipPeekAtLastError();
        if (le != hipSuccess) { fprintf(stderr, "kernel_launch: launch %d failed: %s\n", li, hipGetErrorName(le)); break; }
    }
}
```

```cpp
#include <hip/hip_runtime.h>
#include <cstdio>
#include <cstdint>

#ifndef MK_N_LAUNCHES
#define MK_N_LAUNCHES 1
#endif

#ifndef P8_ALIGN
#define P8_ALIGN true
#endif
#ifndef PROBE_DUP
#define PROBE_DUP -1
#endif
#define GAS __attribute__((address_space(1)))
#define LAS __attribute__((address_space(3)))
typedef unsigned short bf16;
typedef short bf16x8 __attribute__((ext_vector_type(8)));
typedef short s16x4 __attribute__((ext_vector_type(4)));
typedef float f32x4 __attribute__((ext_vector_type(4)));
typedef float f32x2 __attribute__((ext_vector_type(2)));
typedef float f32x16 __attribute__((ext_vector_type(16)));
typedef unsigned u32x4 __attribute__((ext_vector_type(4)));
typedef unsigned u32x2 __attribute__((ext_vector_type(2)));

constexpr int DM = 2048, NB = 8, SEQ = 2048, NTOK = NB * SEQ;
constexpr int POOLW = 1024, NHEAD = 8, HD = 128, NKV = 2, IDXH = 16, IDXD = 64, TOPK = 256;
constexpr int PIN = 3664, PLD = 3840;
constexpr int C_U = 0, C_Q = 1024, C_K = 2048, C_V = 2304, C_QI = 2560, C_KI = 3584, C_WI = 3648;
constexpr int NEXP = 32, DEXP = 512, NGRP = 4, EPG = 8;
constexpr int MAXSLOT = 40960;
constexpr float EPS = 1e-6f;

constexpr size_t MiB = 1u << 20;
constexpr size_t WS_CTL = 0, CTL_ZERO_BYTES = 1 * MiB;
constexpr size_t WS_MOD = 1 * MiB;
constexpr size_t WS_RW = 1 * MiB + 512 * 1024;
constexpr size_t WS_TOKINFO = 2 * MiB;
constexpr size_t WS_TOKLIST = 3 * MiB;
constexpr size_t WS_WPT = 5 * MiB;
constexpr size_t WS_MASK = 6 * MiB;
constexpr size_t WS_WINP = 10 * MiB;
constexpr size_t WS_WIN = 16 * MiB;
constexpr size_t WS_WOUT = 32 * MiB;
constexpr size_t WS_WGU = 40 * MiB;
constexpr size_t WS_WD = 168 * MiB;
constexpr size_t WS_H = 232 * MiB;
constexpr size_t WS_P = 296 * MiB;
constexpr size_t WS_CAT = 416 * MiB;
constexpr size_t WS_Y = 296 * MiB;
constexpr size_t WS_A = 480 * MiB;
constexpr size_t WS_X1 = 520 * MiB;
constexpr size_t WS_END = 584 * MiB;
static_assert(WS_Y + (size_t)MAXSLOT * DM * 2 <= WS_A && WS_P + (size_t)NTOK * PLD * 2 <= WS_CAT && WS_A + (size_t)MAXSLOT * DEXP * 2 <= WS_X1 && WS_X1 + (size_t)NTOK * DM * 2 <= WS_END, "ws map");
constexpr int CW_TMO = 0, CW_Q0 = 64, CW_BAR = 4096, CW_ECNT = 16384;

constexpr int RING_BYTES = 131072;
constexpr int MISC_OFF = RING_BYTES;
constexpr int LDS_BYTES = 147456;
constexpr int NWAVES = 8, NTHR = 512;

#define LDS_WAIT() asm volatile("s_waitcnt lgkmcnt(0)" ::: "memory")
#define VM_WAIT() asm volatile("s_waitcnt vmcnt(0)" ::: "memory")
__device__ __forceinline__ unsigned cvt_pk_bf16(float lo, float hi) { unsigned r; asm volatile("v_cvt_pk_bf16_f32 %0, %1, %2" : "=v"(r) : "v"(lo), "v"(hi)); return r; }
__device__ __forceinline__ float bf2f(bf16 v) { return __builtin_bit_cast(float, (unsigned)v << 16); }
__device__ __forceinline__ float wave_sum(float v) {
#pragma unroll
    for (int o = 1; o < 64; o <<= 1) v += __shfl_xor(v, o);
    return v;
}

__device__ __forceinline__ int lane_now() { int l; asm volatile("v_mbcnt_lo_u32_b32 %0, -1, 0\n\tv_mbcnt_hi_u32_b32 %0, -1, %0" : "=v"(l)); return l; }
namespace pg8 {
constexpr int BM = 256, BK = 64, HALF = 128, HTB = HALF * BK * 2, STAGE_BYTES = 8 * HTB, NXCD = 8, WGM = 4;
__host__ __device__ __forceinline__ int lds_byte(int r, int c) { const int st = (r >> 4) * 2 + (c >> 5), rr = r & 15, cc = c & 31, ob = rr * 64 + cc * 2; return st * 1024 + (ob ^ (((ob >> 9) & 1) << 5)); }
__host__ __device__ __forceinline__ void stage_rc(int b, int& R, int& C) { const int st = b / 1024, sb = b % 1024, swz = sb ^ (((sb >> 9) & 1) << 5); R = (st >> 1) * 16 + swz / 64; C = (st & 1) * 32 + (swz % 64) / 2; }
__host__ __device__ __forceinline__ int perm32(int rho) { const int n = rho >> 4, i = rho & 15; return 8 * (i >> 2) + 4 * n + (i & 3); }

typedef int v4i_t __attribute__((ext_vector_type(4)));
typedef int v8i_t __attribute__((ext_vector_type(8)));
struct Unit { int pm, pn, e, ord, half; };
struct Gemm { const bf16* A; const bf16* Bt; int K, lda, ldb; const LAS unsigned* rowtab; };

struct StaticOrder {
    int nM, nN, nwg, G, c, reps;
    __device__ void init(int M, int N, int G_, int c_) { nM = M / BM; nN = N / BM; nwg = nM * nN; G = G_; c = c_; reps = 1; }
    __device__ bool next(int i, Unit& u) const {
        const long L = (long)i * G + c; if (L >= (long)nwg * reps) return false;
        int wgid = (int)(L % nwg); { const int q = nwg / NXCD, r = nwg % NXCD, xcd = wgid % NXCD, off = wgid / NXCD; wgid = (xcd < r ? xcd * (q + 1) : r * (q + 1) + (xcd - r) * q) + off; }
        const int nig = WGM * nN, gid = wgid / nig, fm = gid * WGM, gsz = (nM - fm) < WGM ? (nM - fm) : WGM;
        u.pm = fm + ((wgid % nig) % gsz); u.pn = (wgid % nig) / gsz; u.e = 0; u.ord = i; u.half = 0; return true;
    }
    __device__ __forceinline__ size_t b_off(const Unit& u, int ldb) const { return (size_t)u.pn * BM * ldb * 2; }
};
struct FoldOrder {
    int G, c;
    __device__ bool next(int i, Unit& u) const { const int L = i * G + c; if (L >= 32) return false; u.pm = L >> 3; u.pn = L & 7; u.e = 0; u.ord = i; u.half = 0; return true; }
    __device__ __forceinline__ size_t b_off(const Unit& u, int ldb) const { return ((size_t)u.pn * BM * ldb + (size_t)u.pm * 256) * 2; }
};
struct MoeTabs { const LAS int* tb; const LAS int* tf; const LAS int* hl; };
__device__ __forceinline__ bool moe_unit(const MoeTabs& T, int NT, int L, int reps, int& pm, int& pn, int& e, int& half) {
    const int nf = T.tf[NEXP], nh = T.hl[NEXP], total = (nf + nh) * NT;
    if (L >= total * reps) return false;
    L %= total;
    const int mt = L / NT; pn = L - mt * NT;
    if (mt < nf) { int x = 0; while (x < NEXP - 1 && T.tf[x + 1] <= mt) ++x; e = x; pm = T.tb[x] + (mt - T.tf[x]); half = 0; }
    else { e = T.hl[mt - nf]; pm = T.tb[e + 1] - 1; half = 1; }
    return true;
}
struct GroupedOrder {
    MoeTabs T; int NT, G, c, rows_per_e, reps;
    __device__ bool next(int i, Unit& u) const { u.ord = i; return moe_unit(T, NT, i * G + c, reps, u.pm, u.pn, u.e, u.half); }
    __device__ __forceinline__ size_t b_off(const Unit& u, int ldb) const { return ((size_t)u.e * rows_per_e + (size_t)u.pn * BM) * ldb * 2; }
};

template <class Epi, class Sched, bool GATHER, bool ALIGN_EPI, bool FP8 = false>
__device__ __forceinline__ void gemm_phase(LAS unsigned char* lds, const Gemm g, const Sched& S, const Epi& E, const int wid) {
    const int lane = lane_now(), tid = wid * 64 + lane, wr = wid >> 2, wc = wid & 3, fr = lane & 15, fq = lane >> 4;
    const int K = g.K, nt = K / BK;
    int Rr[2], Cc[2];
    unsigned voffB[2];
    unsigned cva[2][2], nva[2][2];
#pragma unroll
    for (int i = 0; i < 2; ++i) { int R, C; stage_rc(tid * 16 + i * 8192, R, C); Rr[i] = R; Cc[i] = C; const int Rb = Epi::PERM ? ((R & ~31) + perm32(R & 31)) : R;
        voffB[i] = (unsigned)(Rb * g.ldb + C) * 2u; }
    const size_t kstep = (size_t)(BK * 2);
    const unsigned hstepA = (unsigned)HALF * g.lda * 2u;
    const size_t hstepB = (size_t)HALF * g.ldb * 2;
    const unsigned ldsw = (unsigned)wid * 1024u;
    const int aoff = lds_byte(wr * 64 + fr, fq * 8), boff = lds_byte(wc * 32 + fr, fq * 8);
#define PG8_SA(b, h) (((b) * 2 + (h)) * HTB)
#define PG8_SB(b, h) ((4 + (b) * 2 + (h)) * HTB)
#define PG8_STAGE(bufoff, gbase, v0, v1) do { \
        __builtin_amdgcn_global_load_lds((const unsigned*)((const char*)(gbase) + (v0)), (LAS unsigned*)(lds + (bufoff) + ldsw), 16, 0, 0); \
        __builtin_amdgcn_global_load_lds((const unsigned*)((const char*)(gbase) + (v1)), (LAS unsigned*)(lds + (bufoff) + ldsw + 8192), 16, 0, 0); } while (0)
#define PG8_STAGE_B(bufoff, gbase) PG8_STAGE(bufoff, gbase, voffB[0], voffB[1])
#define PG8_LD8(base) __builtin_shufflevector(*(const LAS v4i_t*)(base), *(const LAS v4i_t*)((base) + 1024), 0, 1, 2, 3, 4, 5, 6, 7)
#define PG8_LDA(dst, b, h) do { _Pragma("unroll") for (int m = 0; m < 4; ++m) dst[m] = PG8_LD8(lds + PG8_SA(b, h) + aoff + m * 2048); } while (0)
#define PG8_LDB(dst, b, h) do { _Pragma("unroll") for (int n = 0; n < 2; ++n) dst[n] = PG8_LD8(lds + PG8_SB(b, h) + boff + n * 2048); } while (0)
#define PG8_LO(x) __builtin_bit_cast(bf16x8, __builtin_shufflevector((x), (x), 0, 1, 2, 3))
#define PG8_HI(x) __builtin_bit_cast(bf16x8, __builtin_shufflevector((x), (x), 4, 5, 6, 7))
#define PG8_MMA(ai, bj, At, Bt) do { __builtin_amdgcn_s_setprio(1); _Pragma("unroll") for (int m = 0; m < 4; ++m) _Pragma("unroll") for (int n = 0; n < 2; ++n) { \
        if constexpr (FP8) asm volatile("v_mfma_scale_f32_16x16x128_f8f6f4 %0, %1, %2, %0, %3, %3 op_sel_hi:[0,0,0]" : "+v"(acc[ai][bj][m][n]) : "v"(Bt[n]), "v"(At[m]), "v"(sc8));   \
        else { acc[ai][bj][m][n] = __builtin_amdgcn_mfma_f32_16x16x32_bf16(PG8_LO(Bt[n]), PG8_LO(At[m]), acc[ai][bj][m][n], 0, 0, 0); \
               acc[ai][bj][m][n] = __builtin_amdgcn_mfma_f32_16x16x32_bf16(PG8_HI(Bt[n]), PG8_HI(At[m]), acc[ai][bj][m][n], 0, 0, 0); } } \
        __builtin_amdgcn_s_setprio(0); } while (0)
#define PG8_WAIT_V(n) asm volatile("s_waitcnt vmcnt(" #n ")" ::: "memory")
#define PG8_WAIT_L(n) asm volatile("s_waitcnt lgkmcnt(" #n ")" ::: "memory")
#define PG8_BAR __builtin_amdgcn_s_barrier()
#define PG8_SCHED __builtin_amdgcn_sched_barrier(0)
#define PG8_AOFF(dst, u) do { _Pragma("unroll") for (int h_ = 0; h_ < 2; ++h_) _Pragma("unroll") for (int i_ = 0; i_ < 2; ++i_) { \
        if constexpr (GATHER) dst[h_][i_] = g.rowtab[(u).ord * 256 + h_ * HALF + Rr[i_]] + (unsigned)Cc[i_] * 2u; \
        else dst[h_][i_] = (unsigned)(Rr[i_] * g.lda + Cc[i_]) * 2u + (unsigned)h_ * hstepA; } } while (0)
    Unit cur, nxt; int ui = 0;
    if (!S.next(0, cur)) return;
    const int sc8 = 0x7f7f7f7f;
    f32x4 acc[2][2][4][2];
#pragma unroll
    for (int a = 0; a < 2; ++a)
#pragma unroll
        for (int b = 0; b < 2; ++b)
#pragma unroll
            for (int m = 0; m < 4; ++m)
#pragma unroll
                for (int n = 0; n < 2; ++n) acc[a][b][m][n] = (f32x4){0.f, 0.f, 0.f, 0.f};
    v8i_t At[4], B0[2], B1[2];
    const size_t tstepA = (size_t)BM * g.lda * 2;
    const char* cA = GATHER ? (const char*)g.A : (const char*)g.A + (size_t)cur.pm * tstepA;
    const char* cB = (const char*)g.Bt + S.b_off(cur, g.ldb);
    PG8_AOFF(cva, cur);
#pragma unroll
    for (int h_ = 0; h_ < 2; ++h_)
#pragma unroll
        for (int i_ = 0; i_ < 2; ++i_) nva[h_][i_] = cva[h_][i_];
    if constexpr (GATHER) { LDS_WAIT(); }
    PG8_STAGE_B(PG8_SB(0, 0), cB); PG8_STAGE_B(PG8_SB(0, 1), cB + hstepB); PG8_STAGE(PG8_SA(0, 0), cA, cva[0][0], cva[0][1]); PG8_STAGE(PG8_SA(0, 1), cA, cva[1][0], cva[1][1]);
    if (wr == 1) PG8_BAR;
    PG8_WAIT_V(2); PG8_BAR;
    PG8_STAGE_B(PG8_SB(1, 0), cB + kstep); PG8_STAGE(PG8_SA(1, 0), cA + kstep, cva[0][0], cva[0][1]); PG8_STAGE_B(PG8_SB(1, 1), cB + hstepB + kstep);
    PG8_WAIT_V(6); PG8_BAR;
    for (;;) {
        const bool has_next = S.next(ui + 1, nxt);
        const bool full = (cur.half == 0);
        const char* nA = GATHER ? cA : (has_next ? (const char*)g.A + (size_t)nxt.pm * tstepA : cA);
        const char* nB = has_next ? (const char*)g.Bt + S.b_off(nxt, g.ldb) : cB;
#pragma nounroll
        for (int t = 0; t < nt; t += 2) {
            const bool last = (t == nt - 2);
            const char* a1 = cA + (size_t)(t + 1) * kstep;
            const char* a2 = last ? nA : cA + (size_t)(t + 2) * kstep; const char* b2 = last ? nB : cB + (size_t)(t + 2) * kstep;
            const char* a3 = a2 + kstep; const char* b3 = b2 + kstep;
            if (last) { if (has_next) { PG8_AOFF(nva, nxt); } else {
#pragma unroll
                for (int h_ = 0; h_ < 2; ++h_)
#pragma unroll
                    for (int i_ = 0; i_ < 2; ++i_) nva[h_][i_] = cva[h_][i_]; }
                if constexpr (GATHER) { LDS_WAIT(); } }
            unsigned v2[2][2];
#pragma unroll
            for (int h_ = 0; h_ < 2; ++h_)
#pragma unroll
                for (int i_ = 0; i_ < 2; ++i_) v2[h_][i_] = last ? nva[h_][i_] : cva[h_][i_];
            PG8_LDB(B0, 0, 0); PG8_LDB(B1, 0, 1); PG8_SCHED; PG8_LDA(At, 0, 0); PG8_STAGE(PG8_SA(1, 1), a1, cva[1][0], cva[1][1]);
            PG8_WAIT_V(8); PG8_WAIT_L(0); PG8_BAR; PG8_MMA(0, 0, At, B0); PG8_MMA(0, 1, At, B1); PG8_BAR; PG8_SCHED;
            PG8_LDA(At, 0, 1); PG8_STAGE_B(PG8_SB(0, 0), b2); PG8_STAGE_B(PG8_SB(0, 1), b2 + hstepB); PG8_STAGE(PG8_SA(0, 0), a2, v2[0][0], v2[0][1]);
            PG8_WAIT_V(8); PG8_WAIT_L(0); PG8_BAR; if (full) { PG8_MMA(1, 0, At, B0); PG8_MMA(1, 1, At, B1); } PG8_BAR; PG8_SCHED;
            PG8_LDB(B0, 1, 0); PG8_LDB(B1, 1, 1); PG8_SCHED; PG8_LDA(At, 1, 0); PG8_STAGE(PG8_SA(0, 1), a2, v2[1][0], v2[1][1]);
            PG8_WAIT_V(8); PG8_WAIT_L(0); PG8_BAR; PG8_MMA(0, 0, At, B0); PG8_MMA(0, 1, At, B1); PG8_BAR; PG8_SCHED;
            PG8_LDA(At, 1, 1); PG8_STAGE_B(PG8_SB(1, 0), b3); PG8_STAGE_B(PG8_SB(1, 1), b3 + hstepB); PG8_STAGE(PG8_SA(1, 0), a3, v2[0][0], v2[0][1]);
            PG8_WAIT_V(8); PG8_WAIT_L(0); PG8_BAR; if (full) { PG8_MMA(1, 0, At, B0); PG8_MMA(1, 1, At, B1); } PG8_BAR; PG8_SCHED;
        }
        if constexpr (FP8) asm volatile("s_nop 15\n\ts_nop 15" ::: "memory");
        if constexpr (ALIGN_EPI) { if (wr == 0) PG8_BAR; }
        E(acc, cur, wr, wc, fr, fq);
        if (!has_next) break;
#pragma unroll
        for (int a = 0; a < 2; ++a)
#pragma unroll
            for (int b = 0; b < 2; ++b)
#pragma unroll
                for (int m = 0; m < 4; ++m)
#pragma unroll
                    for (int n = 0; n < 2; ++n) acc[a][b][m][n] = (f32x4){0.f, 0.f, 0.f, 0.f};
        cur = nxt; cA = nA; cB = nB; ++ui;
#pragma unroll
        for (int h_ = 0; h_ < 2; ++h_)
#pragma unroll
            for (int i_ = 0; i_ < 2; ++i_) cva[h_][i_] = nva[h_][i_];
        if constexpr (ALIGN_EPI) { if (wr == 1) PG8_BAR; }
    }
    PG8_WAIT_V(0);
    if constexpr (!ALIGN_EPI) { if (wr == 0) PG8_BAR; }
    PG8_BAR;
#undef PG8_SA
#undef PG8_SB
#undef PG8_STAGE
#undef PG8_STAGE_B
#undef PG8_LDA
#undef PG8_LDB
#undef PG8_MMA
#undef PG8_LD8
#undef PG8_LO
#undef PG8_HI
#undef PG8_WAIT_V
#undef PG8_WAIT_L
#undef PG8_BAR
#undef PG8_SCHED
#undef PG8_AOFF
}

struct EpiBf16 {
    static constexpr bool PERM = true;
    bf16* O; int ldc; const float* rowscale; float oscale;
    __device__ __forceinline__ void operator()(const f32x4 (&acc)[2][2][4][2], const Unit& u, int wr, int wc, int fr, int fq) const {
        const int row0 = u.pm * BM + wr * 64 + fr, col0 = u.pn * BM + wc * 32 + 8 * fq;
#pragma unroll
        for (int ai = 0; ai < 2; ++ai)
#pragma unroll
            for (int m = 0; m < 4; ++m) { const int row = row0 + ai * HALF + m * 16; bf16* rowp = O + (size_t)row * ldc + col0; const float s = rowscale ? rowscale[row] * oscale : oscale;
#pragma unroll
                for (int bj = 0; bj < 2; ++bj) { const f32x4 v0 = acc[ai][bj][m][0] * s, v1 = acc[ai][bj][m][1] * s;
                    u32x4 w; w.x = cvt_pk_bf16(v0[0], v0[1]); w.y = cvt_pk_bf16(v0[2], v0[3]); w.z = cvt_pk_bf16(v1[0], v1[1]); w.w = cvt_pk_bf16(v1[2], v1[3]);
                    *(u32x4*)(rowp + bj * HALF) = w; } }
    }
};
struct EpiFp8 {
    static constexpr bool PERM = true;
    unsigned char* O; int ldc; float oscale;
    __device__ __forceinline__ void operator()(const f32x4 (&acc)[2][2][4][2], const Unit& u, int wr, int wc, int fr, int fq) const {
        const int row0 = u.pm * BM + wr * 64 + fr, col0 = u.pn * BM + wc * 32 + 8 * fq;
#pragma unroll
        for (int ai = 0; ai < 2; ++ai)
#pragma unroll
            for (int m = 0; m < 4; ++m) { unsigned char* rowp = O + (size_t)(row0 + ai * HALF + m * 16) * ldc + col0;
#pragma unroll
                for (int bj = 0; bj < 2; ++bj) { const f32x4 v0 = acc[ai][bj][m][0] * oscale, v1 = acc[ai][bj][m][1] * oscale; u32x2 w;
                    { int p = __builtin_amdgcn_cvt_pk_fp8_f32(v0[0], v0[1], 0, false); p = __builtin_amdgcn_cvt_pk_fp8_f32(v0[2], v0[3], p, true); w.x = (unsigned)p; }
                    { int p = __builtin_amdgcn_cvt_pk_fp8_f32(v1[0], v1[1], 0, false); p = __builtin_amdgcn_cvt_pk_fp8_f32(v1[2], v1[3], p, true); w.y = (unsigned)p; }
                    *(u32x2*)(rowp + bj * HALF) = w; } }
    }
};
struct EpiResid {
    static constexpr bool PERM = true;
    const float* X; bf16* X1; const float* gate;
    __device__ __forceinline__ void operator()(const f32x4 (&acc)[2][2][4][2], const Unit& u, int wr, int wc, int fr, int fq) const {
        const int row0 = u.pm * BM + wr * 64 + fr, col0 = u.pn * BM + wc * 32 + 8 * fq;
        const float* gp = gate + (size_t)((u.pm * BM) / SEQ) * (6 * DM) + col0;
        f32x4 gv[2][2];
#pragma unroll
        for (int bj = 0; bj < 2; ++bj)
#pragma unroll
            for (int n = 0; n < 2; ++n) gv[bj][n] = *(const f32x4*)(gp + bj * HALF + n * 4);
#pragma unroll
        for (int ai = 0; ai < 2; ++ai) {
            f32x4 xv[4][2][2];
#pragma unroll
            for (int m = 0; m < 4; ++m) { const size_t ro = (size_t)(row0 + ai * HALF + m * 16) * DM + col0;
#pragma unroll
                for (int bj = 0; bj < 2; ++bj) { xv[m][bj][0] = *(const f32x4*)(X + ro + bj * HALF); xv[m][bj][1] = *(const f32x4*)(X + ro + bj * HALF + 4); } }
#pragma unroll
            for (int m = 0; m < 4; ++m) { const size_t ro = (size_t)(row0 + ai * HALF + m * 16) * DM + col0;
#pragma unroll
                for (int bj = 0; bj < 2; ++bj) {
                    const f32x4 v0 = xv[m][bj][0] + gv[bj][0] * acc[ai][bj][m][0], v1 = xv[m][bj][1] + gv[bj][1] * acc[ai][bj][m][1];
                    u32x4 w; w.x = cvt_pk_bf16(v0[0], v0[1]); w.y = cvt_pk_bf16(v0[2], v0[3]); w.z = cvt_pk_bf16(v1[0], v1[1]); w.w = cvt_pk_bf16(v1[2], v1[3]);
                    *(u32x4*)(X1 + ro + bj * HALF) = w; } }
        }
    }
};
struct EpiGateUp {
    static constexpr bool PERM = true;
    unsigned char* O; float isc;
    __device__ __forceinline__ void operator()(const f32x4 (&acc)[2][2][4][2], const Unit& u, int wr, int wc, int fr, int fq) const {
        const int row0 = u.pm * BM + wr * 64 + fr, col0 = u.pn * HALF + wc * 32 + 8 * fq;
#pragma unroll
        for (int ai = 0; ai < 2; ++ai)
#pragma unroll
            for (int m = 0; m < 4; ++m) { unsigned char* rowp = O + (size_t)(row0 + ai * HALF + m * 16) * DEXP + col0; float r[8];
#pragma unroll
                for (int n = 0; n < 2; ++n)
#pragma unroll
                    for (int j = 0; j < 4; ++j) { const float gt = acc[ai][0][m][n][j] * isc, up = acc[ai][1][m][n][j] * isc;
                        r[n * 4 + j] = gt * __builtin_amdgcn_rcpf(1.f + __builtin_amdgcn_exp2f(-1.4426950408889634f * gt)) * up; }
                u32x2 w; { int p = __builtin_amdgcn_cvt_pk_fp8_f32(r[0], r[1], 0, false); p = __builtin_amdgcn_cvt_pk_fp8_f32(r[2], r[3], p, true); w.x = (unsigned)p; }
                { int p = __builtin_amdgcn_cvt_pk_fp8_f32(r[4], r[5], 0, false); p = __builtin_amdgcn_cvt_pk_fp8_f32(r[6], r[7], p, true); w.y = (unsigned)p; }
                *(u32x2*)rowp = w; }
    }
};
}

constexpr int MISC_BASE = 139264;
constexpr int LDS_TOTAL = 159744;
constexpr int MO_BARW = 0;
constexpr int MO_TB = 256;
constexpr int MO_CNT = 768;
constexpr int MO_ROWTAB = 1024;
constexpr int MO_BIAS = 10240;
constexpr int MAXU = 8;
static_assert(MISC_BASE + MO_BIAS + 304 * 4 <= LDS_TOTAL, "lds map");

#define XB_TMO      128
#define XB_XCNT(j)  (256  + 64 * (j))
#define XB_XSUB(j)  (1280 + 64 * (j))
#define XB_XGEN(j)  (2304 + 64 * (j))
#define XB_TOP      3328
#define XB_TOPGEN   3392
#define XCD_BAR_WORDS 3456
#define XB_SPIN_CAP (1u << 18)
__device__ __forceinline__ unsigned xb_ld(unsigned* p)              { return __hip_atomic_load(p, __ATOMIC_RELAXED, __HIP_MEMORY_SCOPE_AGENT); }
__device__ __forceinline__ unsigned xb_add(unsigned* p, unsigned v) { return __hip_atomic_fetch_add(p, v, __ATOMIC_RELAXED, __HIP_MEMORY_SCOPE_AGENT); }
__device__ __forceinline__ unsigned xb_xcc_id() { return (unsigned)__builtin_amdgcn_s_getreg((3 << 11) | 20) & 0xFu; }
#define XB_SPIN(cond, bar) do { unsigned _sp = 0; while (cond) { __builtin_amdgcn_s_sleep(1); \
    if ((++_sp & 255u) == 0u) { if (xb_ld(&(bar)[XB_TMO])) break; if (_sp > XB_SPIN_CAP) { atomicAdd(&(bar)[XB_TMO], 1u); break; } } } } while (0)
struct XcdBarrier { unsigned* bar; unsigned x; volatile LAS unsigned* st; int wave; };
__device__ __forceinline__ XcdBarrier xcd_barrier_post(unsigned* bar, volatile LAS unsigned* st, int wave) {
    XcdBarrier b; b.bar = bar; b.x = xb_xcc_id(); b.st = st; b.wave = wave;
    if (wave == 0 && lane_now() == 0) (void)xb_add(&bar[XB_XCNT(b.x)], 1u);
    return b;
}
__device__ __forceinline__ void xcd_barrier_complete(unsigned* bar, unsigned x, unsigned& nloc, unsigned& nx) {
    const unsigned G = gridDim.x * gridDim.y * gridDim.z;
    unsigned sum, cnt, mine, sp = 0u;
    for (;;) {
        sum = 0u; cnt = 0u; mine = 0u;
#pragma unroll
        for (unsigned j = 0; j < 16; ++j) { const unsigned c = xb_ld(&bar[XB_XCNT(j)]); sum += c; cnt += (c > 0u) ? 1u : 0u; mine = (j == x) ? c : mine; }
        if (sum == G) break;
        __builtin_amdgcn_s_sleep(1);
        if ((++sp & 255u) == 0u) { if (xb_ld(&bar[XB_TMO])) break; if (sp > XB_SPIN_CAP) { atomicAdd(&bar[XB_TMO], 1u); break; } }
    }
    nloc = mine > 0u ? mine : 1u; nx = cnt > 0u ? cnt : 1u;
}
__device__ __forceinline__ void xcd_barrier(const XcdBarrier& b) {
    asm volatile("s_waitcnt vmcnt(0)" ::: "memory");
    __syncthreads();
    if (b.wave == 0 && lane_now() == 0) {
        unsigned* bar = b.bar;
        __builtin_amdgcn_s_waitcnt(0);
        unsigned nloc = b.st[0], nx = b.st[1];
        if (nloc == 0u) { xcd_barrier_complete(bar, b.x, nloc, nx); b.st[0] = nloc; b.st[1] = nx; }
        const unsigned old = xb_add(&bar[XB_XSUB(b.x)], 1u);
        const unsigned gen = old / nloc;
        if (old + 1u == (gen + 1u) * nloc) {
            __builtin_amdgcn_fence(__ATOMIC_RELEASE, "agent");
            asm volatile("s_waitcnt vmcnt(0)" ::: "memory");
            const unsigned og = xb_add(&bar[XB_TOP], 1u);
            const unsigned tg = og / nx;
            if (og + 1u == (tg + 1u) * nx) xb_add(&bar[XB_TOPGEN], 1u);
            else XB_SPIN(xb_ld(&bar[XB_TOPGEN]) == tg, bar);
            __builtin_amdgcn_fence(__ATOMIC_ACQUIRE, "agent");
            xb_add(&bar[XB_XGEN(b.x)], 1u);
            asm volatile("s_waitcnt vmcnt(0)" ::: "memory");
        } else {
            XB_SPIN(xb_ld(&bar[XB_XGEN(b.x)]) == gen, bar);
            __builtin_amdgcn_fence(__ATOMIC_ACQUIRE, "agent");
            asm volatile("s_waitcnt vmcnt(0)" ::: "memory");
        }
    }
    __syncthreads();
}

struct Frame {
    LAS unsigned char* lds;
    unsigned* ctl;
    int tid, lane, wave, G, bid, vcu;
    const float *x, *c, *w_ada, *b_ada, *g_mix, *w_in, *w_pool, *pool_scale, *rel_bias, *w_out, *g_ffn, *w_group, *b_group, *w_router, *b_router, *w_gate, *w_up, *w_down, *g_final;
    float* out; float* mod;
    bf16 *RW, *WpT, *WinP, *Win, *Wout, *Wgu, *Wd, *H, *P, *CAT, *Y, *A, *X1;
    unsigned* MASK; int* TOKLIST; unsigned* TOKINFO;
};

constexpr float Y_SCALE = 8.f;
constexpr float WD_SCALE = 16.f;
constexpr float WGU_SCALE = 32.f;
__device__ __forceinline__ unsigned pk4_fp8(float a, float b, float c, float d) { int p = __builtin_amdgcn_cvt_pk_fp8_f32(a, b, 0, false); p = __builtin_amdgcn_cvt_pk_fp8_f32(c, d, p, true); return (unsigned)p; }
struct P0Tile { const float* src; unsigned char* dst; int ld_src, k0, n0, nvalid, ld_dst, himul, radd, fp8; float scale; };
constexpr int P0_R0 = 32 * 44, P0_R1 = 32 * 32, P0_R2 = 32 * 256, P0_R5 = 64, P0_R6 = 512, P0_R7 = 32;
constexpr int P0_TILES = P0_R0 + P0_R1 + 3 * P0_R2 + P0_R5;
constexpr int P0_ITEMS = P0_TILES + P0_R6 + P0_R7;
constexpr int P0_DEF_E0 = 16;
constexpr int P0_OFF_START = P0_R0 + P0_R1 + 2 * P0_R2 + P0_DEF_E0 * 256, P0_OFF_LEN = (32 - P0_DEF_E0) * 256;
__device__ __forceinline__ P0Tile p0_decode(Frame& F, int it) {
    P0Tile t; t.fp8 = 0; t.scale = 1.f; t.himul = 128; t.radd = 0;
    if (it < P0_R0) { const int kb = it / 44, nb = it % 44; t.src = F.w_in; t.ld_src = PIN; t.k0 = 64 * kb; t.n0 = 1024 + 64 * nb; t.nvalid = PIN; t.dst = (unsigned char*)F.Win; t.ld_dst = DM * 2; return t; } it -= P0_R0;
    if (it < P0_R1) { const int kb = it >> 5, nb = it & 31; t.src = F.w_out; t.ld_src = DM; t.k0 = 64 * kb; t.n0 = 64 * nb; t.nvalid = DM; t.dst = (unsigned char*)F.Wout; t.ld_dst = DM * 2; return t; } it -= P0_R1;
    if (it < 2 * P0_R2) { const int up = it >= P0_R2; if (up) it -= P0_R2; const int e = it >> 8, r = it & 255, kb = r >> 3, nb = r & 7;
        t.src = (up ? F.w_up : F.w_gate) + (size_t)e * DM * DEXP; t.ld_src = DEXP; t.k0 = 64 * kb; t.n0 = 64 * nb; t.nvalid = DEXP; t.dst = (unsigned char*)F.Wgu + (size_t)e * 1024 * DM; t.ld_dst = DM;
        t.himul = 256; t.radd = up ? 128 : 0; t.fp8 = 1; t.scale = WGU_SCALE; return t; } it -= 2 * P0_R2;
    if (it < P0_R2) { const int e = it >> 8, r = it & 255, kb = r >> 5, nb = r & 31;
        t.src = F.w_down + (size_t)e * DEXP * DM; t.ld_src = DM; t.k0 = 64 * kb; t.n0 = 64 * nb; t.nvalid = DM; t.dst = (unsigned char*)F.Wd + (size_t)e * DM * DEXP; t.ld_dst = DEXP; t.fp8 = 1; t.scale = WD_SCALE; return t; } it -= P0_R2;
    { const int g = it >> 4, r = it & 15, kb = r >> 2, nb = r & 3; t.src = F.w_pool + (size_t)g * 65536; t.ld_src = 256; t.k0 = 64 * kb; t.n0 = 64 * nb; t.nvalid = 256; t.dst = (unsigned char*)(F.WpT + (size_t)g * 65536); t.ld_dst = 512; return t; }
}
__device__ __forceinline__ void p0_tile_load(const P0Tile& t, f32x4 (&v)[16], int lane) {
    const int nn = (lane & 15) * 4, kr = lane >> 4;
#pragma unroll
    for (int i = 0; i < 16; ++i) { v[i] = (f32x4){0.f, 0.f, 0.f, 0.f}; if (t.n0 + nn < t.nvalid) v[i] = *(const f32x4*)(t.src + (size_t)(t.k0 + 16 * kr + i) * t.ld_src + t.n0 + nn); }
}
__device__ __forceinline__ void p0_tile_pack(const P0Tile& t, const f32x4 (&v)[16], u32x4 (&o)[8]) {
    if (t.fp8) {
        const float sc = t.scale;
#pragma unroll
        for (int j = 0; j < 4; ++j) { u32x4 p; p.x = pk4_fp8(v[0][j] * sc, v[1][j] * sc, v[2][j] * sc, v[3][j] * sc); p.y = pk4_fp8(v[4][j] * sc, v[5][j] * sc, v[6][j] * sc, v[7][j] * sc);
            p.z = pk4_fp8(v[8][j] * sc, v[9][j] * sc, v[10][j] * sc, v[11][j] * sc); p.w = pk4_fp8(v[12][j] * sc, v[13][j] * sc, v[14][j] * sc, v[15][j] * sc); o[2 * j] = p; o[2 * j + 1] = p; }
    } else {
#pragma unroll
        for (int j = 0; j < 4; ++j) {
            o[2 * j].x = cvt_pk_bf16(v[0][j], v[1][j]); o[2 * j].y = cvt_pk_bf16(v[2][j], v[3][j]); o[2 * j].z = cvt_pk_bf16(v[4][j], v[5][j]); o[2 * j].w = cvt_pk_bf16(v[6][j], v[7][j]);
            o[2 * j + 1].x = cvt_pk_bf16(v[8][j], v[9][j]); o[2 * j + 1].y = cvt_pk_bf16(v[10][j], v[11][j]); o[2 * j + 1].z = cvt_pk_bf16(v[12][j], v[13][j]); o[2 * j + 1].w = cvt_pk_bf16(v[14][j], v[15][j]); }
    }
}
__device__ __forceinline__ void p0_tile_store(const P0Tile& t, const u32x4 (&o)[8], int lane) {
    const int nn = (lane & 15) * 4, kr = lane >> 4;
#pragma unroll
    for (int j = 0; j < 4; ++j) { const int ng = t.n0 + nn + j, row = (ng >> 7) * t.himul + (ng & 127) + t.radd;
        unsigned char* d = t.dst + (size_t)row * t.ld_dst;
        const int ko = (t.k0 + 16 * kr) << (t.fp8 ? 0 : 1);
        *(u32x4*)(d + ko) = o[2 * j];
        if (!t.fp8) *(u32x4*)(d + ko + 16) = o[2 * j + 1]; }
}
__device__ __forceinline__ void p0_small_item(Frame& F, int it) {
    const int lane = F.lane;
    if (it < P0_R6) {
        f32x4 v[4][4];
#pragma unroll
        for (int rr = 0; rr < 4; ++rr)
#pragma unroll
            for (int j = 0; j < 4; ++j) v[rr][j] = *(const f32x4*)(F.w_in + (size_t)(it * 4 + rr) * PIN + j * 256 + lane * 4);
#pragma unroll
        for (int rr = 0; rr < 4; ++rr)
#pragma unroll
            for (int j = 0; j < 4; ++j) { u32x2 o; o.x = cvt_pk_bf16(v[rr][j][0], v[rr][j][1]); o.y = cvt_pk_bf16(v[rr][j][2], v[rr][j][3]);
                *(u32x2*)(F.WinP + (size_t)(it * 4 + rr) * 1024 + j * 256 + lane * 4) = o; }
        return; } it -= P0_R6;
    {
        const int k = it * 64 + lane;
        const f32x4 g = *(const f32x4*)(F.w_group + (size_t)k * 4);
        f32x4 r[8];
#pragma unroll
        for (int q = 0; q < 8; ++q) r[q] = *(const f32x4*)(F.w_router + (size_t)k * 32 + 4 * q);
#pragma unroll
        for (int j = 0; j < 48; ++j) { float v = 0.f; if (j < 4) v = g[j]; else if (j < 36) v = r[(j - 4) >> 2][(j - 4) & 3];
            F.RW[(size_t)j * DM + k] = (bf16)(cvt_pk_bf16(v, 0.f) & 0xffffu); }
    }
}
__device__ __forceinline__ void p0_mod_item(Frame& F, int m) {
    LAS float* sil = (LAS float*)F.lds;
    LAS float* part = (LAS float*)(F.lds + 65536);
    { float cv[NB * DM / NTHR];
#pragma unroll
      for (int q = 0; q < NB * DM / NTHR; ++q) cv[q] = F.c[F.tid + q * NTHR];
#pragma unroll
      for (int q = 0; q < NB * DM / NTHR; ++q) sil[F.tid + q * NTHR] = cv[q] / (1.f + __expf(-cv[q])); }
    __syncthreads();
    const int lane = F.lane, cq = lane & 15, rs = lane >> 4, j0 = 64 * m + 4 * cq;
    f32x4 acc[NB];
#pragma unroll
    for (int b = 0; b < NB; ++b) acc[b] = (f32x4){0.f, 0.f, 0.f, 0.f};
#pragma unroll 1
    for (int i0 = 0; i0 < 64; i0 += 16) {
        f32x4 w[16];
#pragma unroll
        for (int u = 0; u < 16; ++u) w[u] = *(const f32x4*)(F.w_ada + (size_t)(256 * F.wave + 4 * (i0 + u) + rs) * (6 * DM) + j0);
        __builtin_amdgcn_sched_barrier(0);
#pragma unroll
        for (int u = 0; u < 16; ++u) { const int k = 256 * F.wave + 4 * (i0 + u) + rs;
#pragma unroll
            for (int b = 0; b < NB; ++b) acc[b] += w[u] * sil[b * DM + k];
            if ((u & 1) == 1) __builtin_amdgcn_sched_barrier(0); }
    }
#pragma unroll
    for (int b = 0; b < NB; ++b)
#pragma unroll
        for (int j = 0; j < 4; ++j) { float v = acc[b][j]; v += __shfl_xor(v, 16); v += __shfl_xor(v, 32); acc[b][j] = v; }
    if (rs == 0) {
#pragma unroll
        for (int b = 0; b < NB; ++b) *(LAS f32x4*)(part + (F.wave * NB + b) * 64 + 4 * cq) = acc[b]; }
    __syncthreads();
    { const int b = F.tid >> 6, col = F.tid & 63; float s = F.b_ada[64 * m + col];
#pragma unroll
        for (int w = 0; w < NWAVES; ++w) s += part[(w * NB + b) * 64 + col];
        F.mod[(size_t)b * (6 * DM) + 64 * m + col] = s; }
    __syncthreads();
}
__device__ __forceinline__ void p0_run(Frame& F, int r, int stride, int a0, int lenA, int b0, int lenB) {
    const int total = lenA + lenB;
#define P0_MAP(d) ((d) < lenA ? a0 + (d) : b0 + ((d) - lenA))
    f32x4 v[16]; u32x4 o[8]; bool loaded = false; P0Tile cur, nxt;
    if (r < total && P0_MAP(r) < P0_TILES) { cur = p0_decode(F, P0_MAP(r)); p0_tile_load(cur, v, F.lane); loaded = true; }
    for (int d = r; d < total; d += stride) {
        const int it = P0_MAP(d);
        if (it < P0_TILES) {
            if (!loaded) { cur = p0_decode(F, it); p0_tile_load(cur, v, F.lane); }
            p0_tile_pack(cur, v, o);
            const int dn = d + stride; loaded = false;
            if (dn < total && P0_MAP(dn) < P0_TILES) { nxt = p0_decode(F, P0_MAP(dn)); p0_tile_load(nxt, v, F.lane); loaded = true; }
            p0_tile_store(cur, o, F.lane);
            cur = nxt;
        } else p0_small_item(F, it - P0_TILES);
    }
#undef P0_MAP
}
constexpr int P0_EARLY_A = P0_R0 + P0_R1, P0_EARLY_B0 = P0_R0 + P0_R1 + 3 * P0_R2, P0_EARLY_BLEN = P0_ITEMS - P0_EARLY_B0;
__device__ __forceinline__ void p0_prologue(Frame& F, int qword) {
    (void)qword;
    __syncthreads();
    for (int m = F.bid; m < 192; m += F.G) p0_mod_item(F, m);
    const int gw = F.bid * NWAVES + F.wave;
    const int r = (F.G == 256) ? ((F.bid >= 192) ? gw - 192 * NWAVES : gw + 64 * NWAVES) : gw;
    p0_run(F, r, F.G * NWAVES, 0, P0_EARLY_A, P0_EARLY_B0, P0_EARLY_BLEN);
}
__device__ __forceinline__ void p0_late(Frame& F) {
    __syncthreads();
    const int end = (F.G == 256) ? P0_OFF_START : P0_EARLY_B0;
    p0_run(F, F.bid * NWAVES + F.wave, F.G * NWAVES, P0_EARLY_A + P0_R2, end - P0_EARLY_A - P0_R2, 0, 0);
}
__device__ __forceinline__ void p0_deferred(Frame& F) {
    if (F.G != 256 || F.bid < 192) return;
    f32x4 v[16]; u32x4 o[8]; P0Tile cur, nxt; const int w0 = (F.bid - 192) * NWAVES + F.wave;
    cur = p0_decode(F, P0_OFF_START + w0); p0_tile_load(cur, v, F.lane);
    for (int j = w0; j < P0_OFF_LEN; j += 64 * NWAVES) {
        p0_tile_pack(cur, v, o);
        if (j + 64 * NWAVES < P0_OFF_LEN) { nxt = p0_decode(F, P0_OFF_START + j + 64 * NWAVES); p0_tile_load(nxt, v, F.lane); }
        p0_tile_store(cur, o, F.lane);
        cur = nxt;
    }
}

__device__ __forceinline__ void p1_norm_rows(Frame& F, const float* xin, const float* gvec, int sh_off, int sc_off, bf16* hout) {
    const int gw = F.bid * NWAVES + F.wave, NGW = F.G * NWAVES, lane = F.lane;
    for (int grp = gw; grp < NTOK / 8; grp += NGW) {
        const int m0 = grp * 8, b = m0 / SEQ;
        const float* modb = F.mod + (size_t)b * (6 * DM);
        f32x4 gs[8], sh[8];
#pragma unroll
        for (int j = 0; j < 8; ++j) { const int col = 256 * j + 4 * lane; const f32x4 g = *(const f32x4*)(gvec + col), sc = *(const f32x4*)(modb + sc_off + col);
            gs[j] = g * (sc + 1.f); sh[j] = *(const f32x4*)(modb + sh_off + col); }
        f32x4 xa[8], xb[8];
#pragma unroll
        for (int j = 0; j < 8; ++j) xa[j] = *(const f32x4*)(xin + (size_t)m0 * DM + 256 * j + 4 * lane);
#define P1_ROW(CUR, NXT, r) do { \
            if ((r) + 1 < 8) { _Pragma("unroll") for (int j = 0; j < 8; ++j) NXT[j] = *(const f32x4*)(xin + (size_t)(m0 + (r) + 1) * DM + 256 * j + 4 * lane); } \
            float s = 0.f; \
            _Pragma("unroll") for (int j = 0; j < 8; ++j) s += (CUR[j][0] * CUR[j][0] + CUR[j][1] * CUR[j][1]) + (CUR[j][2] * CUR[j][2] + CUR[j][3] * CUR[j][3]); \
            const float rstd = 1.f / sqrtf(wave_sum(s) * (1.f / DM) + EPS); \
            bf16* orow = hout + (size_t)(m0 + (r)) * DM; \
            _Pragma("unroll") for (int j = 0; j < 8; ++j) { const f32x4 y = CUR[j] * rstd * gs[j] + sh[j]; \
                u32x2 o; o.x = cvt_pk_bf16(y[0], y[1]); o.y = cvt_pk_bf16(y[2], y[3]); *(u32x2*)(orow + 256 * j + 4 * lane) = o; } } while (0)
#pragma unroll 1
        for (int rp = 0; rp < 4; ++rp) { P1_ROW(xa, xb, 2 * rp); P1_ROW(xb, xa, 2 * rp + 1); }
#undef P1_ROW
    }
}

template <int W>
__device__ __forceinline__ void p3_window_load(Frame& F, int g, int tp, int lane, bf16x8 (&v)[W]) {
    const int m = 2 * tp + (lane >> 5), t = m & (SEQ - 1), c0 = g * 256 + 8 * (lane & 31);
    const char* up = (const char*)(F.P + (size_t)m * PLD + C_U + c0);
#pragma unroll
    for (int tau = 0; tau < W; ++tau) { const int back = (t - tau >= 0) ? tau : 0; v[tau] = *(const bf16x8*)(up - (size_t)back * (PLD * 2)); }
}
template <int W>
__device__ __forceinline__ void p3_window_finish(Frame& F, int g, int tp, int lane, const bf16x8 (&v)[W]) {
    const int m = 2 * tp + (lane >> 5), t = m & (SEQ - 1), c0 = g * 256 + 8 * (lane & 31);
    float sum[8], self[8];
#pragma unroll
    for (int j = 0; j < 8; ++j) { self[j] = bf2f((bf16)v[0][j]); sum[j] = self[j]; }
#pragma unroll
    for (int tau = 1; tau < W; ++tau) { const float wgt = (t - tau >= 0) ? 1.f : 0.f;
#pragma unroll
        for (int j = 0; j < 8; ++j) sum[j] = fmaf(wgt, bf2f((bf16)v[tau][j]), sum[j]); }
    const float inv = 1.f / (float)((t + 1) < W ? (t + 1) : W);
    u32x4 o; o.x = cvt_pk_bf16(sum[0] * inv - self[0], sum[1] * inv - self[1]); o.y = cvt_pk_bf16(sum[2] * inv - self[2], sum[3] * inv - self[3]);
    o.z = cvt_pk_bf16(sum[4] * inv - self[4], sum[5] * inv - self[5]); o.w = cvt_pk_bf16(sum[6] * inv - self[6], sum[7] * inv - self[7]);
    *(u32x4*)(F.CAT + (size_t)m * DM + c0) = o;
}
__device__ __forceinline__ void p3_window(Frame& F) {
    const int gw = F.bid * NWAVES + F.wave, NGW = F.G * NWAVES, lane = F.lane;
    for (int tp = gw; tp < NTOK / 2; tp += NGW) {
        bf16x8 v2[2], v4[4], v8[8], v16[16];
        p3_window_load<2>(F, 0, tp, lane, v2); p3_window_load<4>(F, 1, tp, lane, v4); p3_window_load<8>(F, 2, tp, lane, v8); p3_window_load<16>(F, 3, tp, lane, v16);
        p3_window_finish<2>(F, 0, tp, lane, v2); p3_window_finish<4>(F, 1, tp, lane, v4); p3_window_finish<8>(F, 2, tp, lane, v8); p3_window_finish<16>(F, 3, tp, lane, v16);
    }
}
__device__ __forceinline__ int half_sum32(int v) {
    v += __builtin_amdgcn_update_dpp(0, v, 0x128, 0xf, 0xf, false);
    v += __builtin_amdgcn_update_dpp(0, v, 0x124, 0xf, 0xf, false);
    v += __builtin_amdgcn_update_dpp(0, v, 0x122, 0xf, 0xf, false);
    v += __builtin_amdgcn_update_dpp(0, v, 0x121, 0xf, 0xf, false);
    v += __shfl_xor(v, 16);
    return v;
}
__device__ __forceinline__ float relu_asm(float x) { const int i = __builtin_bit_cast(int, x); return __builtin_bit_cast(float, i > 0 ? i : 0); }
constexpr int IDX_CH = 512;
__device__ __forceinline__ void p3_indexer_item(Frame& F, int conv_it, const bf16* Pb, unsigned* Mb, int tb, LAS unsigned char* kl, int tid, int wave, int lane) {
    const int r = lane & 31, hi = lane >> 5, t0 = tb + 2 * wave, ktd = t0 >> 5, tq = t0 + hi;
    const int nch = ((tb + 15) / IDX_CH) + 1;
    const GAS char* Pc = (const GAS char*)Pb;
    const unsigned srow = (unsigned)(tid >> 3), sch = (unsigned)(tid & 7);
    const unsigned sgo = (srow * PLD + C_KI + sch * 8) * 2u;
    const unsigned slo = srow * 128u + ((sch ^ ((srow >> 1) & 7u)) * 16u);
    bf16x8 stg[8];
#define IDX_LOAD(c) do { _Pragma("unroll") for (int i = 0; i < 8; ++i) { const GAS char* bp_ = Pc + (size_t)((c) * IDX_CH + 64 * i) * (PLD * 2); asm volatile("" : "+s"(bp_)); \
        stg[i] = *(const GAS bf16x8*)(bp_ + sgo); } } while (0)
    IDX_LOAD(0);
    bf16x8 aq[4];
    { const unsigned qoff = (unsigned)((t0 + (r >> 4)) * PLD + C_QI + (r & 15) * 64 + 8 * hi) * 2u;
#pragma unroll
      for (int j = 0; j < 4; ++j) aq[j] = *(const GAS bf16x8*)(Pc + qoff + 32 * j); }
    bf16x8 a0, a1;
    { const GAS char* w0p = Pc + (size_t)t0 * (PLD * 2) + (C_WI + 4 * hi) * 2; const GAS char* w1p = w0p + PLD * 2;
      const u32x2 x0 = *(const GAS u32x2*)w0p, x1 = *(const GAS u32x2*)(w0p + 16), y0 = *(const GAS u32x2*)w1p, y1 = *(const GAS u32x2*)(w1p + 16);
      u32x4 wa = {x0.x, x0.y, x1.x, x1.y}, wb = {y0.x, y0.y, y1.x, y1.y};
      if (r != 0) wa = (u32x4){0u, 0u, 0u, 0u};
      if (r != 4) wb = (u32x4){0u, 0u, 0u, 0u};
      a0 = *reinterpret_cast<bf16x8*>(&wa); a1 = *reinterpret_cast<bf16x8*>(&wb); }
    float key[64];
    float vmax = -__builtin_inff(), vmin = __builtin_inff(), s1 = 0.f, s2 = 0.f;
    unsigned kro[4];
#pragma unroll
    for (int j = 0; j < 4; ++j) kro[j] = (unsigned)r * 128u + ((((unsigned)(2 * j + hi)) ^ (((unsigned)r >> 1) & 7u)) * 16u);
    for (int crep = 0; crep < ((PROBE_DUP == 32) ? 2 : 1); ++crep) {
    if (crep) { IDX_LOAD(0); }
#pragma unroll
    for (int c = 0; c < SEQ / IDX_CH; ++c) {
        if (c < nch) {
            __syncthreads();
#pragma unroll
            for (int i = 0; i < 8; ++i) *(LAS bf16x8*)(kl + slo + i * 8192) = stg[i];
            __syncthreads();
            if (c + 1 < nch) IDX_LOAD(c + 1);
#pragma unroll
            for (int g = 0; g < IDX_CH / 128; ++g) {
                const int kt0 = c * (IDX_CH / 32) + 4 * g;
                if (kt0 <= ktd) {
#pragma unroll
                    for (int q = 0; q < 4; ++q) {
                        const int kt = kt0 + q; const LAS unsigned char* tl = kl + (4 * g + q) * 4096;
                        f32x16 d = {};
#pragma unroll
                        for (int j = 0; j < 4; ++j) d = __builtin_amdgcn_mfma_f32_32x32x16_bf16(aq[j], *(const LAS bf16x8*)(tl + kro[j]), d, 0, 0, 0);
                        u32x4 b0, b1;
                        b0.x = cvt_pk_bf16(relu_asm(d[0]), relu_asm(d[1])); b0.y = cvt_pk_bf16(relu_asm(d[2]), relu_asm(d[3]));
                        b0.z = cvt_pk_bf16(relu_asm(d[4]), relu_asm(d[5])); b0.w = cvt_pk_bf16(relu_asm(d[6]), relu_asm(d[7]));
                        b1.x = cvt_pk_bf16(relu_asm(d[8]), relu_asm(d[9])); b1.y = cvt_pk_bf16(relu_asm(d[10]), relu_asm(d[11]));
                        b1.z = cvt_pk_bf16(relu_asm(d[12]), relu_asm(d[13])); b1.w = cvt_pk_bf16(relu_asm(d[14]), relu_asm(d[15]));
                        asm volatile("s_nop 1" ::: "memory");
                        f32x16 e = {};
                        e = __builtin_amdgcn_mfma_f32_32x32x16_bf16(a0, *reinterpret_cast<bf16x8*>(&b0), e, 0, 0, 0);
                        e = __builtin_amdgcn_mfma_f32_32x32x16_bf16(a1, *reinterpret_cast<bf16x8*>(&b1), e, 0, 0, 0);
                        const bool ok = (kt * 32 + r <= tq);
                        const float sv = ok ? e[0] : -__builtin_inff();
                        key[kt] = sv; vmax = fmaxf(vmax, sv); vmin = fminf(vmin, ok ? e[0] : __builtin_inff());
                        { const float z0 = ok ? e[0] : 0.f; s1 += z0; s2 = fmaf(z0, z0, s2); }
                    }
                } else {
#pragma unroll
                    for (int q = 0; q < 4; ++q) key[kt0 + q] = -__builtin_inff();
                }
            }
        } else {
#pragma unroll
            for (int q = 0; q < IDX_CH / 32; ++q) key[c * (IDX_CH / 32) + q] = -__builtin_inff();
        }
    }
    }
#undef IDX_LOAD
    f32x4 cv[16];
    { const int r = conv_it & 255; const float* gsrc = F.w_gate + (size_t)(conv_it >> 8) * DM * DEXP + (size_t)(64 * (r >> 3)) * DEXP + 64 * (r & 7) + (size_t)(16 * (lane >> 4)) * DEXP + (lane & 15) * 4;
#pragma unroll
      for (int i = 0; i < 16; ++i) cv[i] = *(const f32x4*)(gsrc + (size_t)i * DEXP); }
    float T = -3.0e38f;
    const bool need = (tq + 1) > TOPK;
    for (int srep = 0; srep < ((PROBE_DUP == 31) ? 2 : 1); ++srep)
    if (__any(need)) {
#pragma unroll
        for (int o = 1; o < 32; o <<= 1) { vmax = fmaxf(vmax, __shfl_xor(vmax, o)); vmin = fminf(vmin, __shfl_xor(vmin, o)); s1 += __shfl_xor(s1, o); s2 += __shfl_xor(s2, o); }
        const float nf = (float)(tq + 1), mu = s1 / nf, sd = sqrtf(fmaxf(s2 / nf - mu * mu, 1e-20f));
        float zq; { const float pu = (float)TOPK / nf;
            const float q = fminf(pu, 1.f - pu), t = sqrtf(-2.f * __logf(fmaxf(q, 1e-6f)));
            const float zz = t - (2.515517f + t * (0.802853f + t * 0.010328f)) / (1.f + t * (1.432788f + t * (0.189269f + t * 0.001308f)));
            zq = (pu < 0.5f) ? zz : -zz; }
        const float dens = nf * 0.3989423f * __expf(-0.5f * zq * zq) / sd;
        float lo = vmin, hi = vmax, prev = mu + zq * sd, flo = (float)(tq + 1) - 255.5f, fhi = 1.f - 255.5f; int pcnt = TOPK, side = 0; bool done = !need;
        for (int it = 0; it < 96; ++it) {
            const float mid = 0.5f * lo + 0.5f * hi;
            float cand = ((it & 3) == 3) ? mid : lo + (hi - lo) * flo / (flo - fhi);
            if (it == 0) cand = prev;
            if (it == 1) cand = prev + ((float)(pcnt - TOPK) + 0.5f) / dens;
            if (!(cand > lo && cand < hi)) cand = mid;
            if (!(cand > lo && cand < hi)) done = true;
            if (__all(done)) break;
            int cnt = 0;
#pragma unroll
            for (int g = 0; g < 8; ++g) {
                if (8 * g <= ktd) {
#define CNT4(k0, k1, k2, k3) asm volatile("v_cmp_ge_f32_e64 s[88:89], %1, %5\n\tv_cmp_ge_f32_e64 s[90:91], %2, %5\n\tv_cmp_ge_f32_e64 s[92:93], %3, %5\n\tv_cmp_ge_f32_e64 s[94:95], %4, %5\n\t" \
                        "v_addc_co_u32_e64 %0, s[88:89], 0, %0, s[88:89]\n\tv_addc_co_u32_e64 %0, s[90:91], 0, %0, s[90:91]\n\tv_addc_co_u32_e64 %0, s[92:93], 0, %0, s[92:93]\n\tv_addc_co_u32_e64 %0, s[94:95], 0, %0, s[94:95]" \
                        : "+v"(cnt) : "v"(k0), "v"(k1), "v"(k2), "v"(k3), "v"(cand) : "s88", "s89", "s90", "s91", "s92", "s93", "s94", "s95")
                    CNT4(key[8 * g + 0], key[8 * g + 1], key[8 * g + 2], key[8 * g + 3]);
                    CNT4(key[8 * g + 4], key[8 * g + 5], key[8 * g + 6], key[8 * g + 7]);
#undef CNT4
                }
            }
            cnt = half_sum32(cnt);
            if (!done) {
                if (cnt >= TOPK) { lo = cand; flo = (float)cnt - 255.5f; if (side == 1) fhi *= 0.5f; side = 1; }
                else { hi = cand; fhi = (float)cnt - 255.5f; if (side == 2) flo *= 0.5f; side = 2; }
                if (cnt == TOPK) done = true; }
            prev = cand; pcnt = cnt;
        }
        if (need) T = lo;
    }
    unsigned mw0 = 0u, mw1 = 0u;
#pragma unroll
    for (int kt = 0; kt < 64; ++kt) {
        if (kt <= ktd) { const unsigned long long bal = __ballot(key[kt] >= T);
            const unsigned blo = (unsigned)bal, bhi = (unsigned)(bal >> 32);
            asm volatile("s_nop 4\n\tv_writelane_b32 %0, %2, %4\n\tv_writelane_b32 %1, %3, %4" : "+v"(mw0), "+v"(mw1) : "s"(blo), "s"(bhi), "n"(kt)); }
    }
    Mb[(size_t)t0 * 64 + lane] = mw0; Mb[(size_t)(t0 + 1) * 64 + lane] = mw1;
    { P0Tile t; const int r = conv_it & 255; t.src = nullptr; t.ld_src = DEXP; t.k0 = 64 * (r >> 3); t.n0 = 64 * (r & 7); t.nvalid = DEXP; t.dst = (unsigned char*)F.Wgu + (size_t)(conv_it >> 8) * 1024 * DM; t.ld_dst = DM;
      t.himul = 256; t.radd = 0; t.fp8 = 1; t.scale = WGU_SCALE;
      u32x4 co[8]; p0_tile_pack(t, cv, co); p0_tile_store(t, co, lane); }
}
__device__ __forceinline__ void p3_indexer(Frame& F) {
    for (int wgi = F.vcu; wgi < 256; wgi += F.G) {
        const int b = wgi >> 5, j = wgi & 31;
#pragma unroll 1
        for (int s = 0; s < 4; ++s) { const int q16 = (s == 0) ? j : (s == 1) ? 63 - j : (s == 2) ? 64 + j : 127 - j;
            p3_indexer_item(F, (wgi * 4 + s) * NWAVES + F.wave, F.P + (size_t)b * SEQ * PLD, F.MASK + (size_t)b * SEQ * 64, q16 * 16, F.lds, F.tid, F.wave, F.lane); }
    }
}

namespace att {
constexpr int D = 128, QBLK = 32, KVBLK = 64, QB = 256;
constexpr int SHM_V = KVBLK * D * 2, SHM_K = KVBLK * D * 2;
constexpr int ATT_LDS = 2 * SHM_V + 2 * SHM_K + NWAVES * 64 * 4;
constexpr float SCALE = 0.08838834764831845f, THR = 8.f;
constexpr int RMAX = 207, NBIAS = 304;
#define KSWZ(row, colB) ((row) * 256 + ((colB) ^ (((row) & 7) << 4)))
#define SBAR() __builtin_amdgcn_sched_barrier(0)
__device__ __forceinline__ int v_st(int k, int c) { const int kk = (k & ~0xC) | ((k & 4) << 1) | ((k & 8) >> 1); return ((kk >> 3) * 4 + (c >> 5)) * 512 + ((kk & 7) * 32 + (c & 31)) * 2; }
__device__ __forceinline__ int v_rd_base(int lane) { return ((lane & 3) << 3) | (((lane >> 2) & 3) << 6) | (((lane >> 4) & 1) << 5) | (((lane >> 5) & 1) << 8); }
constexpr int v_rd_off(int d0, int ks, int half) { return d0 * 512 + ks * 4096 + half * 2048; }
__device__ __forceinline__ int crow(int r, int hi) { return (r & 3) + 8 * (r >> 2) + 4 * hi; }

__device__ __forceinline__ void mask_bias_tile(f32x16& p0, f32x16& p1, u32x2 mk, int hi, bool near, const LAS float* tb) {
    const float NEG = -__builtin_inff();
    const unsigned w0 = mk.x >> (4 * hi), w1 = mk.y >> (4 * hi);
    if (near) {
#pragma unroll
        for (int r = 0; r < 16; ++r) { const int c = (r & 3) + 8 * (r >> 2); p0[r] += tb[c]; p1[r] += tb[c + 32]; }
    }
    const int negb = __float_as_int(NEG);
#pragma unroll
    for (int r = 0; r < 16; ++r) { const int c = (r & 3) + 8 * (r >> 2);
        const int m0 = __builtin_amdgcn_sbfe((int)w0, c, 1), m1 = __builtin_amdgcn_sbfe((int)w1, c, 1);
        const float x0 = p0[r], x1 = p1[r];
        p0[r] = __int_as_float((__float_as_int(x0) & m0) | (negb & ~m0));
        p1[r] = __int_as_float((__float_as_int(x1) & m1) | (negb & ~m1)); }
}
__device__ __forceinline__ void partialSM(f32x16& p0, f32x16& p1, float& m_reg, float& mn, float& alpha) {
    float pmax = p0[0];
#pragma unroll
    for (int r = 1; r < 16; ++r) pmax = fmaxf(pmax, p0[r]);
#pragma unroll
    for (int r = 0; r < 16; ++r) pmax = fmaxf(pmax, p1[r]);
    { auto rr = __builtin_amdgcn_permlane32_swap(__float_as_uint(pmax), __float_as_uint(pmax), false, false);
      pmax = fmaxf(__uint_as_float(rr[0]), __uint_as_float(rr[1])); }
    constexpr float C2 = 1.4426950408889634f * SCALE;
    if (__builtin_expect(__all((pmax - m_reg) * SCALE <= THR), 1)) { mn = m_reg; alpha = 1.f; }
    else { mn = fmaxf(m_reg, pmax); alpha = __builtin_amdgcn_exp2f((m_reg - mn) * C2); m_reg = mn; }
    const float mnL = -mn * C2;
#pragma unroll
    for (int r = 0; r < 16; ++r) p0[r] = fmaf(p0[r], C2, mnL);
#pragma unroll
    for (int r = 0; r < 16; ++r) p1[r] = fmaf(p1[r], C2, mnL);
#pragma unroll
    for (int r = 0; r < 16; ++r) p0[r] = __builtin_amdgcn_exp2f(p0[r]);
}
__device__ __forceinline__ void finishSM(f32x16& p0, f32x16& p1, float alpha, float& l_reg, bf16x8& pa0, bf16x8& pa1, bf16x8& pa2, bf16x8& pa3) {
#pragma unroll
    for (int r = 0; r < 16; ++r) p1[r] = __builtin_amdgcn_exp2f(p1[r]);
    float ps = 0;
#pragma unroll
    for (int r = 0; r < 16; ++r) ps += p0[r];
#pragma unroll
    for (int r = 0; r < 16; ++r) ps += p1[r];
    { auto rr = __builtin_amdgcn_permlane32_swap(__float_as_uint(ps), __float_as_uint(ps), false, false);
      ps = __uint_as_float(rr[0]) + __uint_as_float(rr[1]); }
    l_reg = l_reg * alpha + ps;
#define PK4(P, B_, OUT) do { unsigned a0 = cvt_pk_bf16(P[B_+0], P[B_+1]), a1 = cvt_pk_bf16(P[B_+2], P[B_+3]);                          \
        unsigned b0 = cvt_pk_bf16(P[B_+4], P[B_+5]), b1 = cvt_pk_bf16(P[B_+6], P[B_+7]);                                             \
        auto r0 = __builtin_amdgcn_permlane32_swap(a0, b0, false, false); auto r1 = __builtin_amdgcn_permlane32_swap(a1, b1, false, false); \
        u32x4 w = {r0[0], r1[0], r0[1], r1[1]}; OUT = *reinterpret_cast<bf16x8*>(&w); } while (0)
    PK4(p0, 0, pa0); PK4(p0, 8, pa1); PK4(p1, 0, pa2); PK4(p1, 8, pa3);
#undef PK4
}
template <int KB>
__device__ __forceinline__ void qkt(f32x16& p0, f32x16& p1, const char* K_lds, const char* Qw, int r32, int hi) {
    p0 = f32x16{}; p1 = f32x16{};
    const char* kb[4]; const char* qb[4];
#pragma unroll
    for (int dd = 0; dd < 4; ++dd) { kb[dd] = K_lds + KB * SHM_K + KSWZ(r32, (dd * 16 + hi * 8) * 2); qb[dd] = Qw + KSWZ(r32, (dd * 16 + hi * 8) * 2); }
#pragma unroll
    for (int d0 = 0; d0 < 8; ++d0) { const char* a = kb[d0 & 3] + (d0 >> 2) * 128;
        bf16x8 b0 = *reinterpret_cast<const bf16x8*>(a);
        bf16x8 b1 = *reinterpret_cast<const bf16x8*>(a + 32 * 256);
        bf16x8 q = *reinterpret_cast<const bf16x8*>(qb[d0 & 3] + (d0 >> 2) * 128);
        p0 = __builtin_amdgcn_mfma_f32_32x32x16_bf16(b0, q, p0, 0, 0, 0);
        p1 = __builtin_amdgcn_mfma_f32_32x32x16_bf16(b1, q, p1, 0, 0, 0); }
    __builtin_amdgcn_sched_group_barrier(0x100, 3, 0);
#pragma unroll
    for (int d0 = 0; d0 < 7; ++d0) { __builtin_amdgcn_sched_group_barrier(0x100, 3, 0); __builtin_amdgcn_sched_group_barrier(0x008, 2, 0); }
    __builtin_amdgcn_sched_group_barrier(0x008, 2, 0);
}
template <int VB>
__device__ __forceinline__ void pv_tile(f32x16* o, int vb0, bf16x8 pa0, bf16x8 pa1, bf16x8 pa2, bf16x8 pa3) {
#define TRRD(dst, off) asm volatile("ds_read_b64_tr_b16 %0, %1 offset:%2" : "=&v"(dst) : "v"(vb0), "i"(off) : "memory")
#define PV_D0(d0) do { s16x4 l0, l1, l2, l3, h0, h1, h2, h3; constexpr int b_ = VB * SHM_V + v_rd_off(d0, 0, 0); \
        TRRD(l0, b_); TRRD(h0, b_ + 2048); TRRD(l1, b_ + 4096); TRRD(h1, b_ + 6144); TRRD(l2, b_ + 8192); TRRD(h2, b_ + 10240); TRRD(l3, b_ + 12288); TRRD(h3, b_ + 14336); \
        asm volatile("s_waitcnt lgkmcnt(0)" ::: "memory"); SBAR();   \
        o[d0] = __builtin_amdgcn_mfma_f32_32x32x16_bf16(pa0, (bf16x8){l0[0], l0[1], l0[2], l0[3], h0[0], h0[1], h0[2], h0[3]}, o[d0], 0, 0, 0);   \
        o[d0] = __builtin_amdgcn_mfma_f32_32x32x16_bf16(pa1, (bf16x8){l1[0], l1[1], l1[2], l1[3], h1[0], h1[1], h1[2], h1[3]}, o[d0], 0, 0, 0);   \
        o[d0] = __builtin_amdgcn_mfma_f32_32x32x16_bf16(pa2, (bf16x8){l2[0], l2[1], l2[2], l2[3], h2[0], h2[1], h2[2], h2[3]}, o[d0], 0, 0, 0);   \
        o[d0] = __builtin_amdgcn_mfma_f32_32x32x16_bf16(pa3, (bf16x8){l3[0], l3[1], l3[2], l3[3], h3[0], h3[1], h3[2], h3[3]}, o[d0], 0, 0, 0); } while (0)
    PV_D0(0); PV_D0(1); PV_D0(2); PV_D0(3);
#undef PV_D0
#undef TRRD
}
struct BlockRef { const bf16* Q; const bf16* K; bf16* O; const unsigned* M; int P0; };
struct Seam { bf16x8 st_v0, st_v1, st_k0, st_k1; u32x2 mkA; };
constexpr int Q_OFF = 2 * SHM_V + 2 * SHM_K + NWAVES * 64 * 4;
constexpr int ATT_LDS_ALL = Q_OFF + NWAVES * 8192;
#define VMW() asm volatile("s_waitcnt vmcnt(0)" ::: "memory")
#define KVROW (PLD * 2)
#define SLOAD_H(Kp, k0) do { const char* kt_ = (const char*)(Kp) + (size_t)(k0) * KVROW; \
        S.st_k0 = *(const bf16x8*)(kt_ + kvo); S.st_k1 = *(const bf16x8*)(kt_ + 32 * KVROW + kvo); \
        S.st_v0 = *(const bf16x8*)(kt_ + (C_V - C_K) * 2 + kvo); S.st_v1 = *(const bf16x8*)(kt_ + 32 * KVROW + (C_V - C_K) * 2 + kvo); } while (0)
#define SWRITE_HK(bf) do { *(bf16x8*)(K_lds + (bf) * SHM_K + kws) = S.st_k0; *(bf16x8*)(K_lds + (bf) * SHM_K + kws + 32 * 256) = S.st_k1; } while (0)
#define SWRITE_HV(bf) do { *(bf16x8*)(V_lds + (bf) * SHM_V + vst0) = S.st_v0; *(bf16x8*)(V_lds + (bf) * SHM_V + vst1) = S.st_v1; } while (0)
#define SWRITE_H(bf) do { SWRITE_HV(bf); SWRITE_HK(bf); } while (0)
#define MLOAD(ref, tile) (*(const u32x2*)((const char*)((ref).M + (size_t)wid * QBLK * 64 + 2 * (tile)) + mro))
__device__ __forceinline__ void attn_prime(const BlockRef& cur, char* lds, Seam& S, const int wid, const int lane) {
    const int tid = wid * 64 + lane, r32 = lane & 31;
    const int sr = tid >> 4, sc = (tid & 15) * 8, kws = KSWZ(sr, sc * 2); char* K_lds = lds + 2 * SHM_V;
    const unsigned kvo = (unsigned)(sr * PLD + sc) * 2u, mro = (unsigned)r32 * 256u;
    SLOAD_H(cur.K, 0); S.mkA = MLOAD(cur, 0); VMW(); SWRITE_HK(0);
    __syncthreads();
}
__device__ __forceinline__ void attn_block(const BlockRef& cur, const BlockRef& nxt, char* lds, const LAS float* btab, Seam& S, const int wid, const int lane) {
    const int tid = wid * 64 + lane, r32 = lane & 31, hi = lane >> 5;
    const int NT = (cur.P0 + QB - 1) / KVBLK + 1;
    const int qlo = cur.P0 + wid * QBLK, pos = qlo + r32;
    char* V_lds = lds; char* K_lds = lds + 2 * SHM_V; char* Qw = lds + Q_OFF + wid * 8192;
    float* ws = (float*)(lds + 2 * SHM_V + 2 * SHM_K) + wid * 64; float* li_l = ws, * al_l = ws + 32;
    float m_reg = -1e30f, l_reg = 0; f32x16 o[4] = {};
    const int sr = tid >> 4, sc = (tid & 15) * 8, vst0 = v_st(sr, sc), vst1 = v_st(32 + sr, sc), kws = KSWZ(sr, sc * 2);
    const unsigned kvo = (unsigned)(sr * PLD + sc) * 2u, mro = (unsigned)r32 * 256u;
    const int vb0 = (int)(uintptr_t)V_lds + v_rd_base(lane);
    const bf16* Kh = cur.K;
    u32x2 mkA = S.mkA, mkB = (u32x2){0u, 0u};
    {
        const char* qg = (const char*)(cur.Q + (size_t)wid * QBLK * PLD) + (unsigned)(r32 * PLD + hi * 8) * 2u;
        bf16x8 qv[8];
#pragma unroll
        for (int d0 = 0; d0 < 8; ++d0) qv[d0] = *(const bf16x8*)(qg + d0 * 32);
#pragma unroll
        for (int d0 = 0; d0 < 8; ++d0) *(bf16x8*)(Qw + KSWZ(r32, (d0 * 16 + hi * 8) * 2)) = qv[d0];
        asm volatile("s_waitcnt lgkmcnt(0)" ::: "memory");
    }
#define RESC(a) do { if (__any((a) < 1.f)) { if (hi == 0) al_l[r32] = (a); asm volatile("s_waitcnt lgkmcnt(0)" ::: "memory");              \
                     for (int d_ = 0; d_ < 4; ++d_) for (int r = 0; r < 16; ++r) o[d_][r] *= al_l[crow(r, hi)]; } } while (0)
#define KBASE(t) ((t) * KVBLK)
#define MASKT(P0_, P1_, mk, t) do { const int kb_ = KBASE(t); const bool near_ = (kb_ <= qlo + QBLK - 1) && (kb_ > qlo - 176); \
        mask_bias_tile(P0_, P1_, mk, hi, near_, btab + (RMAX - (pos - kb_ - 4 * hi))); } while (0)
    f32x16 pA0, pA1, pB0, pB1; float mnA, mnB, alA, alB; bf16x8 pa0, pa1, pa2, pa3;
    SWRITE_HV(0); SBAR();
    if (NT > 1) { SLOAD_H(Kh, KBASE(1)); mkB = MLOAD(cur, 1); }
    SBAR(); qkt<0>(pA0, pA1, K_lds, Qw, r32, hi);
    MASKT(pA0, pA1, mkA, 0); partialSM(pA0, pA1, m_reg, mnA, alA);
    if (NT > 1) { VMW(); SWRITE_H(1); }
    __syncthreads();
#define HALF_STEP(PX0, PX1, mnX, alX, mkX, PY0, PY1, alY, mkY, t, KB, VB, SB) do {                                                      \
        SBAR(); qkt<KB>(PX0, PX1, K_lds, Qw, r32, hi);                                             \
        finishSM(PY0, PY1, alY, l_reg, pa0, pa1, pa2, pa3); SBAR();                                                           \
        if ((t) + 1 < NT) { SLOAD_H(Kh, KBASE((t) + 1)); mkY = MLOAD(cur, (t) + 1); SBAR(); }                                               \
        pv_tile<VB>(o, vb0, pa0, pa1, pa2, pa3); MASKT(PX0, PX1, mkX, (t)); partialSM(PX0, PX1, m_reg, mnX, alX);                                        \
        __syncthreads();                                                                                                      \
        if ((t) + 1 < NT) { VMW(); SWRITE_H(SB); }                                                                          \
        RESC(alX); __syncthreads(); } while (0)
    for (int t = 1; t + 1 < NT; t += 2) {
        HALF_STEP(pB0, pB1, mnB, alB, mkB, pA0, pA1, alA, mkA, t, 1, 0, 0);
        HALF_STEP(pA0, pA1, mnA, alA, mkA, pB0, pB1, alB, mkB, t + 1, 0, 1, 1);
    }
    const bool even = (NT & 1) == 0;
    if (even) { SBAR(); qkt<1>(pB0, pB1, K_lds, Qw, r32, hi); SBAR(); }
    SLOAD_H(nxt.K, 0); mkA = MLOAD(nxt, 0); SBAR();
    finishSM(pA0, pA1, alA, l_reg, pa0, pa1, pa2, pa3); SBAR();
    pv_tile<0>(o, vb0, pa0, pa1, pa2, pa3);
    if (even) { MASKT(pB0, pB1, mkB, NT - 1); partialSM(pB0, pB1, m_reg, mnB, alB); __syncthreads(); RESC(alB);
        finishSM(pB0, pB1, alB, l_reg, pa0, pa1, pa2, pa3); SBAR(); pv_tile<1>(o, vb0, pa0, pa1, pa2, pa3); }
    SBAR(); VMW(); SWRITE_HK(0); SBAR();
    S.mkA = mkA;
    if (hi == 0) li_l[r32] = l_reg; asm volatile("s_waitcnt lgkmcnt(0)" ::: "memory");
    float rli[16];
#pragma unroll
    for (int r = 0; r < 16; ++r) rli[r] = __builtin_amdgcn_rcpf(li_l[crow(r, hi)]);
    {
        bf16* ol = (bf16*)Qw;
#pragma unroll
        for (int r = 0; r < 16; ++r) { const int orow = crow(r, hi);
#pragma unroll
            for (int d0 = 0; d0 < 4; ++d0) ol[orow * D + d0 * 32 + r32] = (bf16)(cvt_pk_bf16(o[d0][r] * rli[r], 0.f) & 0xffffu); }
        asm volatile("s_waitcnt lgkmcnt(0)" ::: "memory");
        char* Ob = (char*)(cur.O + (size_t)(wid * QBLK) * DM);
        const unsigned ovo = (unsigned)((lane >> 4) * (DM * 2) + (lane & 15) * 16);
#pragma unroll
        for (int i = 0; i < 8; ++i) { const u32x4 w = *(const u32x4*)(Qw + i * 1024 + lane * 16);
            GAS char* Obi = (GAS char*)(Ob + (size_t)i * (4 * DM * 2)); asm volatile("" : "+s"(Obi));
            *(GAS u32x4*)(Obi + ovo) = w; }
        asm volatile("s_waitcnt lgkmcnt(0)" ::: "memory");
    }
    __syncthreads();
#undef RESC
#undef KBASE
#undef MASKT
#undef HALF_STEP
}
#undef VMW
#undef SLOAD_H
#undef SWRITE_HK
#undef SWRITE_HV
#undef SWRITE_H
#undef MLOAD
#undef KVROW
}

__device__ __forceinline__ int t5_bucket(int rel) {
    if (rel < 16) return rel;
    int v = 16 + (int)(logf((float)rel / 16.f) / logf(8.f) * 16.f);
    return v < 31 ? v : 31;
}
__device__ __forceinline__ att::BlockRef p4_ref(Frame& F, int it, int pass) {
    const int b = it >> 5, h = (it >> 2) & 7, p = it & 3, kvh = h >> 2, qb = pass ? 7 - p : p;
    const bf16* Pb = F.P + (size_t)b * SEQ * PLD;
    att::BlockRef r; r.P0 = qb * 256;
    r.Q = Pb + (size_t)r.P0 * PLD + C_Q + h * HD; r.K = Pb + C_K + kvh * HD;
    r.O = F.CAT + (size_t)(b * SEQ + r.P0) * DM + POOLW + h * HD; r.M = F.MASK + (size_t)(b * SEQ + r.P0) * 64;
    return r;
}
__device__ __forceinline__ void p4_attention(Frame& F, int nitems) {
    LAS float* btab = (LAS float*)(F.lds + MISC_BASE + MO_BIAS);
    char* lds = (char*)F.lds;
    int it = F.vcu, pass = 0;
    if (it >= nitems) return;
    att::Seam S;
    { const att::BlockRef c0 = p4_ref(F, it & 255, 0); att::attn_prime(c0, lds, S, F.wave, F.lane); }
    for (;;) {
        if (pass == 0) {
            const int h = (it >> 2) & 7;
            __syncthreads();
            for (int i = F.tid; i < att::NBIAS; i += NTHR) { const int rel = att::RMAX - i; float v = 0.f;
                if (rel >= 0) v = (F.rel_bias[t5_bucket(rel) * NHEAD + h] - F.rel_bias[31 * NHEAD + h]) * (1.f / att::SCALE);
                btab[i] = v; }
            __syncthreads();
        }
        const bool more_item = it + F.G < nitems, last = (pass == 1) && !more_item;
        const int itn = (pass == 0) ? it : (more_item ? it + F.G : it), passn = (pass == 0) ? 1 : (more_item ? 0 : 1);
        const att::BlockRef cur = p4_ref(F, it & 255, pass), nxt = p4_ref(F, itn & 255, passn);
        att::attn_block(cur, nxt, lds, btab, S, F.wave, F.lane);
        if (last) break;
        it = itn; pass = passn;
    }
}

constexpr int P6_ROWS = 32, P6_PITCH = 4112;
constexpr int P6_LOG = P6_ROWS * P6_PITCH;
static_assert(P6_LOG + P6_ROWS * 48 * 4 <= MISC_BASE, "P6 LDS");
__device__ __forceinline__ void p6_route(Frame& F, const LAS float* lg, int m) {
    float gmax = lg[0] + F.b_group[0]; int gsel = 0;
#pragma unroll
    for (int i = 1; i < NGRP; ++i) { const float v = lg[i] + F.b_group[i]; if (v > gmax) { gmax = v; gsel = i; } }
    float gz = 0.f;
#pragma unroll
    for (int i = 0; i < NGRP; ++i) gz += __expf(lg[i] + F.b_group[i] - gmax);
    const float pg = 1.f / gz;
    float e1v = -3.0e38f, e2v = -3.0e38f; int i1 = 0, i2 = 0;
#pragma unroll
    for (int i = 0; i < EPG; ++i) { const float v = lg[4 + gsel * EPG + i] + F.b_router[gsel * EPG + i];
        if (v > e1v) { e2v = e1v; i2 = i1; e1v = v; i1 = i; } else if (v > e2v) { e2v = v; i2 = i; } }
    const float w1 = 1.f / (1.f + __expf(e2v - e1v)), w2 = 1.f - w1;
    const int ex1 = gsel * EPG + i1, ex2 = gsel * EPG + i2;
    const unsigned p1 = atomicAdd(F.ctl + CW_ECNT + 16 * ex1, 1u), p2 = atomicAdd(F.ctl + CW_ECNT + 16 * ex2, 1u);
    F.TOKLIST[ex1 * NTOK + (int)p1] = m; F.TOKLIST[ex2 * NTOK + (int)p2] = m;
    unsigned* ti = F.TOKINFO + (size_t)m * 8;
    ti[0] = (unsigned)ex1; ti[1] = p1; ti[2] = (unsigned)ex2; ti[3] = p2; ti[4] = __float_as_uint(pg * w1); ti[5] = __float_as_uint(pg * w2);
}
__device__ __forceinline__ void p6_norm_router(Frame& F, bool route) {
    LAS unsigned char* tile = F.lds;
    LAS float* logit = (LAS float*)(F.lds + P6_LOG);
    const int lane = F.lane, wave = F.wave, fr = lane & 15, fq = lane >> 4;
    int prev_m0 = -1;
    for (int grp = F.bid; grp < NTOK / P6_ROWS; grp += F.G) {
        const int m0 = grp * P6_ROWS, b = m0 / SEQ;
        const float* modb = F.mod + (size_t)b * (6 * DM);
        u32x2 xb[4][8];
#pragma unroll
        for (int rr = 0; rr < 4; ++rr)
#pragma unroll
            for (int j = 0; j < 8; ++j) xb[rr][j] = *(const u32x2*)(F.X1 + (size_t)(m0 + 4 * wave + rr) * DM + 256 * j + 4 * lane);
        f32x4 gs[8], sh[8];
#pragma unroll
        for (int j = 0; j < 8; ++j) { const int col = 256 * j + 4 * lane; const f32x4 g = *(const f32x4*)(F.g_ffn + col), sc = *(const f32x4*)(modb + 4 * DM + col);
            gs[j] = g * (sc + 1.f); sh[j] = *(const f32x4*)(modb + 3 * DM + col); }
        if (route && prev_m0 >= 0 && lane < 4) p6_route(F, logit + (4 * wave + lane) * 48, prev_m0 + 4 * wave + lane);
#pragma unroll
        for (int rr = 0; rr < 4; ++rr) {
            const int lr = 4 * wave + rr, m = m0 + lr;
            f32x4 v[8]; float s = 0.f;
#pragma unroll
            for (int j = 0; j < 8; ++j) { const u32x2 q = xb[rr][j];
                v[j][0] = __uint_as_float(q.x << 16); v[j][1] = __uint_as_float(q.x & 0xffff0000u); v[j][2] = __uint_as_float(q.y << 16); v[j][3] = __uint_as_float(q.y & 0xffff0000u);
                s += (v[j][0] * v[j][0] + v[j][1] * v[j][1]) + (v[j][2] * v[j][2] + v[j][3] * v[j][3]); }
            const float rstd = 1.f / sqrtf(wave_sum(s) * (1.f / DM) + EPS);
            unsigned char* orow = (unsigned char*)F.H + (size_t)m * DM;
#pragma unroll
            for (int j = 0; j < 8; ++j) { const f32x4 y = v[j] * rstd * gs[j] + sh[j];
                u32x2 o; o.x = cvt_pk_bf16(y[0], y[1]); o.y = cvt_pk_bf16(y[2], y[3]);
                *(unsigned*)(orow + 256 * j + 4 * lane) = pk4_fp8(y[0], y[1], y[2], y[3]);
                *(LAS u32x2*)(tile + lr * P6_PITCH + (256 * j + 4 * lane) * 2) = o; }
        }
        __syncthreads();
        if (wave < 6) {
            const int rb = wave / 3, nb = wave - 3 * rb;
            f32x4 acc = (f32x4){0.f, 0.f, 0.f, 0.f};
            const LAS unsigned char* ap = tile + (rb * 16 + fr) * P6_PITCH + 16 * fq;
            const bf16* bp = F.RW + (size_t)(nb * 16 + fr) * DM + 8 * fq;
#pragma unroll 16
            for (int ks = 0; ks < 64; ++ks) acc = __builtin_amdgcn_mfma_f32_16x16x32_bf16(*(const LAS bf16x8*)(ap + 64 * ks), *(const bf16x8*)(bp + 32 * ks), acc, 0, 0, 0);
#pragma unroll
            for (int j = 0; j < 4; ++j) logit[(rb * 16 + 4 * fq + j) * 48 + nb * 16 + fr] = acc[j];
        }
        __syncthreads();
        prev_m0 = m0;
    }
    if (route && prev_m0 >= 0 && lane < 4) p6_route(F, logit + (4 * wave + lane) * 48, prev_m0 + 4 * wave + lane);
}
constexpr int S6_ROWS = 16, S6_LOG = S6_ROWS * P6_PITCH, S6_CTR = 69120, S6_SCR_HI = 69632;
static_assert(S6_LOG + S6_ROWS * 48 * 4 <= S6_CTR && S6_SCR_HI + 4 * 16640 <= MISC_BASE, "side-by-side LDS map");
__device__ __forceinline__ void bar4(volatile LAS unsigned* cnt, unsigned& target, int lane) {
    asm volatile("s_waitcnt lgkmcnt(0)" ::: "memory");
    target += 4u;
    if (lane == 0) (void)__hip_atomic_fetch_add((LAS unsigned*)cnt, 1u, __ATOMIC_RELAXED, __HIP_MEMORY_SCOPE_WORKGROUP);
    while (*cnt < target) __builtin_amdgcn_s_sleep(1);
    asm volatile("" ::: "memory");
}
__device__ __forceinline__ void s6_router(Frame& F, volatile LAS unsigned* bcnt) {
    LAS unsigned char* tile = F.lds;
    LAS float* logit = (LAS float*)(F.lds + S6_LOG);
    const int lane = F.lane, wave = F.wave, fr = lane & 15, fq = lane >> 4;
    unsigned btarget = 0u; int prev_m0 = -1;
    for (int grp = F.bid; grp < NTOK / S6_ROWS; grp += F.G) {
        const int m0 = grp * S6_ROWS, b = m0 / SEQ;
        const float* modb = F.mod + (size_t)b * (6 * DM);
        u32x2 xb[4][8];
#pragma unroll
        for (int rr = 0; rr < 4; ++rr)
#pragma unroll
            for (int j = 0; j < 8; ++j) xb[rr][j] = *(const u32x2*)(F.X1 + (size_t)(m0 + 4 * wave + rr) * DM + 256 * j + 4 * lane);
        f32x4 gs[8], sh[8];
#pragma unroll
        for (int j = 0; j < 8; ++j) { const int col = 256 * j + 4 * lane; const f32x4 g = *(const f32x4*)(F.g_ffn + col), sc = *(const f32x4*)(modb + 4 * DM + col);
            gs[j] = g * (sc + 1.f); sh[j] = *(const f32x4*)(modb + 3 * DM + col); }
        if (prev_m0 >= 0 && lane < 4) p6_route(F, logit + (4 * wave + lane) * 48, prev_m0 + 4 * wave + lane);
        bar4(bcnt, btarget, lane);
#pragma unroll
        for (int rr = 0; rr < 4; ++rr) {
            const int lr = 4 * wave + rr, m = m0 + lr;
            f32x4 v[8]; float s = 0.f;
#pragma unroll
            for (int j = 0; j < 8; ++j) { const u32x2 q = xb[rr][j];
                v[j][0] = __uint_as_float(q.x << 16); v[j][1] = __uint_as_float(q.x & 0xffff0000u); v[j][2] = __uint_as_float(q.y << 16); v[j][3] = __uint_as_float(q.y & 0xffff0000u);
                s += (v[j][0] * v[j][0] + v[j][1] * v[j][1]) + (v[j][2] * v[j][2] + v[j][3] * v[j][3]); }
            const float rstd = 1.f / sqrtf(wave_sum(s) * (1.f / DM) + EPS);
            unsigned char* orow = (unsigned char*)F.H + (size_t)m * DM;
#pragma unroll
            for (int j = 0; j < 8; ++j) { const f32x4 y = v[j] * rstd * gs[j] + sh[j];
                u32x2 o; o.x = cvt_pk_bf16(y[0], y[1]); o.y = cvt_pk_bf16(y[2], y[3]);
                *(unsigned*)(orow + 256 * j + 4 * lane) = pk4_fp8(y[0], y[1], y[2], y[3]);
                *(LAS u32x2*)(tile + lr * P6_PITCH + (256 * j + 4 * lane) * 2) = o; }
        }
        bar4(bcnt, btarget, lane);
        if (wave < 3) {
            const int nb = wave;
            f32x4 acc = (f32x4){0.f, 0.f, 0.f, 0.f};
            const LAS unsigned char* ap = tile + fr * P6_PITCH + 16 * fq;
            const bf16* bp = F.RW + (size_t)(nb * 16 + fr) * DM + 8 * fq;
#pragma unroll 16
            for (int ks = 0; ks < 64; ++ks) acc = __builtin_amdgcn_mfma_f32_16x16x32_bf16(*(const LAS bf16x8*)(ap + 64 * ks), *(const bf16x8*)(bp + 32 * ks), acc, 0, 0, 0);
#pragma unroll
            for (int j = 0; j < 4; ++j) logit[(4 * fq + j) * 48 + nb * 16 + fr] = acc[j];
        }
        bar4(bcnt, btarget, lane);
        prev_m0 = m0;
    }
    if (prev_m0 >= 0 && lane < 4) p6_route(F, logit + (4 * wave + lane) * 48, prev_m0 + 4 * wave + lane);
    bar4(bcnt, btarget, lane);
}
__device__ __forceinline__ int lds_pop(LAS unsigned* ctr, int lane) {
    int v = 0; if (lane == 0) v = (int)__hip_atomic_fetch_add(ctr, 1u, __ATOMIC_RELAXED, __HIP_MEMORY_SCOPE_WORKGROUP);
    return __builtin_amdgcn_readfirstlane(v);
}
__device__ __forceinline__ void s6_convert(Frame& F, LAS unsigned* ctr, int a0, int total) {
    f32x4 v[16]; u32x4 o[8]; P0Tile cur, nxt;
    int d = F.bid + F.G * lds_pop(ctr, F.lane);
    if (d >= total) return;
    cur = p0_decode(F, a0 + d); p0_tile_load(cur, v, F.lane);
    for (;;) {
        p0_tile_pack(cur, v, o);
        const int dn = F.bid + F.G * lds_pop(ctr, F.lane); const bool more = dn < total;
        if (more) { nxt = p0_decode(F, a0 + dn); p0_tile_load(nxt, v, F.lane); }
        p0_tile_store(cur, o, F.lane);
        if (!more) break;
        cur = nxt;
    }
}
__device__ __forceinline__ void p6_side_by_side(Frame& F) {
    LAS unsigned* ctrs = (LAS unsigned*)(F.lds + S6_CTR);
    __syncthreads();
    if (F.tid == 0) { ctrs[0] = 0u; ctrs[1] = 0u; }
    __syncthreads();
    constexpr int A0 = P0_EARLY_A + P0_R2;
    const int total = ((F.G == 256) ? P0_OFF_START : P0_EARLY_B0) - A0;
    if (F.wave < 4) { s6_router(F, (volatile LAS unsigned*)ctrs); s6_convert(F, ctrs + 1, A0, total); }
    else s6_convert(F, ctrs + 1, A0, total);
}

__device__ __forceinline__ pg8::MoeTabs moe_tabs(Frame& F) {
    pg8::MoeTabs T; T.tb = (const LAS int*)(F.lds + MISC_BASE + MO_TB); T.tf = T.tb + 40; T.hl = T.tb + 80; return T;
}
__device__ __forceinline__ void moe_tables(Frame& F) {
    LAS int* tb = (LAS int*)(F.lds + MISC_BASE + MO_TB); LAS int* tf = tb + 40; LAS int* hl = tb + 80; LAS int* cnt = (LAS int*)(F.lds + MISC_BASE + MO_CNT);
    __syncthreads();
    if (F.tid < NEXP) cnt[F.tid] = (int)__hip_atomic_load(F.ctl + CW_ECNT + 16 * F.tid, __ATOMIC_RELAXED, __HIP_MEMORY_SCOPE_AGENT);
    __syncthreads();
    if (F.tid == 0) { int s = 0, f = 0, nh = 0;
        for (int e = 0; e < NEXP; ++e) { const int c = cnt[e], t = (c + 255) >> 8, rem = c - ((t - 1) << 8), h = (t > 0 && rem <= 128) ? 1 : 0;
            tb[e] = s; tf[e] = f; s += t; f += t - h; if (h) hl[nh++] = e; }
        tb[NEXP] = s; tf[NEXP] = f; hl[NEXP] = nh; }
    __syncthreads();
}
__device__ __forceinline__ void p7_rowtab(Frame& F, int reps) {
    const pg8::MoeTabs T = moe_tabs(F); const LAS int* cnt = (const LAS int*)(F.lds + MISC_BASE + MO_CNT);
    LAS unsigned* rowtab = (LAS unsigned*)(F.lds + MISC_BASE + MO_ROWTAB);
    unsigned off[MAXU * 256 / NTHR];
#pragma unroll
    for (int q = 0; q < MAXU * 256 / NTHR; ++q) { const int idx = F.tid + q * NTHR, ord = idx >> 8, r = idx & 255; int pm, pn, e, half; off[q] = 0u;
        if (pg8::moe_unit(T, 4, ord * F.G + F.vcu, reps, pm, pn, e, half)) {
            const int slot = (pm - T.tb[e]) * 256 + r; if (slot < cnt[e]) off[q] = (unsigned)F.TOKLIST[e * NTOK + slot] * (unsigned)DM; } }
#pragma unroll
    for (int q = 0; q < MAXU * 256 / NTHR; ++q) rowtab[F.tid + q * NTHR] = off[q];
    __syncthreads();
}
struct P9Row { u32x2 x[8]; int ya[8], yc[8]; };
__device__ __forceinline__ void p9_load(Frame& F, const LAS int* tb, int m, int e1, int p1, int e2, int p2, P9Row& R, int lane) {
    const bf16* x1r = F.X1 + (size_t)m * DM;
    const unsigned char* y1 = (const unsigned char*)F.Y + ((size_t)tb[e1] * 256 + p1) * DM; const unsigned char* y2 = (const unsigned char*)F.Y + ((size_t)tb[e2] * 256 + p2) * DM;
#pragma unroll
    for (int j = 0; j < 8; ++j) { const int col = 256 * j + 4 * lane; R.x[j] = *(const u32x2*)(x1r + col); R.ya[j] = *(const int*)(y1 + col); R.yc[j] = *(const int*)(y2 + col); }
}
__device__ __forceinline__ void p9_final(Frame& F) {
    const LAS int* tb = (const LAS int*)(F.lds + MISC_BASE + MO_TB);
    const int gw = F.bid * NWAVES + F.wave, NGW = F.G * NWAVES, lane = F.lane;
    for (int grp = gw; grp < NTOK / 8; grp += NGW) {
        const int m0 = grp * 8, b = m0 / SEQ;
        const unsigned tiw = (lane < 48) ? F.TOKINFO[(size_t)(m0 + lane / 6) * 8 + (lane % 6)] : 0u;
        f32x4 gt[8], gf[8];
#pragma unroll
        for (int j = 0; j < 8; ++j) { const int col = 256 * j + 4 * lane; gt[j] = *(const f32x4*)(F.mod + (size_t)b * (6 * DM) + 5 * DM + col); gf[j] = *(const f32x4*)(F.g_final + col); }
        P9Row R[2];
#define P9_TI(r, w) __builtin_amdgcn_readlane((int)tiw, 6 * (r) + (w))
        p9_load(F, tb, m0, P9_TI(0, 0), P9_TI(0, 1), P9_TI(0, 2), P9_TI(0, 3), R[0], lane);
#pragma unroll
        for (int r = 0; r < 8; ++r) {
            if (r + 1 < 8) p9_load(F, tb, m0 + r + 1, P9_TI(r + 1, 0), P9_TI(r + 1, 1), P9_TI(r + 1, 2), P9_TI(r + 1, 3), R[(r + 1) & 1], lane);
            const P9Row& C = R[r & 1];
            const float g1s = __uint_as_float((unsigned)P9_TI(r, 4)) * (1.f / Y_SCALE), g2s = __uint_as_float((unsigned)P9_TI(r, 5)) * (1.f / Y_SCALE);
            f32x4 v[8]; float s = 0.f;
#pragma unroll
            for (int j = 0; j < 8; ++j) { const u32x2 xb = C.x[j]; const int a = C.ya[j], c = C.yc[j];
                f32x4 xv; xv[0] = __uint_as_float(xb.x << 16); xv[1] = __uint_as_float(xb.x & 0xffff0000u); xv[2] = __uint_as_float(xb.y << 16); xv[3] = __uint_as_float(xb.y & 0xffff0000u);
                f32x4 ya, yc;
                { const f32x2 lo = __builtin_amdgcn_cvt_pk_f32_fp8(a, false), hi = __builtin_amdgcn_cvt_pk_f32_fp8(a, true); ya[0] = lo[0]; ya[1] = lo[1]; ya[2] = hi[0]; ya[3] = hi[1]; }
                { const f32x2 lo = __builtin_amdgcn_cvt_pk_f32_fp8(c, false), hi = __builtin_amdgcn_cvt_pk_f32_fp8(c, true); yc[0] = lo[0]; yc[1] = lo[1]; yc[2] = hi[0]; yc[3] = hi[1]; }
                v[j] = xv + gt[j] * (ya * g1s + yc * g2s);
                s += (v[j][0] * v[j][0] + v[j][1] * v[j][1]) + (v[j][2] * v[j][2] + v[j][3] * v[j][3]); }
            const float rstd = 1.f / sqrtf(wave_sum(s) * (1.f / DM) + EPS);
            float* xr = F.out + (size_t)(m0 + r) * DM;
#pragma unroll
            for (int j = 0; j < 8; ++j) *(f32x4*)(xr + 256 * j + 4 * lane) = v[j] * rstd * gf[j];
        }
#undef P9_TI
    }
}

struct Args { const float* in[19]; float* out; unsigned char* ws; int ph_lo, ph_hi; };
constexpr int N_PHASES = 10;
__global__ void __launch_bounds__(NTHR, 2) fwd(Args args) {
    extern __shared__ __attribute__((aligned(16))) unsigned char lds_raw[];
    Frame F;
    F.lds = (LAS unsigned char*)lds_raw;
    F.wave = __builtin_amdgcn_readfirstlane((int)threadIdx.x >> 6); F.lane = lane_now(); F.tid = F.wave * 64 + F.lane; F.G = gridDim.x; F.bid = blockIdx.x; F.vcu = (F.G % 8 == 0) ? (F.bid % 8) * (F.G / 8) + F.bid / 8 : F.bid;
    unsigned char* ws = args.ws;
    F.ctl = (unsigned*)(ws + WS_CTL);
    F.x = args.in[0]; F.c = args.in[1]; F.w_ada = args.in[2]; F.b_ada = args.in[3]; F.g_mix = args.in[4]; F.w_in = args.in[5]; F.w_pool = args.in[6]; F.pool_scale = args.in[7];
    F.rel_bias = args.in[8]; F.w_out = args.in[9]; F.g_ffn = args.in[10]; F.w_group = args.in[11]; F.b_group = args.in[12]; F.w_router = args.in[13]; F.b_router = args.in[14];
    F.w_gate = args.in[15]; F.w_up = args.in[16]; F.w_down = args.in[17]; F.g_final = args.in[18];
    F.out = args.out; F.mod = (float*)(ws + WS_MOD);
    F.RW = (bf16*)(ws + WS_RW); F.WpT = (bf16*)(ws + WS_WPT); F.WinP = (bf16*)(ws + WS_WINP); F.Win = (bf16*)(ws + WS_WIN); F.Wout = (bf16*)(ws + WS_WOUT);
    F.Wgu = (bf16*)(ws + WS_WGU); F.Wd = (bf16*)(ws + WS_WD); F.H = (bf16*)(ws + WS_H); F.P = (bf16*)(ws + WS_P); F.CAT = (bf16*)(ws + WS_CAT); F.Y = (bf16*)(ws + WS_Y); F.A = (bf16*)(ws + WS_A); F.X1 = (bf16*)(ws + WS_X1);
    F.MASK = (unsigned*)(ws + WS_MASK); F.TOKLIST = (int*)(ws + WS_TOKLIST); F.TOKINFO = (unsigned*)(ws + WS_TOKINFO);
    volatile LAS unsigned* barw = (volatile LAS unsigned*)(F.lds + MISC_BASE + MO_BARW);
    if (F.tid < 4) barw[F.tid] = 0u;
    __syncthreads();
    XcdBarrier bar; bar.bar = F.ctl + CW_BAR; bar.x = 0; bar.st = nullptr; bar.wave = F.wave;
    if (MK_N_LAUNCHES == 1) bar = xcd_barrier_post(F.ctl + CW_BAR, barw, F.wave);
    const int lo = args.ph_lo, hi = args.ph_hi;
#ifndef PH_MASK
#define PH_MASK 0x3ff
#endif
#define IN(k) (((PH_MASK >> (k)) & 1) && lo <= (k) && (k) < hi && (F.lane = lane_now(), F.tid = F.wave * 64 + F.lane, true))
#define SEAM(k) do { if (MK_N_LAUNCHES == 1 && IN(k) && IN((k) + 1)) xcd_barrier(bar); } while (0)
    LAS unsigned char* ring = F.lds;

#define REP(k) for (int rep_ = 0; rep_ < ((PROBE_DUP == (k) && ((k) == 0 || (k) == 6 || (k) == 9 || (k) == 11)) ? 2 : 1); ++rep_)
#define NREP(k) ((PROBE_DUP == (k)) ? 2 : 1)
    if (IN(0)) { REP(0) { p0_prologue(F, CW_Q0 + 64 * rep_); } SEAM(0); }
    if (IN(1)) {
        REP(1) {
        { pg8::Gemm g{F.WpT, F.WinP, 256, 256, 1024, nullptr}; pg8::FoldOrder S{F.G, F.bid}; pg8::EpiBf16 E{F.Win, DM, F.pool_scale, 1.f};
          pg8::gemm_phase<pg8::EpiBf16, pg8::FoldOrder, false, true>(ring, g, S, E, F.wave); }
        REP(11) { p1_norm_rows(F, F.x, F.g_mix, 0, DM, F.H); }
        }
        SEAM(1);
    }
    if (IN(2)) {
        REP(2) {
        pg8::Gemm g{F.H, F.Win, DM, DM, DM, nullptr}; pg8::StaticOrder S; S.init(NTOK, PLD, F.G, F.bid); S.reps = NREP(2); pg8::EpiBf16 E{F.P, PLD, nullptr, 1.f};
        pg8::gemm_phase<pg8::EpiBf16, pg8::StaticOrder, false, true>(ring, g, S, E, F.wave);
        }
        p0_deferred(F);
        SEAM(2);
    }
    if (IN(3)) { if (PROBE_DUP == 3) { p3_window(F); p3_indexer(F); } if (PROBE_DUP == 33) p3_window(F); p3_window(F); p3_indexer(F); SEAM(3); }
    if (IN(4)) { p4_attention(F, PROBE_DUP == 4 ? 512 : 256); SEAM(4); }
    if (IN(5)) {
        REP(5) {
        pg8::Gemm g{F.CAT, F.Wout, DM, DM, DM, nullptr}; pg8::StaticOrder S; S.init(NTOK, DM, F.G, F.bid); S.reps = NREP(5); pg8::EpiResid E{F.x, F.X1, F.mod + 2 * DM};
        pg8::gemm_phase<pg8::EpiResid, pg8::StaticOrder, false, true>(ring, g, S, E, F.wave);
        }
        SEAM(5);
    }
    if (IN(6)) { if (PROBE_DUP == 6) { REP(6) { p6_norm_router(F, rep_ == 0); } p0_late(F); } else p6_side_by_side(F); SEAM(6); }
    if (IN(7)) {
        moe_tables(F); p7_rowtab(F, NREP(7));
        REP(7) {
        pg8::Gemm g{F.H, F.Wgu, DM / 2, DM / 2, DM / 2, (const LAS unsigned*)(F.lds + MISC_BASE + MO_ROWTAB)};
        pg8::GroupedOrder S{moe_tabs(F), 4, F.G, F.vcu, 1024, NREP(7)}; pg8::EpiGateUp E{(unsigned char*)F.A, 1.f / WGU_SCALE};
        pg8::gemm_phase<pg8::EpiGateUp, pg8::GroupedOrder, true, true, true>(ring, g, S, E, F.wave);
        }
        SEAM(7);
    }
    if (IN(8)) {
        if (MK_N_LAUNCHES != 1) moe_tables(F);
        REP(8) {
        pg8::Gemm g{F.A, F.Wd, DEXP / 2, DEXP / 2, DEXP / 2, nullptr};
        pg8::GroupedOrder S{moe_tabs(F), 8, F.G, F.vcu, DM, NREP(8)}; pg8::EpiFp8 E{(unsigned char*)F.Y, DM, Y_SCALE / WD_SCALE};
        pg8::gemm_phase<pg8::EpiFp8, pg8::GroupedOrder, false, P8_ALIGN, true>(ring, g, S, E, F.wave);
        }
        SEAM(8);
    }
    if (IN(9)) { if (MK_N_LAUNCHES != 1) moe_tables(F); REP(9) { p9_final(F); } }
#undef REP
#undef NREP
#undef IN
#undef SEAM
}

extern "C" void kernel_launch(void* const* d_in, const int* in_sizes, int n_in, void* d_out, int out_size, void* d_ws, size_t ws_size, hipStream_t stream) {
    static int grid = 0;
    if (grid == 0) {
        if (n_in != 19 || in_sizes[0] != NTOK * DM || out_size != NTOK * DM || ws_size < WS_END) {
            fprintf(stderr, "kernel_launch: unexpected shapes (n_in %d, in0 %d, out %d, ws %zu); nothing launched\n", n_in, n_in > 0 ? in_sizes[0] : -1, out_size, ws_size); grid = -1; return; }
        int dev = 0, cus = 0;
        if (hipGetDevice(&dev) != hipSuccess || hipDeviceGetAttribute(&cus, hipDeviceAttributeMultiprocessorCount, dev) != hipSuccess || cus < 128) { fprintf(stderr, "kernel_launch: device query failed or too few CUs (%d)\n", cus); grid = -1; return; }
        if (hipFuncSetAttribute((const void*)fwd, hipFuncAttributeMaxDynamicSharedMemorySize, LDS_TOTAL) != hipSuccess) { fprintf(stderr, "kernel_launch: hipFuncSetAttribute failed\n"); grid = -1; return; }
        int per_cu = 0;
        if (hipOccupancyMaxActiveBlocksPerMultiprocessor(&per_cu, (const void*)fwd, NTHR, LDS_TOTAL) != hipSuccess || per_cu < 1) fprintf(stderr, "kernel_launch: note: occupancy query reports %d blocks per CU\n", per_cu);
        (void)hipGetLastError();
        grid = cus;
    }
    if (grid < 0) return;
    if (hipMemsetAsync((char*)d_ws + WS_CTL, 0, CTL_ZERO_BYTES, stream) != hipSuccess) { fprintf(stderr, "kernel_launch: memset failed\n"); return; }
    Args a{};
    for (int i = 0; i < 19; ++i) a.in[i] = (const float*)d_in[i];
    a.out = (float*)d_out; a.ws = (unsigned char*)d_ws;
    const int nl = MK_N_LAUNCHES;
    for (int li = 0; li < nl; ++li) {
        a.ph_lo = (nl == 1) ? 0 : li; a.ph_hi = (nl == 1) ? N_PHASES : li + 1;
        hipLaunchKernelGGL(fwd, dim3(grid), dim3(NTHR), LDS_TOTAL, stream, a);
        const hipError_t le = hipPeekAtLastError();
        if (le != hipSuccess) { fprintf(stderr, "kernel_launch: launch %d failed: %s\n", li, hipGetErrorName(le)); break; }
    }
}
```

```cpp
#include <hip/hip_runtime.h>
#include <cstdio>
#include <cstdint>

#ifndef MK_N_LAUNCHES
#define MK_N_LAUNCHES 1
#endif

#ifndef P8_ALIGN
#define P8_ALIGN true
#endif
#ifndef PROBE_DUP
#define PROBE_DUP -1
#endif
#define GAS __attribute__((address_space(1)))
#define LAS __attribute__((address_space(3)))
typedef unsigned short bf16;
typedef short bf16x8 __attribute__((ext_vector_type(8)));
typedef short s16x4 __attribute__((ext_vector_type(4)));
typedef float f32x4 __attribute__((ext_vector_type(4)));
typedef float f32x2 __attribute__((ext_vector_type(2)));
typedef float f32x16 __attribute__((ext_vector_type(16)));
typedef unsigned u32x4 __attribute__((ext_vector_type(4)));
typedef unsigned u32x2 __attribute__((ext_vector_type(2)));

constexpr int DM = 2048, NB = 8, SEQ = 2048, NTOK = NB * SEQ;
constexpr int POOLW = 1024, NHEAD = 8, HD = 128, NKV = 2, IDXH = 16, IDXD = 64, TOPK = 256;
constexpr int PIN = 3664, PLD = 3840;
constexpr int C_U = 0, C_Q = 1024, C_K = 2048, C_V = 2304, C_QI = 2560, C_KI = 3584, C_WI = 3648;
constexpr int NEXP = 32, DEXP = 512, NGRP = 4, EPG = 8;
constexpr int MAXSLOT = 40960;
constexpr float EPS = 1e-6f;

constexpr size_t MiB = 1u << 20;
constexpr size_t WS_CTL = 0, CTL_ZERO_BYTES = 1 * MiB;
constexpr size_t WS_MOD = 1 * MiB;
constexpr size_t WS_RW = 1 * MiB + 512 * 1024;
constexpr size_t WS_TOKINFO = 2 * MiB;
constexpr size_t WS_TOKLIST = 3 * MiB;
constexpr size_t WS_WPT = 5 * MiB;
constexpr size_t WS_MASK = 6 * MiB;
constexpr size_t WS_WINP = 10 * MiB;
constexpr size_t WS_WIN = 16 * MiB;
constexpr size_t WS_WOUT = 32 * MiB;
constexpr size_t WS_WGU = 40 * MiB;
constexpr size_t WS_WD = 168 * MiB;
constexpr size_t WS_H = 232 * MiB;
constexpr size_t WS_P = 296 * MiB;
constexpr size_t WS_CAT = 416 * MiB;
constexpr size_t WS_Y = 296 * MiB;
constexpr size_t WS_A = 480 * MiB;
constexpr size_t WS_X1 = 520 * MiB;
constexpr size_t WS_END = 584 * MiB;
static_assert(WS_Y + (size_t)MAXSLOT * DM * 2 <= WS_A && WS_P + (size_t)NTOK * PLD * 2 <= WS_CAT && WS_A + (size_t)MAXSLOT * DEXP * 2 <= WS_X1 && WS_X1 + (size_t)NTOK * DM * 2 <= WS_END, "ws map");
constexpr int CW_TMO = 0, CW_Q0 = 64, CW_BAR = 4096, CW_ECNT = 16384;

constexpr int RING_BYTES = 131072;
constexpr int MISC_OFF = RING_BYTES;
constexpr int LDS_BYTES = 147456;
constexpr int NWAVES = 8, NTHR = 512;

#define LDS_WAIT() asm volatile("s_waitcnt lgkmcnt(0)" ::: "memory")
#define VM_WAIT() asm volatile("s_waitcnt vmcnt(0)" ::: "memory")
__device__ __forceinline__ unsigned cvt_pk_bf16(float lo, float hi) { unsigned r; asm volatile("v_cvt_pk_bf16_f32 %0, %1, %2" : "=v"(r) : "v"(lo), "v"(hi)); return r; }
__device__ __forceinline__ float bf2f(bf16 v) { return __builtin_bit_cast(float, (unsigned)v << 16); }
__device__ __forceinline__ float wave_sum(float v) {
#pragma unroll
    for (int o = 1; o < 64; o <<= 1) v += __shfl_xor(v, o);
    return v;
}

__device__ __forceinline__ int lane_now() { int l; asm volatile("v_mbcnt_lo_u32_b32 %0, -1, 0\n\tv_mbcnt_hi_u32_b32 %0, -1, %0" : "=v"(l)); return l; }
namespace pg8 {
constexpr int BM = 256, BK = 64, HALF = 128, HTB = HALF * BK * 2, STAGE_BYTES = 8 * HTB, NXCD = 8, WGM = 4;
__host__ __device__ __forceinline__ int lds_byte(int r, int c) { const int st = (r >> 4) * 2 + (c >> 5), rr = r & 15, cc = c & 31, ob = rr * 64 + cc * 2; return st * 1024 + (ob ^ (((ob >> 9) & 1) << 5)); }
__host__ __device__ __forceinline__ void stage_rc(int b, int& R, int& C) { const int st = b / 1024, sb = b % 1024, swz = sb ^ (((sb >> 9) & 1) << 5); R = (st >> 1) * 16 + swz / 64; C = (st & 1) * 32 + (swz % 64) / 2; }
__host__ __device__ __forceinline__ int perm32(int rho) { const int n = rho >> 4, i = rho & 15; return 8 * (i >> 2) + 4 * n + (i & 3); }

typedef int v4i_t __attribute__((ext_vector_type(4)));
typedef int v8i_t __attribute__((ext_vector_type(8)));
struct Unit { int pm, pn, e, ord, half; };
struct Gemm { const bf16* A; const bf16* Bt; int K, lda, ldb; const LAS unsigned* rowtab; };

struct StaticOrder {
    int nM, nN, nwg, G, c, reps;
    __device__ void init(int M, int N, int G_, int c_) { nM = M / BM; nN = N / BM; nwg = nM * nN; G = G_; c = c_; reps = 1; }
    __device__ bool next(int i, Unit& u) const {
        const long L = (long)i * G + c; if (L >= (long)nwg * reps) return false;
        int wgid = (int)(L % nwg); { const int q = nwg / NXCD, r = nwg % NXCD, xcd = wgid % NXCD, off = wgid / NXCD; wgid = (xcd < r ? xcd * (q + 1) : r * (q + 1) + (xcd - r) * q) + off; }
        const int nig = WGM * nN, gid = wgid / nig, fm = gid * WGM, gsz = (nM - fm) < WGM ? (nM - fm) : WGM;
        u.pm = fm + ((wgid % nig) % gsz); u.pn = (wgid % nig) / gsz; u.e = 0; u.ord = i; u.half = 0; return true;
    }
    __device__ __forceinline__ size_t b_off(const Unit& u, int ldb) const { return (size_t)u.pn * BM * ldb * 2; }
};
struct FoldOrder {
    int G, c;
    __device__ bool next(int i, Unit& u) const { const int L = i * G + c; if (L >= 32) return false; u.pm = L >> 3; u.pn = L & 7; u.e = 0; u.ord = i; u.half = 0; return true; }
    __device__ __forceinline__ size_t b_off(const Unit& u, int ldb) const { return ((size_t)u.pn * BM * ldb + (size_t)u.pm * 256) * 2; }
};
struct MoeTabs { const LAS int* tb; const LAS int* tf; const LAS int* hl; };
__device__ __forceinline__ bool moe_unit(const MoeTabs& T, int NT, int L, int reps, int& pm, int& pn, int& e, int& half) {
    const int nf = T.tf[NEXP], nh = T.hl[NEXP], total = (nf + nh) * NT;
    if (L >= total * reps) return false;
    L %= total;
    const int mt = L / NT; pn = L - mt * NT;
    if (mt < nf) { int x = 0; while (x < NEXP - 1 && T.tf[x + 1] <= mt) ++x; e = x; pm = T.tb[x] + (mt - T.tf[x]); half = 0; }
    else { e = T.hl[mt - nf]; pm = T.tb[e + 1] - 1; half = 1; }
    return true;
}
struct GroupedOrder {
    MoeTabs T; int NT, G, c, rows_per_e, reps;
    __device__ bool next(int i, Unit& u) const { u.ord = i; return moe_unit(T, NT, i * G + c, reps, u.pm, u.pn, u.e, u.half); }
    __device__ __forceinline__ size_t b_off(const Unit& u, int ldb) const { return ((size_t)u.e * rows_per_e + (size_t)u.pn * BM) * ldb * 2; }
};

template <class Epi, class Sched, bool GATHER, bool ALIGN_EPI, bool FP8 = false>
__device__ __forceinline__ void gemm_phase(LAS unsigned char* lds, const Gemm g, const Sched& S, const Epi& E, const int wid) {
    const int lane = lane_now(), tid = wid * 64 + lane, wr = wid >> 2, wc = wid & 3, fr = lane & 15, fq = lane >> 4;
    const int K = g.K, nt = K / BK;
    int Rr[2], Cc[2];
    unsigned voffB[2];
    unsigned cva[2][2], nva[2][2];
#pragma unroll
    for (int i = 0; i < 2; ++i) { int R, C; stage_rc(tid * 16 + i * 8192, R, C); Rr[i] = R; Cc[i] = C; const int Rb = Epi::PERM ? ((R & ~31) + perm32(R & 31)) : R;
        voffB[i] = (unsigned)(Rb * g.ldb + C) * 2u; }
    const size_t kstep = (size_t)(BK * 2);
    const unsigned hstepA = (unsigned)HALF * g.lda * 2u;
    const size_t hstepB = (size_t)HALF * g.ldb * 2;
    const unsigned ldsw = (unsigned)wid * 1024u;
    const int aoff = lds_byte(wr * 64 + fr, fq * 8), boff = lds_byte(wc * 32 + fr, fq * 8);
#define PG8_SA(b, h) (((b) * 2 + (h)) * HTB)
#define PG8_SB(b, h) ((4 + (b) * 2 + (h)) * HTB)
#define PG8_STAGE(bufoff, gbase, v0, v1) do { \
        __builtin_amdgcn_global_load_lds((const unsigned*)((const char*)(gbase) + (v0)), (LAS unsigned*)(lds + (bufoff) + ldsw), 16, 0, 0); \
        __builtin_amdgcn_global_load_lds((const unsigned*)((const char*)(gbase) + (v1)), (LAS unsigned*)(lds + (bufoff) + ldsw + 8192), 16, 0, 0); } while (0)
#define PG8_STAGE_B(bufoff, gbase) PG8_STAGE(bufoff, gbase, voffB[0], voffB[1])
#define PG8_LD8(base) __builtin_shufflevector(*(const LAS v4i_t*)(base), *(const LAS v4i_t*)((base) + 1024), 0, 1, 2, 3, 4, 5, 6, 7)
#define PG8_LDA(dst, b, h) do { _Pragma("unroll") for (int m = 0; m < 4; ++m) dst[m] = PG8_LD8(lds + PG8_SA(b, h) + aoff + m * 2048); } while (0)
#define PG8_LDB(dst, b, h) do { _Pragma("unroll") for (int n = 0; n < 2; ++n) dst[n] = PG8_LD8(lds + PG8_SB(b, h) + boff + n * 2048); } while (0)
#define PG8_LO(x) __builtin_bit_cast(bf16x8, __builtin_shufflevector((x), (x), 0, 1, 2, 3))
#define PG8_HI(x) __builtin_bit_cast(bf16x8, __builtin_shufflevector((x), (x), 4, 5, 6, 7))
#define PG8_MMA(ai, bj, At, Bt) do { __builtin_amdgcn_s_setprio(1); _Pragma("unroll") for (int m = 0; m < 4; ++m) _Pragma("unroll") for (int n = 0; n < 2; ++n) { \
        if constexpr (FP8) asm volatile("v_mfma_scale_f32_16x16x128_f8f6f4 %0, %1, %2, %0, %3, %3 op_sel_hi:[0,0,0]" : "+v"(acc[ai][bj][m][n]) : "v"(Bt[n]), "v"(At[m]), "v"(sc8));   \
        else { acc[ai][bj][m][n] = __builtin_amdgcn_mfma_f32_16x16x32_bf16(PG8_LO(Bt[n]), PG8_LO(At[m]), acc[ai][bj][m][n], 0, 0, 0); \
               acc[ai][bj][m][n] = __builtin_amdgcn_mfma_f32_16x16x32_bf16(PG8_HI(Bt[n]), PG8_HI(At[m]), acc[ai][bj][m][n], 0, 0, 0); } } \
        __builtin_amdgcn_s_setprio(0); } while (0)
#define PG8_WAIT_V(n) asm volatile("s_waitcnt vmcnt(" #n ")" ::: "memory")
#define PG8_WAIT_L(n) asm volatile("s_waitcnt lgkmcnt(" #n ")" ::: "memory")
#define PG8_BAR __builtin_amdgcn_s_barrier()
#define PG8_SCHED __builtin_amdgcn_sched_barrier(0)
#define PG8_AOFF(dst, u) do { _Pragma("unroll") for (int h_ = 0; h_ < 2; ++h_) _Pragma("unroll") for (int i_ = 0; i_ < 2; ++i_) { \
        if constexpr (GATHER) dst[h_][i_] = g.rowtab[(u).ord * 256 + h_ * HALF + Rr[i_]] + (unsigned)Cc[i_] * 2u; \
        else dst[h_][i_] = (unsigned)(Rr[i_] * g.lda + Cc[i_]) * 2u + (unsigned)h_ * hstepA; } } while (0)
    Unit cur, nxt; int ui = 0;
    if (!S.next(0, cur)) return;
    const int sc8 = 0x7f7f7f7f;
    f32x4 acc[2][2][4][2];
#pragma unroll
    for (int a = 0; a < 2; ++a)
#pragma unroll
        for (int b = 0; b < 2; ++b)
#pragma unroll
            for (int m = 0; m < 4; ++m)
#pragma unroll
                for (int n = 0; n < 2; ++n) acc[a][b][m][n] = (f32x4){0.f, 0.f, 0.f, 0.f};
    v8i_t At[4], B0[2], B1[2];
    const size_t tstepA = (size_t)BM * g.lda * 2;
    const char* cA = GATHER ? (const char*)g.A : (const char*)g.A + (size_t)cur.pm * tstepA;
    const char* cB = (const char*)g.Bt + S.b_off(cur, g.ldb);
    PG8_AOFF(cva, cur);
#pragma unroll
    for (int h_ = 0; h_ < 2; ++h_)
#pragma unroll
        for (int i_ = 0; i_ < 2; ++i_) nva[h_][i_] = cva[h_][i_];
    if constexpr (GATHER) { LDS_WAIT(); }
    PG8_STAGE_B(PG8_SB(0, 0), cB); PG8_STAGE_B(PG8_SB(0, 1), cB + hstepB); PG8_STAGE(PG8_SA(0, 0), cA, cva[0][0], cva[0][1]); PG8_STAGE(PG8_SA(0, 1), cA, cva[1][0], cva[1][1]);
    if (wr == 1) PG8_BAR;
    PG8_WAIT_V(2); PG8_BAR;
    PG8_STAGE_B(PG8_SB(1, 0), cB + kstep); PG8_STAGE(PG8_SA(1, 0), cA + kstep, cva[0][0], cva[0][1]); PG8_STAGE_B(PG8_SB(1, 1), cB + hstepB + kstep);
    PG8_WAIT_V(6); PG8_BAR;
    for (;;) {
        const bool has_next = S.next(ui + 1, nxt);
        const bool full = (cur.half == 0);
        const char* nA = GATHER ? cA : (has_next ? (const char*)g.A + (size_t)nxt.pm * tstepA : cA);
        const char* nB = has_next ? (const char*)g.Bt + S.b_off(nxt, g.ldb) : cB;
#pragma nounroll
        for (int t = 0; t < nt; t += 2) {
            const bool last = (t == nt - 2);
            const char* a1 = cA + (size_t)(t + 1) * kstep;
            const char* a2 = last ? nA : cA + (size_t)(t + 2) * kstep; const char* b2 = last ? nB : cB + (size_t)(t + 2) * kstep;
            const char* a3 = a2 + kstep; const char* b3 = b2 + kstep;
            if (last) { if (has_next) { PG8_AOFF(nva, nxt); } else {
#pragma unroll
                for (int h_ = 0; h_ < 2; ++h_)
#pragma unroll
                    for (int i_ = 0; i_ < 2; ++i_) nva[h_][i_] = cva[h_][i_]; }
                if constexpr (GATHER) { LDS_WAIT(); } }
            unsigned v2[2][2];
#pragma unroll
            for (int h_ = 0; h_ < 2; ++h_)
#pragma unroll
                for (int i_ = 0; i_ < 2; ++i_) v2[h_][i_] = last ? nva[h_][i_] : cva[h_][i_];
            PG8_LDB(B0, 0, 0); PG8_LDB(B1, 0, 1); PG8_SCHED; PG8_LDA(At, 0, 0); PG8_STAGE(PG8_SA(1, 1), a1, cva[1][0], cva[1][1]);
            PG8_WAIT_V(8); PG8_WAIT_L(0); PG8_BAR; PG8_MMA(0, 0, At, B0); PG8_MMA(0, 1, At, B1); PG8_BAR; PG8_SCHED;
            PG8_LDA(At, 0, 1); PG8_STAGE_B(PG8_SB(0, 0), b2); PG8_STAGE_B(PG8_SB(0, 1), b2 + hstepB); PG8_STAGE(PG8_SA(0, 0), a2, v2[0][0], v2[0][1]);
            PG8_WAIT_V(8); PG8_WAIT_L(0); PG8_BAR; if (full) { PG8_MMA(1, 0, At, B0); PG8_MMA(1, 1, At, B1); } PG8_BAR; PG8_SCHED;
            PG8_LDB(B0, 1, 0); PG8_LDB(B1, 1, 1); PG8_SCHED; PG8_LDA(At, 1, 0); PG8_STAGE(PG8_SA(0, 1), a2, v2[1][0], v2[1][1]);
            PG8_WAIT_V(8); PG8_WAIT_L(0); PG8_BAR; PG8_MMA(0, 0, At, B0); PG8_MMA(0, 1, At, B1); PG8_BAR; PG8_SCHED;
            PG8_LDA(At, 1, 1); PG8_STAGE_B(PG8_SB(1, 0), b3); PG8_STAGE_B(PG8_SB(1, 1), b3 + hstepB); PG8_STAGE(PG8_SA(1, 0), a3, v2[0][0], v2[0][1]);
            PG8_WAIT_V(8); PG8_WAIT_L(0); PG8_BAR; if (full) { PG8_MMA(1, 0, At, B0); PG8_MMA(1, 1, At, B1); } PG8_BAR; PG8_SCHED;
        }
        if constexpr (FP8) asm volatile("s_nop 15\n\ts_nop 15" ::: "memory");
        if constexpr (ALIGN_EPI) { if (wr == 0) PG8_BAR; }
        E(acc, cur, wr, wc, fr, fq);
        if (!has_next) break;
#pragma unroll
        for (int a = 0; a < 2; ++a)
#pragma unroll
            for (int b = 0; b < 2; ++b)
#pragma unroll
                for (int m = 0; m < 4; ++m)
#pragma unroll
                    for (int n = 0; n < 2; ++n) acc[a][b][m][n] = (f32x4){0.f, 0.f, 0.f, 0.f};
        cur = nxt; cA = nA; cB = nB; ++ui;
#pragma unroll
        for (int h_ = 0; h_ < 2; ++h_)
#pragma unroll
            for (int i_ = 0; i_ < 2; ++i_) cva[h_][i_] = nva[h_][i_];
        if constexpr (ALIGN_EPI) { if (wr == 1) PG8_BAR; }
    }
    PG8_WAIT_V(0);
    if constexpr (!ALIGN_EPI) { if (wr == 0) PG8_BAR; }
    PG8_BAR;
#undef PG8_SA
#undef PG8_SB
#undef PG8_STAGE
#undef PG8_STAGE_B
#undef PG8_LDA
#undef PG8_LDB
#undef PG8_MMA
#undef PG8_LD8
#undef PG8_LO
#undef PG8_HI
#undef PG8_WAIT_V
#undef PG8_WAIT_L
#undef PG8_BAR
#undef PG8_SCHED
#undef PG8_AOFF
}

struct EpiBf16 {
    static constexpr bool PERM = true;
    bf16* O; int ldc; const float* rowscale; float oscale;
    __device__ __forceinline__ void operator()(const f32x4 (&acc)[2][2][4][2], const Unit& u, int wr, int wc, int fr, int fq) const {
        const int row0 = u.pm * BM + wr * 64 + fr, col0 = u.pn * BM + wc * 32 + 8 * fq;
#pragma unroll
        for (int ai = 0; ai < 2; ++ai)
#pragma unroll
            for (int m = 0; m < 4; ++m) { const int row = row0 + ai * HALF + m * 16; bf16* rowp = O + (size_t)row * ldc + col0; const float s = rowscale ? rowscale[row] * oscale : oscale;
#pragma unroll
                for (int bj = 0; bj < 2; ++bj) { const f32x4 v0 = acc[ai][bj][m][0] * s, v1 = acc[ai][bj][m][1] * s;
                    u32x4 w; w.x = cvt_pk_bf16(v0[0], v0[1]); w.y = cvt_pk_bf16(v0[2], v0[3]); w.z = cvt_pk_bf16(v1[0], v1[1]); w.w = cvt_pk_bf16(v1[2], v1[3]);
                    *(u32x4*)(rowp + bj * HALF) = w; } }
    }
};
struct EpiFp8 {
    static constexpr bool PERM = true;
    unsigned char* O; int ldc; float oscale;
    __device__ __forceinline__ void operator()(const f32x4 (&acc)[2][2][4][2], const Unit& u, int wr, int wc, int fr, int fq) const {
        const int row0 = u.pm * BM + wr * 64 + fr, col0 = u.pn * BM + wc * 32 + 8 * fq;
#pragma unroll
        for (int ai = 0; ai < 2; ++ai)
#pragma unroll
            for (int m = 0; m < 4; ++m) { unsigned char* rowp = O + (size_t)(row0 + ai * HALF + m * 16) * ldc + col0;
#pragma unroll
                for (int bj = 0; bj < 2; ++bj) { const f32x4 v0 = acc[ai][bj][m][0] * oscale, v1 = acc[ai][bj][m][1] * oscale; u32x2 w;
                    { int p = __builtin_amdgcn_cvt_pk_fp8_f32(v0[0], v0[1], 0, false); p = __builtin_amdgcn_cvt_pk_fp8_f32(v0[2], v0[3], p, true); w.x = (unsigned)p; }
                    { int p = __builtin_amdgcn_cvt_pk_fp8_f32(v1[0], v1[1], 0, false); p = __builtin_amdgcn_cvt_pk_fp8_f32(v1[2], v1[3], p, true); w.y = (unsigned)p; }
                    *(u32x2*)(rowp + bj * HALF) = w; } }
    }
};
struct EpiResid {
    static constexpr bool PERM = true;
    const float* X; bf16* X1; const float* gate;
    __device__ __forceinline__ void operator()(const f32x4 (&acc)[2][2][4][2], const Unit& u, int wr, int wc, int fr, int fq) const {
        const int row0 = u.pm * BM + wr * 64 + fr, col0 = u.pn * BM + wc * 32 + 8 * fq;
        const float* gp = gate + (size_t)((u.pm * BM) / SEQ) * (6 * DM) + col0;
        f32x4 gv[2][2];
#pragma unroll
        for (int bj = 0; bj < 2; ++bj)
#pragma unroll
            for (int n = 0; n < 2; ++n) gv[bj][n] = *(const f32x4*)(gp + bj * HALF + n * 4);
#pragma unroll
        for (int ai = 0; ai < 2; ++ai) {
            f32x4 xv[4][2][2];
#pragma unroll
            for (int m = 0; m < 4; ++m) { const size_t ro = (size_t)(row0 + ai * HALF + m * 16) * DM + col0;
#pragma unroll
                for (int bj = 0; bj < 2; ++bj) { xv[m][bj][0] = *(const f32x4*)(X + ro + bj * HALF); xv[m][bj][1] = *(const f32x4*)(X + ro + bj * HALF + 4); } }
#pragma unroll
            for (int m = 0; m < 4; ++m) { const size_t ro = (size_t)(row0 + ai * HALF + m * 16) * DM + col0;
#pragma unroll
                for (int bj = 0; bj < 2; ++bj) {
                    const f32x4 v0 = xv[m][bj][0] + gv[bj][0] * acc[ai][bj][m][0], v1 = xv[m][bj][1] + gv[bj][1] * acc[ai][bj][m][1];
                    u32x4 w; w.x = cvt_pk_bf16(v0[0], v0[1]); w.y = cvt_pk_bf16(v0[2], v0[3]); w.z = cvt_pk_bf16(v1[0], v1[1]); w.w = cvt_pk_bf16(v1[2], v1[3]);
                    *(u32x4*)(X1 + ro + bj * HALF) = w; } }
        }
    }
};
struct EpiGateUp {
    static constexpr bool PERM = true;
    unsigned char* O; float isc;
    __device__ __forceinline__ void operator()(const f32x4 (&acc)[2][2][4][2], const Unit& u, int wr, int wc, int fr, int fq) const {
        const int row0 = u.pm * BM + wr * 64 + fr, col0 = u.pn * HALF + wc * 32 + 8 * fq;
#pragma unroll
        for (int ai = 0; ai < 2; ++ai)
#pragma unroll
            for (int m = 0; m < 4; ++m) { unsigned char* rowp = O + (size_t)(row0 + ai * HALF + m * 16) * DEXP + col0; float r[8];
#pragma unroll
                for (int n = 0; n < 2; ++n)
#pragma unroll
                    for (int j = 0; j < 4; ++j) { const float gt = acc[ai][0][m][n][j] * isc, up = acc[ai][1][m][n][j] * isc;
                        r[n * 4 + j] = gt * __builtin_amdgcn_rcpf(1.f + __builtin_amdgcn_exp2f(-1.4426950408889634f * gt)) * up; }
                u32x2 w; { int p = __builtin_amdgcn_cvt_pk_fp8_f32(r[0], r[1], 0, false); p = __builtin_amdgcn_cvt_pk_fp8_f32(r[2], r[3], p, true); w.x = (unsigned)p; }
                { int p = __builtin_amdgcn_cvt_pk_fp8_f32(r[4], r[5], 0, false); p = __builtin_amdgcn_cvt_pk_fp8_f32(r[6], r[7], p, true); w.y = (unsigned)p; }
                *(u32x2*)rowp = w; }
    }
};
}

constexpr int MISC_BASE = 139264;
constexpr int LDS_TOTAL = 159744;
constexpr int MO_BARW = 0;
constexpr int MO_TB = 256;
constexpr int MO_CNT = 768;
constexpr int MO_ROWTAB = 1024;
constexpr int MO_BIAS = 10240;
constexpr int MAXU = 8;
static_assert(MISC_BASE + MO_BIAS + 304 * 4 <= LDS_TOTAL, "lds map");

#define XB_TMO      128
#define XB_XCNT(j)  (256  + 64 * (j))
#define XB_XSUB(j)  (1280 + 64 * (j))
#define XB_XGEN(j)  (2304 + 64 * (j))
#define XB_TOP      3328
#define XB_TOPGEN   3392
#define XCD_BAR_WORDS 3456
#define XB_SPIN_CAP (1u << 18)
__device__ __forceinline__ unsigned xb_ld(unsigned* p)              { return __hip_atomic_load(p, __ATOMIC_RELAXED, __HIP_MEMORY_SCOPE_AGENT); }
__device__ __forceinline__ unsigned xb_add(unsigned* p, unsigned v) { return __hip_atomic_fetch_add(p, v, __ATOMIC_RELAXED, __HIP_MEMORY_SCOPE_AGENT); }
__device__ __forceinline__ unsigned xb_xcc_id() { return (unsigned)__builtin_amdgcn_s_getreg((3 << 11) | 20) & 0xFu; }
#define XB_SPIN(cond, bar) do { unsigned _sp = 0; while (cond) { __builtin_amdgcn_s_sleep(1); \
    if ((++_sp & 255u) == 0u) { if (xb_ld(&(bar)[XB_TMO])) break; if (_sp > XB_SPIN_CAP) { atomicAdd(&(bar)[XB_TMO], 1u); break; } } } } while (0)
struct XcdBarrier { unsigned* bar; unsigned x; volatile LAS unsigned* st; int wave; };
__device__ __forceinline__ XcdBarrier xcd_barrier_post(unsigned* bar, volatile LAS unsigned* st, int wave) {
    XcdBarrier b; b.bar = bar; b.x = xb_xcc_id(); b.st = st; b.wave = wave;
    if (wave == 0 && lane_now() == 0) (void)xb_add(&bar[XB_XCNT(b.x)], 1u);
    return b;
}
__device__ __forceinline__ void xcd_barrier_complete(unsigned* bar, unsigned x, unsigned& nloc, unsigned& nx) {
    const unsigned G = gridDim.x * gridDim.y * gridDim.z;
    unsigned sum, cnt, mine, sp = 0u;
    for (;;) {
        sum = 0u; cnt = 0u; mine = 0u;
#pragma unroll
        for (unsigned j = 0; j < 16; ++j) { const unsigned c = xb_ld(&bar[XB_XCNT(j)]); sum += c; cnt += (c > 0u) ? 1u : 0u; mine = (j == x) ? c : mine; }
        if (sum == G) break;
        __builtin_amdgcn_s_sleep(1);
        if ((++sp & 255u) == 0u) { if (xb_ld(&bar[XB_TMO])) break; if (sp > XB_SPIN_CAP) { atomicAdd(&bar[XB_TMO], 1u); break; } }
    }
    nloc = mine > 0u ? mine : 1u; nx = cnt > 0u ? cnt : 1u;
}
__device__ __forceinline__ void xcd_barrier(const XcdBarrier& b) {
    asm volatile("s_waitcnt vmcnt(0)" ::: "memory");
    __syncthreads();
    if (b.wave == 0 && lane_now() == 0) {
        unsigned* bar = b.bar;
        __builtin_amdgcn_s_waitcnt(0);
        unsigned nloc = b.st[0], nx = b.st[1];
        if (nloc == 0u) { xcd_barrier_complete(bar, b.x, nloc, nx); b.st[0] = nloc; b.st[1] = nx; }
        const unsigned old = xb_add(&bar[XB_XSUB(b.x)], 1u);
        const unsigned gen = old / nloc;
        if (old + 1u == (gen + 1u) * nloc) {
            __builtin_amdgcn_fence(__ATOMIC_RELEASE, "agent");
            asm volatile("s_waitcnt vmcnt(0)" ::: "memory");
            const unsigned og = xb_add(&bar[XB_TOP], 1u);
            const unsigned tg = og / nx;
            if (og + 1u == (tg + 1u) * nx) xb_add(&bar[XB_TOPGEN], 1u);
            else XB_SPIN(xb_ld(&bar[XB_TOPGEN]) == tg, bar);
            __builtin_amdgcn_fence(__ATOMIC_ACQUIRE, "agent");
            xb_add(&bar[XB_XGEN(b.x)], 1u);
            asm volatile("s_waitcnt vmcnt(0)" ::: "memory");
        } else {
            XB_SPIN(xb_ld(&bar[XB_XGEN(b.x)]) == gen, bar);
            __builtin_amdgcn_fence(__ATOMIC_ACQUIRE, "agent");
            asm volatile("s_waitcnt vmcnt(0)" ::: "memory");
        }
    }
    __syncthreads();
}

struct Frame {
    LAS unsigned char* lds;
    unsigned* ctl;
    int tid, lane, wave, G, bid, vcu;
    const float *x, *c, *w_ada, *b_ada, *g_mix, *w_in, *w_pool, *pool_scale, *rel_bias, *w_out, *g_ffn, *w_group, *b_group, *w_router, *b_router, *w_gate, *w_up, *w_down, *g_final;
    float* out; float* mod;
    bf16 *RW, *WpT, *WinP, *Win, *Wout, *Wgu, *Wd, *H, *P, *CAT, *Y, *A, *X1;
    unsigned* MASK; int* TOKLIST; unsigned* TOKINFO;
};

constexpr float Y_SCALE = 8.f;
constexpr float WD_SCALE = 16.f;
constexpr float WGU_SCALE = 32.f;
__device__ __forceinline__ unsigned pk4_fp8(float a, float b, float c, float d) { int p = __builtin_amdgcn_cvt_pk_fp8_f32(a, b, 0, false); p = __builtin_amdgcn_cvt_pk_fp8_f32(c, d, p, true); return (unsigned)p; }
struct P0Tile { const float* src; unsigned char* dst; int ld_src, k0, n0, nvalid, ld_dst, himul, radd, fp8; float scale; };
constexpr int P0_R0 = 32 * 44, P0_R1 = 32 * 32, P0_R2 = 32 * 256, P0_R5 = 64, P0_R6 = 512, P0_R7 = 32;
constexpr int P0_TILES = P0_R0 + P0_R1 + 3 * P0_R2 + P0_R5;
constexpr int P0_ITEMS = P0_TILES + P0_R6 + P0_R7;
constexpr int P0_DEF_E0 = 16;
constexpr int P0_OFF_START = P0_R0 + P0_R1 + 2 * P0_R2 + P0_DEF_E0 * 256, P0_OFF_LEN = (32 - P0_DEF_E0) * 256;
__device__ __forceinline__ P0Tile p0_decode(Frame& F, int it) {
    P0Tile t; t.fp8 = 0; t.scale = 1.f; t.himul = 128; t.radd = 0;
    if (it < P0_R0) { const int kb = it / 44, nb = it % 44; t.src = F.w_in; t.ld_src = PIN; t.k0 = 64 * kb; t.n0 = 1024 + 64 * nb; t.nvalid = PIN; t.dst = (unsigned char*)F.Win; t.ld_dst = DM * 2; return t; } it -= P0_R0;
    if (it < P0_R1) { const int kb = it >> 5, nb = it & 31; t.src = F.w_out; t.ld_src = DM; t.k0 = 64 * kb; t.n0 = 64 * nb; t.nvalid = DM; t.dst = (unsigned char*)F.Wout; t.ld_dst = DM * 2; return t; } it -= P0_R1;
    if (it < 2 * P0_R2) { const int up = it >= P0_R2; if (up) it -= P0_R2; const int e = it >> 8, r = it & 255, kb = r >> 4, nb = r & 15;
        t.src = (up ? F.w_up : F.w_gate) + (size_t)e * DM * DEXP; t.ld_src = DEXP; t.k0 = 128 * kb; t.n0 = 32 * nb; t.nvalid = DEXP; t.dst = (unsigned char*)F.Wgu + (size_t)e * 1024 * DM; t.ld_dst = DM;
        t.himul = 256; t.radd = up ? 128 : 0; t.fp8 = 1; t.scale = WGU_SCALE; return t; } it -= 2 * P0_R2;
    if (it < P0_R2) { const int e = it >> 8, r = it & 255, kb = r >> 6, nb = r & 63;
        t.src = F.w_down + (size_t)e * DEXP * DM; t.ld_src = DM; t.k0 = 128 * kb; t.n0 = 32 * nb; t.nvalid = DM; t.dst = (unsigned char*)F.Wd + (size_t)e * DM * DEXP; t.ld_dst = DEXP; t.fp8 = 1; t.scale = WD_SCALE; return t; } it -= P0_R2;
    { const int g = it >> 4, r = it & 15, kb = r >> 2, nb = r & 3; t.src = F.w_pool + (size_t)g * 65536; t.ld_src = 256; t.k0 = 64 * kb; t.n0 = 64 * nb; t.nvalid = 256; t.dst = (unsigned char*)(F.WpT + (size_t)g * 65536); t.ld_dst = 512; return t; }
}
__device__ __forceinline__ void p0_tile_load(const P0Tile& t, f32x4 (&v)[16], int lane) {
    const int sh = t.fp8 ? 3 : 4, nn = (lane & ((1 << sh) - 1)) * 4, kr = lane >> sh;
#pragma unroll
    for (int i = 0; i < 16; ++i) { v[i] = (f32x4){0.f, 0.f, 0.f, 0.f}; if (t.n0 + nn < t.nvalid) v[i] = *(const f32x4*)(t.src + (size_t)(t.k0 + 16 * kr + i) * t.ld_src + t.n0 + nn); }
}
__device__ __forceinline__ void p0_tile_pack(const P0Tile& t, const f32x4 (&v)[16], u32x4 (&o)[8]) {
    if (t.fp8) {
        const float sc = t.scale;
#pragma unroll
        for (int j = 0; j < 4; ++j) { u32x4 p; p.x = pk4_fp8(v[0][j] * sc, v[1][j] * sc, v[2][j] * sc, v[3][j] * sc); p.y = pk4_fp8(v[4][j] * sc, v[5][j] * sc, v[6][j] * sc, v[7][j] * sc);
            p.z = pk4_fp8(v[8][j] * sc, v[9][j] * sc, v[10][j] * sc, v[11][j] * sc); p.w = pk4_fp8(v[12][j] * sc, v[13][j] * sc, v[14][j] * sc, v[15][j] * sc); o[2 * j] = p; o[2 * j + 1] = p; }
    } else {
#pragma unroll
        for (int j = 0; j < 4; ++j) {
            o[2 * j].x = cvt_pk_bf16(v[0][j], v[1][j]); o[2 * j].y = cvt_pk_bf16(v[2][j], v[3][j]); o[2 * j].z = cvt_pk_bf16(v[4][j], v[5][j]); o[2 * j].w = cvt_pk_bf16(v[6][j], v[7][j]);
            o[2 * j + 1].x = cvt_pk_bf16(v[8][j], v[9][j]); o[2 * j + 1].y = cvt_pk_bf16(v[10][j], v[11][j]); o[2 * j + 1].z = cvt_pk_bf16(v[12][j], v[13][j]); o[2 * j + 1].w = cvt_pk_bf16(v[14][j], v[15][j]); }
    }
}
__device__ __forceinline__ void p0_tile_store(const P0Tile& t, const u32x4 (&o)[8], int lane) {
    const int sh = t.fp8 ? 3 : 4, nn = (lane & ((1 << sh) - 1)) * 4, kr = lane >> sh;
#pragma unroll
    for (int j = 0; j < 4; ++j) { const int ng = t.n0 + nn + j, row = (ng >> 7) * t.himul + (ng & 127) + t.radd;
        unsigned char* d = t.dst + (size_t)row * t.ld_dst;
        const int ko = (t.k0 + 16 * kr) << (t.fp8 ? 0 : 1);
        *(u32x4*)(d + ko) = o[2 * j];
        if (!t.fp8) *(u32x4*)(d + ko + 16) = o[2 * j + 1]; }
}
__device__ __forceinline__ void p0_small_item(Frame& F, int it) {
    const int lane = F.lane;
    if (it < P0_R6) {
        f32x4 v[4][4];
#pragma unroll
        for (int rr = 0; rr < 4; ++rr)
#pragma unroll
            for (int j = 0; j < 4; ++j) v[rr][j] = *(const f32x4*)(F.w_in + (size_t)(it * 4 + rr) * PIN + j * 256 + lane * 4);
#pragma unroll
        for (int rr = 0; rr < 4; ++rr)
#pragma unroll
            for (int j = 0; j < 4; ++j) { u32x2 o; o.x = cvt_pk_bf16(v[rr][j][0], v[rr][j][1]); o.y = cvt_pk_bf16(v[rr][j][2], v[rr][j][3]);
                *(u32x2*)(F.WinP + (size_t)(it * 4 + rr) * 1024 + j * 256 + lane * 4) = o; }
        return; } it -= P0_R6;
    {
        const int k = it * 64 + lane;
        const f32x4 g = *(const f32x4*)(F.w_group + (size_t)k * 4);
        f32x4 r[8];
#pragma unroll
        for (int q = 0; q < 8; ++q) r[q] = *(const f32x4*)(F.w_router + (size_t)k * 32 + 4 * q);
#pragma unroll
        for (int j = 0; j < 48; ++j) { float v = 0.f; if (j < 4) v = g[j]; else if (j < 36) v = r[(j - 4) >> 2][(j - 4) & 3];
            F.RW[(size_t)j * DM + k] = (bf16)(cvt_pk_bf16(v, 0.f) & 0xffffu); }
    }
}
__device__ __forceinline__ void p0_mod_item(Frame& F, int m) {
    LAS float* sil = (LAS float*)F.lds;
    LAS float* part = (LAS float*)(F.lds + 65536);
    { float cv[NB * DM / NTHR];
#pragma unroll
      for (int q = 0; q < NB * DM / NTHR; ++q) cv[q] = F.c[F.tid + q * NTHR];
#pragma unroll
      for (int q = 0; q < NB * DM / NTHR; ++q) sil[F.tid + q * NTHR] = cv[q] / (1.f + __expf(-cv[q])); }
    __syncthreads();
    const int lane = F.lane, cq = lane & 15, rs = lane >> 4, j0 = 64 * m + 4 * cq;
    f32x4 acc[NB];
#pragma unroll
    for (int b = 0; b < NB; ++b) acc[b] = (f32x4){0.f, 0.f, 0.f, 0.f};
#pragma unroll 1
    for (int i0 = 0; i0 < 64; i0 += 16) {
        f32x4 w[16];
#pragma unroll
        for (int u = 0; u < 16; ++u) w[u] = *(const f32x4*)(F.w_ada + (size_t)(256 * F.wave + 4 * (i0 + u) + rs) * (6 * DM) + j0);
        __builtin_amdgcn_sched_barrier(0);
#pragma unroll
        for (int u = 0; u < 16; ++u) { const int k = 256 * F.wave + 4 * (i0 + u) + rs;
#pragma unroll
            for (int b = 0; b < NB; ++b) acc[b] += w[u] * sil[b * DM + k];
            if ((u & 1) == 1) __builtin_amdgcn_sched_barrier(0); }
    }
#pragma unroll
    for (int b = 0; b < NB; ++b)
#pragma unroll
        for (int j = 0; j < 4; ++j) { float v = acc[b][j]; v += __shfl_xor(v, 16); v += __shfl_xor(v, 32); acc[b][j] = v; }
    if (rs == 0) {
#pragma unroll
        for (int b = 0; b < NB; ++b) *(LAS f32x4*)(part + (F.wave * NB + b) * 64 + 4 * cq) = acc[b]; }
    __syncthreads();
    { const int b = F.tid >> 6, col = F.tid & 63; float s = F.b_ada[64 * m + col];
#pragma unroll
        for (int w = 0; w < NWAVES; ++w) s += part[(w * NB + b) * 64 + col];
        F.mod[(size_t)b * (6 * DM) + 64 * m + col] = s; }
    __syncthreads();
}
__device__ __forceinline__ void p0_run(Frame& F, int r, int stride, int a0, int lenA, int b0, int lenB) {
    const int total = lenA + lenB;
#define P0_MAP(d) ((d) < lenA ? a0 + (d) : b0 + ((d) - lenA))
    f32x4 v[16]; u32x4 o[8]; bool loaded = false; P0Tile cur, nxt;
    if (r < total && P0_MAP(r) < P0_TILES) { cur = p0_decode(F, P0_MAP(r)); p0_tile_load(cur, v, F.lane); loaded = true; }
    for (int d = r; d < total; d += stride) {
        const int it = P0_MAP(d);
        if (it < P0_TILES) {
            if (!loaded) { cur = p0_decode(F, it); p0_tile_load(cur, v, F.lane); }
            p0_tile_pack(cur, v, o);
            const int dn = d + stride; loaded = false;
            if (dn < total && P0_MAP(dn) < P0_TILES) { nxt = p0_decode(F, P0_MAP(dn)); p0_tile_load(nxt, v, F.lane); loaded = true; }
            p0_tile_store(cur, o, F.lane);
            cur = nxt;
        } else p0_small_item(F, it - P0_TILES);
    }
#undef P0_MAP
}
constexpr int P0_EARLY_A = P0_R0 + P0_R1, P0_EARLY_B0 = P0_R0 + P0_R1 + 3 * P0_R2, P0_EARLY_BLEN = P0_ITEMS - P0_EARLY_B0;
__device__ __forceinline__ void p0_prologue(Frame& F, int qword) {
    (void)qword;
    __syncthreads();
    for (int m = F.bid; m < 192; m += F.G) p0_mod_item(F, m);
    const int gw = F.bid * NWAVES + F.wave;
    const int r = (F.G == 256) ? ((F.bid >= 192) ? gw - 192 * NWAVES : gw + 64 * NWAVES) : gw;
    p0_run(F, r, F.G * NWAVES, 0, P0_EARLY_A, P0_EARLY_B0, P0_EARLY_BLEN);
}
__device__ __forceinline__ void p0_late(Frame& F) {
    __syncthreads();
    const int end = (F.G == 256) ? P0_OFF_START : P0_EARLY_B0;
    p0_run(F, F.bid * NWAVES + F.wave, F.G * NWAVES, P0_EARLY_A + P0_R2, end - P0_EARLY_A - P0_R2, 0, 0);
}
__device__ __forceinline__ void p0_deferred(Frame& F) {
    if (F.G != 256 || F.bid < 192) return;
    f32x4 va[16], vb[16]; u32x4 o[8]; P0Tile ta, tb, t; constexpr int ST = 64 * NWAVES;
    int ja = (F.bid - 192) * NWAVES + F.wave, jb = ja + ST;
    if (ja < P0_OFF_LEN) { ta = p0_decode(F, P0_OFF_START + ja); p0_tile_load(ta, va, F.lane); }
    if (jb < P0_OFF_LEN) { tb = p0_decode(F, P0_OFF_START + jb); p0_tile_load(tb, vb, F.lane); }
    while (ja < P0_OFF_LEN) {
        p0_tile_pack(ta, va, o); t = ta; ja += 2 * ST;
        if (ja < P0_OFF_LEN) { ta = p0_decode(F, P0_OFF_START + ja); p0_tile_load(ta, va, F.lane); }
        p0_tile_store(t, o, F.lane);
        if (jb >= P0_OFF_LEN) break;
        p0_tile_pack(tb, vb, o); t = tb; jb += 2 * ST;
        if (jb < P0_OFF_LEN) { tb = p0_decode(F, P0_OFF_START + jb); p0_tile_load(tb, vb, F.lane); }
        p0_tile_store(t, o, F.lane);
    }
}

__device__ __forceinline__ void p1_norm_rows(Frame& F, const float* xin, const float* gvec, int sh_off, int sc_off, bf16* hout) {
    const int gw = F.bid * NWAVES + F.wave, NGW = F.G * NWAVES, lane = F.lane;
    for (int grp = gw; grp < NTOK / 8; grp += NGW) {
        const int m0 = grp * 8, b = m0 / SEQ;
        const float* modb = F.mod + (size_t)b * (6 * DM);
        f32x4 gs[8], sh[8];
#pragma unroll
        for (int j = 0; j < 8; ++j) { const int col = 256 * j + 4 * lane; const f32x4 g = *(const f32x4*)(gvec + col), sc = *(const f32x4*)(modb + sc_off + col);
            gs[j] = g * (sc + 1.f); sh[j] = *(const f32x4*)(modb + sh_off + col); }
        f32x4 xa[8], xb[8];
#pragma unroll
        for (int j = 0; j < 8; ++j) xa[j] = *(const f32x4*)(xin + (size_t)m0 * DM + 256 * j + 4 * lane);
#define P1_ROW(CUR, NXT, r) do { \
            if ((r) + 1 < 8) { _Pragma("unroll") for (int j = 0; j < 8; ++j) NXT[j] = *(const f32x4*)(xin + (size_t)(m0 + (r) + 1) * DM + 256 * j + 4 * lane); } \
            float s = 0.f; \
            _Pragma("unroll") for (int j = 0; j < 8; ++j) s += (CUR[j][0] * CUR[j][0] + CUR[j][1] * CUR[j][1]) + (CUR[j][2] * CUR[j][2] + CUR[j][3] * CUR[j][3]); \
            const float rstd = 1.f / sqrtf(wave_sum(s) * (1.f / DM) + EPS); \
            bf16* orow = hout + (size_t)(m0 + (r)) * DM; \
            _Pragma("unroll") for (int j = 0; j < 8; ++j) { const f32x4 y = CUR[j] * rstd * gs[j] + sh[j]; \
                u32x2 o; o.x = cvt_pk_bf16(y[0], y[1]); o.y = cvt_pk_bf16(y[2], y[3]); *(u32x2*)(orow + 256 * j + 4 * lane) = o; } } while (0)
#pragma unroll 1
        for (int rp = 0; rp < 4; ++rp) { P1_ROW(xa, xb, 2 * rp); P1_ROW(xb, xa, 2 * rp + 1); }
#undef P1_ROW
    }
}

template <int W>
__device__ __forceinline__ void p3_window_load(Frame& F, int g, int tp, int lane, bf16x8 (&v)[W]) {
    const int m = 2 * tp + (lane >> 5), t = m & (SEQ - 1), c0 = g * 256 + 8 * (lane & 31);
    const char* up = (const char*)(F.P + (size_t)m * PLD + C_U + c0);
#pragma unroll
    for (int tau = 0; tau < W; ++tau) { const int back = (t - tau >= 0) ? tau : 0; v[tau] = *(const bf16x8*)(up - (size_t)back * (PLD * 2)); }
}
template <int W>
__device__ __forceinline__ void p3_window_finish(Frame& F, int g, int tp, int lane, const bf16x8 (&v)[W]) {
    const int m = 2 * tp + (lane >> 5), t = m & (SEQ - 1), c0 = g * 256 + 8 * (lane & 31);
    float sum[8], self[8];
#pragma unroll
    for (int j = 0; j < 8; ++j) { self[j] = bf2f((bf16)v[0][j]); sum[j] = self[j]; }
#pragma unroll
    for (int tau = 1; tau < W; ++tau) { const float wgt = (t - tau >= 0) ? 1.f : 0.f;
#pragma unroll
        for (int j = 0; j < 8; ++j) sum[j] = fmaf(wgt, bf2f((bf16)v[tau][j]), sum[j]); }
    const float inv = 1.f / (float)((t + 1) < W ? (t + 1) : W);
    u32x4 o; o.x = cvt_pk_bf16(sum[0] * inv - self[0], sum[1] * inv - self[1]); o.y = cvt_pk_bf16(sum[2] * inv - self[2], sum[3] * inv - self[3]);
    o.z = cvt_pk_bf16(sum[4] * inv - self[4], sum[5] * inv - self[5]); o.w = cvt_pk_bf16(sum[6] * inv - self[6], sum[7] * inv - self[7]);
    *(u32x4*)(F.CAT + (size_t)m * DM + c0) = o;
}
__device__ __forceinline__ void p3_window(Frame& F) {
    const int gw = F.bid * NWAVES + F.wave, NGW = F.G * NWAVES, lane = F.lane;
    for (int tp = gw; tp < NTOK / 2; tp += NGW) {
        bf16x8 v2[2], v4[4], v8[8], v16[16];
        p3_window_load<2>(F, 0, tp, lane, v2); p3_window_load<4>(F, 1, tp, lane, v4); p3_window_load<8>(F, 2, tp, lane, v8); p3_window_load<16>(F, 3, tp, lane, v16);
        p3_window_finish<2>(F, 0, tp, lane, v2); p3_window_finish<4>(F, 1, tp, lane, v4); p3_window_finish<8>(F, 2, tp, lane, v8); p3_window_finish<16>(F, 3, tp, lane, v16);
    }
}
__device__ __forceinline__ int half_sum32(int v) {
    v += __builtin_amdgcn_update_dpp(0, v, 0x128, 0xf, 0xf, false);
    v += __builtin_amdgcn_update_dpp(0, v, 0x124, 0xf, 0xf, false);
    v += __builtin_amdgcn_update_dpp(0, v, 0x122, 0xf, 0xf, false);
    v += __builtin_amdgcn_update_dpp(0, v, 0x121, 0xf, 0xf, false);
    v += __shfl_xor(v, 16);
    return v;
}
__device__ __forceinline__ float relu_asm(float x) { const int i = __builtin_bit_cast(int, x); return __builtin_bit_cast(float, i > 0 ? i : 0); }
constexpr int IDX_CH = 512;
__device__ __forceinline__ void p3_indexer_item(Frame& F, int conv_it, const bf16* Pb, unsigned* Mb, int tb, LAS unsigned char* kl, int tid, int wave, int lane) {
    asm volatile("" : "+v"(lane), "+v"(tid));
    const int r = lane & 31, hi = lane >> 5, t0 = tb + 2 * wave, ktd = t0 >> 5, tq = t0 + hi;
    const int nch = ((tb + 15) / IDX_CH) + 1;
    const GAS char* Pc = (const GAS char*)Pb;
    const unsigned srow = (unsigned)(tid >> 3), sch = (unsigned)(tid & 7);
    const unsigned sgo = (srow * PLD + C_KI + sch * 8) * 2u;
    const unsigned slo = srow * 128u + ((sch ^ ((srow >> 1) & 7u)) * 16u);
    bf16x8 stg[8];
#define IDX_LOAD(c) do { _Pragma("unroll") for (int i = 0; i < 8; ++i) { const GAS char* bp_ = Pc + (size_t)((c) * IDX_CH + 64 * i) * (PLD * 2); asm volatile("" : "+s"(bp_)); \
        stg[i] = *(const GAS bf16x8*)(bp_ + sgo); } } while (0)
    IDX_LOAD(0);
    bf16x8 aq[4];
    { const unsigned qoff = (unsigned)((t0 + (r >> 4)) * PLD + C_QI + (r & 15) * 64 + 8 * hi) * 2u;
#pragma unroll
      for (int j = 0; j < 4; ++j) aq[j] = *(const GAS bf16x8*)(Pc + qoff + 32 * j); }
    bf16x8 a0, a1;
    { const GAS char* w0p = Pc + (size_t)t0 * (PLD * 2) + (C_WI + 4 * hi) * 2; const GAS char* w1p = w0p + PLD * 2;
      const u32x2 x0 = *(const GAS u32x2*)w0p, x1 = *(const GAS u32x2*)(w0p + 16), y0 = *(const GAS u32x2*)w1p, y1 = *(const GAS u32x2*)(w1p + 16);
      u32x4 wa = {x0.x, x0.y, x1.x, x1.y}, wb = {y0.x, y0.y, y1.x, y1.y};
      if (r != 0) wa = (u32x4){0u, 0u, 0u, 0u};
      if (r != 4) wb = (u32x4){0u, 0u, 0u, 0u};
      a0 = *reinterpret_cast<bf16x8*>(&wa); a1 = *reinterpret_cast<bf16x8*>(&wb); }
    float key[64];
    float vmax = -__builtin_inff(), vmin = __builtin_inff(), s1 = 0.f, s2 = 0.f;
    unsigned kro[4];
#pragma unroll
    for (int j = 0; j < 4; ++j) kro[j] = (unsigned)r * 128u + ((((unsigned)(2 * j + hi)) ^ (((unsigned)r >> 1) & 7u)) * 16u);
    for (int crep = 0; crep < ((PROBE_DUP == 32) ? 2 : 1); ++crep) {
    if (crep) { IDX_LOAD(0); }
#pragma unroll
    for (int c = 0; c < SEQ / IDX_CH; ++c) {
        if (c < nch) {
            __syncthreads();
#pragma unroll
            for (int i = 0; i < 8; ++i) *(LAS bf16x8*)(kl + slo + i * 8192) = stg[i];
            __syncthreads();
            if (c + 1 < nch) IDX_LOAD(c + 1);
#pragma unroll
            for (int g = 0; g < IDX_CH / 128; ++g) {
                const int kt0 = c * (IDX_CH / 32) + 4 * g;
                if (kt0 <= ktd) {
#define IDX_PACK(d, b0, b1) do { \
                        b0.x = cvt_pk_bf16(relu_asm(d[0]), relu_asm(d[1])); b0.y = cvt_pk_bf16(relu_asm(d[2]), relu_asm(d[3])); \
                        b0.z = cvt_pk_bf16(relu_asm(d[4]), relu_asm(d[5])); b0.w = cvt_pk_bf16(relu_asm(d[6]), relu_asm(d[7])); \
                        b1.x = cvt_pk_bf16(relu_asm(d[8]), relu_asm(d[9])); b1.y = cvt_pk_bf16(relu_asm(d[10]), relu_asm(d[11])); \
                        b1.z = cvt_pk_bf16(relu_asm(d[12]), relu_asm(d[13])); b1.w = cvt_pk_bf16(relu_asm(d[14]), relu_asm(d[15])); } while (0)
#define IDX_TAKE(kt, e) do { const bool ok = ((kt) * 32 + r <= tq); const float sv = ok ? e[0] : -__builtin_inff(); \
                        key[kt] = sv; vmax = fmaxf(vmax, sv); vmin = fminf(vmin, ok ? e[0] : __builtin_inff()); \
                        { const float z0 = ok ? e[0] : 0.f; s1 += z0; s2 = fmaf(z0, z0, s2); } } while (0)
#define IDX_FRAGS(fr, tl) do { _Pragma("unroll") for (int j = 0; j < 4; ++j) { fr[j] = *(const LAS bf16x8*)((tl) + kro[j]); fr[4 + j] = *(const LAS bf16x8*)((tl) + 4096 + kro[j]); } } while (0)
#define IDX_SCORE(fr, dA, dB) do { _Pragma("unroll") for (int j = 0; j < 4; ++j) dA = __builtin_amdgcn_mfma_f32_32x32x16_bf16(aq[j], fr[j], dA, 0, 0, 0); \
                        _Pragma("unroll") for (int j = 0; j < 4; ++j) dB = __builtin_amdgcn_mfma_f32_32x32x16_bf16(aq[j], fr[4 + j], dB, 0, 0, 0); } while (0)
#define IDX_REDUCE(dA, dB, eA, eB) do { u32x4 b0, b1, c0, c1; \
                        IDX_PACK(dA, b0, b1); asm volatile("s_nop 1" ::: "memory"); \
                        eA = __builtin_amdgcn_mfma_f32_32x32x16_bf16(a0, *reinterpret_cast<bf16x8*>(&b0), eA, 0, 0, 0); \
                        eA = __builtin_amdgcn_mfma_f32_32x32x16_bf16(a1, *reinterpret_cast<bf16x8*>(&b1), eA, 0, 0, 0); \
                        IDX_PACK(dB, c0, c1); asm volatile("s_nop 1" ::: "memory"); \
                        eB = __builtin_amdgcn_mfma_f32_32x32x16_bf16(a0, *reinterpret_cast<bf16x8*>(&c0), eB, 0, 0, 0); \
                        eB = __builtin_amdgcn_mfma_f32_32x32x16_bf16(a1, *reinterpret_cast<bf16x8*>(&c1), eB, 0, 0, 0); } while (0)
                    {
                        const LAS unsigned char* tl = kl + (4 * g) * 4096;
                        bf16x8 fr[8];
                        IDX_FRAGS(fr, tl);
                        __builtin_amdgcn_sched_barrier(0);
                        f32x16 dA = {}, dB = {}, eA = {}, eB = {};
                        IDX_SCORE(fr, dA, dB);
                        __builtin_amdgcn_sched_barrier(0);
                        IDX_FRAGS(fr, tl + 8192);
                        IDX_REDUCE(dA, dB, eA, eB);
                        __builtin_amdgcn_sched_barrier(0);
                        IDX_TAKE(kt0, eA); IDX_TAKE(kt0 + 1, eB);
                        __builtin_amdgcn_sched_barrier(0);
                        f32x16 dC = {}, dD = {}, eC = {}, eD = {};
                        IDX_SCORE(fr, dC, dD);
                        __builtin_amdgcn_sched_barrier(0);
                        IDX_REDUCE(dC, dD, eC, eD);
                        __builtin_amdgcn_sched_barrier(0);
                        IDX_TAKE(kt0 + 2, eC); IDX_TAKE(kt0 + 3, eD);
                    }
#undef IDX_FRAGS
#undef IDX_SCORE
#undef IDX_REDUCE
#undef IDX_PACK
#undef IDX_TAKE
                } else {
#pragma unroll
                    for (int q = 0; q < 4; ++q) key[kt0 + q] = -__builtin_inff();
                }
            }
        } else {
#pragma unroll
            for (int q = 0; q < IDX_CH / 32; ++q) key[c * (IDX_CH / 32) + q] = -__builtin_inff();
        }
    }
    }
#undef IDX_LOAD
    int ln = lane; asm volatile("" : "+v"(ln));
    f32x4 cv[16];
    { const int r = conv_it & 255; const float* gsrc = F.w_gate + (size_t)(conv_it >> 8) * DM * DEXP + (size_t)(128 * (r >> 4)) * DEXP + 32 * (r & 15) + (size_t)(16 * (ln >> 3)) * DEXP + (ln & 7) * 4;
#pragma unroll
      for (int i = 0; i < 16; ++i) cv[i] = *(const f32x4*)(gsrc + (size_t)i * DEXP); }
    float T = -3.0e38f;
    const bool need = (tq + 1) > TOPK;
    for (int srep = 0; srep < ((PROBE_DUP == 31) ? 2 : 1); ++srep)
    if (__any(need)) {
#pragma unroll
        for (int o = 1; o < 32; o <<= 1) { vmax = fmaxf(vmax, __shfl_xor(vmax, o)); vmin = fminf(vmin, __shfl_xor(vmin, o)); s1 += __shfl_xor(s1, o); s2 += __shfl_xor(s2, o); }
        const float nf = (float)(tq + 1), mu = s1 / nf, sd = sqrtf(fmaxf(s2 / nf - mu * mu, 1e-20f));
        float zq; { const float pu = (float)TOPK / nf;
            const float q = fminf(pu, 1.f - pu), t = sqrtf(-2.f * __logf(fmaxf(q, 1e-6f)));
            const float zz = t - (2.515517f + t * (0.802853f + t * 0.010328f)) / (1.f + t * (1.432788f + t * (0.189269f + t * 0.001308f)));
            zq = (pu < 0.5f) ? zz : -zz; }
        const float dens = nf * 0.3989423f * __expf(-0.5f * zq * zq) / sd;
        float lo = vmin, hi = vmax, prev = mu + zq * sd, flo = (float)(tq + 1) - 255.5f, fhi = 1.f - 255.5f; int pcnt = TOPK, side = 0; bool done = !need;
        for (int it = 0; it < 96; ++it) {
            const float mid = 0.5f * lo + 0.5f * hi;
            float cand = ((it & 3) == 3) ? mid : lo + (hi - lo) * flo / (flo - fhi);
            if (it == 0) cand = prev;
            if (it == 1) cand = prev + ((float)(pcnt - TOPK) + 0.5f) / dens;
            if (!(cand > lo && cand < hi)) cand = mid;
            if (!(cand > lo && cand < hi)) done = true;
            if (__all(done)) break;
            int cnt = 0;
#pragma unroll
            for (int g = 0; g < 8; ++g) {
                if (8 * g <= ktd) {
#define CNT4(k0, k1, k2, k3) asm volatile("v_cmp_ge_f32_e64 s[88:89], %1, %5\n\tv_cmp_ge_f32_e64 s[90:91], %2, %5\n\tv_cmp_ge_f32_e64 s[92:93], %3, %5\n\tv_cmp_ge_f32_e64 s[94:95], %4, %5\n\t" \
                        "v_addc_co_u32_e64 %0, s[88:89], 0, %0, s[88:89]\n\tv_addc_co_u32_e64 %0, s[90:91], 0, %0, s[90:91]\n\tv_addc_co_u32_e64 %0, s[92:93], 0, %0, s[92:93]\n\tv_addc_co_u32_e64 %0, s[94:95], 0, %0, s[94:95]" \
                        : "+v"(cnt) : "v"(k0), "v"(k1), "v"(k2), "v"(k3), "v"(cand) : "s88", "s89", "s90", "s91", "s92", "s93", "s94", "s95")
                    CNT4(key[8 * g + 0], key[8 * g + 1], key[8 * g + 2], key[8 * g + 3]);
                    CNT4(key[8 * g + 4], key[8 * g + 5], key[8 * g + 6], key[8 * g + 7]);
#undef CNT4
                }
            }
            cnt = half_sum32(cnt);
            if (!done) {
                if (cnt >= TOPK) { lo = cand; flo = (float)cnt - 255.5f; if (side == 1) fhi *= 0.5f; side = 1; }
                else { hi = cand; fhi = (float)cnt - 255.5f; if (side == 2) flo *= 0.5f; side = 2; }
                if (cnt == TOPK) done = true; }
            prev = cand; pcnt = cnt;
        }
        if (need) T = lo;
    }
    unsigned mw0 = 0u, mw1 = 0u;
#pragma unroll
    for (int kt = 0; kt < 64; ++kt) {
        if (kt <= ktd) { const unsigned long long bal = __ballot(key[kt] >= T);
            const unsigned blo = (unsigned)bal, bhi = (unsigned)(bal >> 32);
            asm volatile("s_nop 4\n\tv_writelane_b32 %0, %2, %4\n\tv_writelane_b32 %1, %3, %4" : "+v"(mw0), "+v"(mw1) : "s"(blo), "s"(bhi), "n"(kt)); }
    }
    Mb[(size_t)t0 * 64 + ln] = mw0; Mb[(size_t)(t0 + 1) * 64 + ln] = mw1;
    { P0Tile t; const int r = conv_it & 255; t.src = nullptr; t.ld_src = DEXP; t.k0 = 128 * (r >> 4); t.n0 = 32 * (r & 15); t.nvalid = DEXP; t.dst = (unsigned char*)F.Wgu + (size_t)(conv_it >> 8) * 1024 * DM; t.ld_dst = DM;
      t.himul = 256; t.radd = 0; t.fp8 = 1; t.scale = WGU_SCALE;
      u32x4 co[8]; p0_tile_pack(t, cv, co); p0_tile_store(t, co, ln); }
}
__device__ __forceinline__ void p3_indexer(Frame& F) {
    for (int wgi = F.vcu; wgi < 256; wgi += F.G) {
        const int b = wgi >> 5, j = wgi & 31;
#pragma unroll 1
        for (int s = 0; s < 4; ++s) { const int q16 = (s == 0) ? j : (s == 1) ? 63 - j : (s == 2) ? 64 + j : 127 - j;
            p3_indexer_item(F, (wgi * 4 + s) * NWAVES + F.wave, F.P + (size_t)b * SEQ * PLD, F.MASK + (size_t)b * SEQ * 64, q16 * 16, F.lds, F.tid, F.wave, F.lane); }
    }
}

namespace att {
constexpr int D = 128, QBLK = 32, KVBLK = 64, QB = 256;
constexpr int SHM_V = KVBLK * D * 2, SHM_K = KVBLK * D * 2;
constexpr int ATT_LDS = 2 * SHM_V + 2 * SHM_K + NWAVES * 64 * 4;
constexpr float SCALE = 0.08838834764831845f, THR = 8.f;
constexpr int RMAX = 207, NBIAS = 304;
#define KSWZ(row, colB) ((row) * 256 + ((colB) ^ (((row) & 7) << 4)))
#define SBAR() __builtin_amdgcn_sched_barrier(0)
__device__ __forceinline__ int v_st(int k, int c) { const int kk = (k & ~0xC) | ((k & 4) << 1) | ((k & 8) >> 1); return ((kk >> 3) * 4 + (c >> 5)) * 512 + ((kk & 7) * 32 + (c & 31)) * 2; }
__device__ __forceinline__ int v_rd_base(int lane) { return ((lane & 3) << 3) | (((lane >> 2) & 3) << 6) | (((lane >> 4) & 1) << 5) | (((lane >> 5) & 1) << 8); }
constexpr int v_rd_off(int d0, int ks, int half) { return d0 * 512 + ks * 4096 + half * 2048; }
__device__ __forceinline__ int crow(int r, int hi) { return (r & 3) + 8 * (r >> 2) + 4 * hi; }

__device__ __forceinline__ void mask_bias_tile(f32x16& p0, f32x16& p1, u32x2 mk, int hi, bool near, const LAS float* tb) {
    const float NEG = -__builtin_inff();
    const unsigned w0 = mk.x >> (4 * hi), w1 = mk.y >> (4 * hi);
    if (near) {
#pragma unroll
        for (int r = 0; r < 16; ++r) { const int c = (r & 3) + 8 * (r >> 2); p0[r] += tb[c]; p1[r] += tb[c + 32]; }
    }
    const int negb = __float_as_int(NEG);
#pragma unroll
    for (int r = 0; r < 16; ++r) { const int c = (r & 3) + 8 * (r >> 2);
        const int m0 = __builtin_amdgcn_sbfe((int)w0, c, 1), m1 = __builtin_amdgcn_sbfe((int)w1, c, 1);
        const float x0 = p0[r], x1 = p1[r];
        p0[r] = __int_as_float((__float_as_int(x0) & m0) | (negb & ~m0));
        p1[r] = __int_as_float((__float_as_int(x1) & m1) | (negb & ~m1)); }
}
__device__ __forceinline__ void partialSM(f32x16& p0, f32x16& p1, float& m_reg, float& mn, float& alpha) {
    float pmax = p0[0];
#pragma unroll
    for (int r = 1; r < 16; ++r) pmax = fmaxf(pmax, p0[r]);
#pragma unroll
    for (int r = 0; r < 16; ++r) pmax = fmaxf(pmax, p1[r]);
    { auto rr = __builtin_amdgcn_permlane32_swap(__float_as_uint(pmax), __float_as_uint(pmax), false, false);
      pmax = fmaxf(__uint_as_float(rr[0]), __uint_as_float(rr[1])); }
    constexpr float C2 = 1.4426950408889634f * SCALE;
    if (__builtin_expect(__all((pmax - m_reg) * SCALE <= THR), 1)) { mn = m_reg; alpha = 1.f; }
    else { mn = fmaxf(m_reg, pmax); alpha = __builtin_amdgcn_exp2f((m_reg - mn) * C2); m_reg = mn; }
    const float mnL = -mn * C2;
#pragma unroll
    for (int r = 0; r < 16; ++r) p0[r] = fmaf(p0[r], C2, mnL);
#pragma unroll
    for (int r = 0; r < 16; ++r) p1[r] = fmaf(p1[r], C2, mnL);
#pragma unroll
    for (int r = 0; r < 16; ++r) p0[r] = __builtin_amdgcn_exp2f(p0[r]);
}
__device__ __forceinline__ void finishSM(f32x16& p0, f32x16& p1, float alpha, float& l_reg, bf16x8& pa0, bf16x8& pa1, bf16x8& pa2, bf16x8& pa3) {
#pragma unroll
    for (int r = 0; r < 16; ++r) p1[r] = __builtin_amdgcn_exp2f(p1[r]);
    float ps = 0;
#pragma unroll
    for (int r = 0; r < 16; ++r) ps += p0[r];
#pragma unroll
    for (int r = 0; r < 16; ++r) ps += p1[r];
    { auto rr = __builtin_amdgcn_permlane32_swap(__float_as_uint(ps), __float_as_uint(ps), false, false);
      ps = __uint_as_float(rr[0]) + __uint_as_float(rr[1]); }
    l_reg = l_reg * alpha + ps;
#define PK4(P, B_, OUT) do { unsigned a0 = cvt_pk_bf16(P[B_+0], P[B_+1]), a1 = cvt_pk_bf16(P[B_+2], P[B_+3]);                          \
        unsigned b0 = cvt_pk_bf16(P[B_+4], P[B_+5]), b1 = cvt_pk_bf16(P[B_+6], P[B_+7]);                                             \
        auto r0 = __builtin_amdgcn_permlane32_swap(a0, b0, false, false); auto r1 = __builtin_amdgcn_permlane32_swap(a1, b1, false, false); \
        u32x4 w = {r0[0], r1[0], r0[1], r1[1]}; OUT = *reinterpret_cast<bf16x8*>(&w); } while (0)
    PK4(p0, 0, pa0); PK4(p0, 8, pa1); PK4(p1, 0, pa2); PK4(p1, 8, pa3);
#undef PK4
}
template <int KB>
__device__ __forceinline__ void qkt(f32x16& p0, f32x16& p1, const char* K_lds, const char* Qw, int r32, int hi) {
    p0 = f32x16{}; p1 = f32x16{};
    const char* kb[4]; const char* qb[4];
#pragma unroll
    for (int dd = 0; dd < 4; ++dd) { kb[dd] = K_lds + KB * SHM_K + KSWZ(r32, (dd * 16 + hi * 8) * 2); qb[dd] = Qw + KSWZ(r32, (dd * 16 + hi * 8) * 2); }
#pragma unroll
    for (int d0 = 0; d0 < 8; ++d0) { const char* a = kb[d0 & 3] + (d0 >> 2) * 128;
        bf16x8 b0 = *reinterpret_cast<const bf16x8*>(a);
        bf16x8 b1 = *reinterpret_cast<const bf16x8*>(a + 32 * 256);
        bf16x8 q = *reinterpret_cast<const bf16x8*>(qb[d0 & 3] + (d0 >> 2) * 128);
        p0 = __builtin_amdgcn_mfma_f32_32x32x16_bf16(b0, q, p0, 0, 0, 0);
        p1 = __builtin_amdgcn_mfma_f32_32x32x16_bf16(b1, q, p1, 0, 0, 0); }
    __builtin_amdgcn_sched_group_barrier(0x100, 3, 0);
#pragma unroll
    for (int d0 = 0; d0 < 7; ++d0) { __builtin_amdgcn_sched_group_barrier(0x100, 3, 0); __builtin_amdgcn_sched_group_barrier(0x008, 2, 0); }
    __builtin_amdgcn_sched_group_barrier(0x008, 2, 0);
}
template <int VB>
__device__ __forceinline__ void pv_tile(f32x16* o, int vb0, bf16x8 pa0, bf16x8 pa1, bf16x8 pa2, bf16x8 pa3) {
#define TRRD(dst, off) asm volatile("ds_read_b64_tr_b16 %0, %1 offset:%2" : "=&v"(dst) : "v"(vb0), "i"(off) : "memory")
#define PV_D0(d0) do { s16x4 l0, l1, l2, l3, h0, h1, h2, h3; constexpr int b_ = VB * SHM_V + v_rd_off(d0, 0, 0); \
        TRRD(l0, b_); TRRD(h0, b_ + 2048); TRRD(l1, b_ + 4096); TRRD(h1, b_ + 6144); TRRD(l2, b_ + 8192); TRRD(h2, b_ + 10240); TRRD(l3, b_ + 12288); TRRD(h3, b_ + 14336); \
        asm volatile("s_waitcnt lgkmcnt(0)" ::: "memory"); SBAR();   \
        o[d0] = __builtin_amdgcn_mfma_f32_32x32x16_bf16(pa0, (bf16x8){l0[0], l0[1], l0[2], l0[3], h0[0], h0[1], h0[2], h0[3]}, o[d0], 0, 0, 0);   \
        o[d0] = __builtin_amdgcn_mfma_f32_32x32x16_bf16(pa1, (bf16x8){l1[0], l1[1], l1[2], l1[3], h1[0], h1[1], h1[2], h1[3]}, o[d0], 0, 0, 0);   \
        o[d0] = __builtin_amdgcn_mfma_f32_32x32x16_bf16(pa2, (bf16x8){l2[0], l2[1], l2[2], l2[3], h2[0], h2[1], h2[2], h2[3]}, o[d0], 0, 0, 0);   \
        o[d0] = __builtin_amdgcn_mfma_f32_32x32x16_bf16(pa3, (bf16x8){l3[0], l3[1], l3[2], l3[3], h3[0], h3[1], h3[2], h3[3]}, o[d0], 0, 0, 0); } while (0)
    PV_D0(0); PV_D0(1); PV_D0(2); PV_D0(3);
#undef PV_D0
#undef TRRD
}
struct BlockRef { const bf16* Q; const bf16* K; bf16* O; const unsigned* M; int P0; };
struct Seam { bf16x8 st_v0, st_v1, st_k0, st_k1; u32x2 mkA; };
constexpr int Q_OFF = 2 * SHM_V + 2 * SHM_K + NWAVES * 64 * 4;
constexpr int ATT_LDS_ALL = Q_OFF + NWAVES * 8192;
#define VMW() asm volatile("s_waitcnt vmcnt(0)" ::: "memory")
#define KVROW (PLD * 2)
#define SLOAD_H(Kp, k0) do { const char* kt_ = (const char*)(Kp) + (size_t)(k0) * KVROW; \
        S.st_k0 = *(const bf16x8*)(kt_ + kvo); S.st_k1 = *(const bf16x8*)(kt_ + 32 * KVROW + kvo); \
        S.st_v0 = *(const bf16x8*)(kt_ + (C_V - C_K) * 2 + kvo); S.st_v1 = *(const bf16x8*)(kt_ + 32 * KVROW + (C_V - C_K) * 2 + kvo); } while (0)
#define SWRITE_HK(bf) do { *(bf16x8*)(K_lds + (bf) * SHM_K + kws) = S.st_k0; *(bf16x8*)(K_lds + (bf) * SHM_K + kws + 32 * 256) = S.st_k1; } while (0)
#define SWRITE_HV(bf) do { *(bf16x8*)(V_lds + (bf) * SHM_V + vst0) = S.st_v0; *(bf16x8*)(V_lds + (bf) * SHM_V + vst1) = S.st_v1; } while (0)
#define SWRITE_H(bf) do { SWRITE_HV(bf); SWRITE_HK(bf); } while (0)
#define MLOAD(ref, tile) (*(const u32x2*)((const char*)((ref).M + (size_t)wid * QBLK * 64 + 2 * (tile)) + mro))
__device__ __forceinline__ void attn_prime(const BlockRef& cur, char* lds, Seam& S, const int wid, const int lane) {
    const int tid = wid * 64 + lane, r32 = lane & 31;
    const int sr = tid >> 4, sc = (tid & 15) * 8, kws = KSWZ(sr, sc * 2); char* K_lds = lds + 2 * SHM_V;
    const unsigned kvo = (unsigned)(sr * PLD + sc) * 2u, mro = (unsigned)r32 * 256u;
    SLOAD_H(cur.K, 0); S.mkA = MLOAD(cur, 0); VMW(); SWRITE_HK(0);
    __syncthreads();
}
__device__ __forceinline__ void attn_block(const BlockRef& cur, const BlockRef& nxt, char* lds, const LAS float* btab, Seam& S, const int wid, const int lane) {
    const int tid = wid * 64 + lane, r32 = lane & 31, hi = lane >> 5;
    const int NT = (cur.P0 + QB - 1) / KVBLK + 1;
    const int qlo = cur.P0 + wid * QBLK, pos = qlo + r32;
    char* V_lds = lds; char* K_lds = lds + 2 * SHM_V; char* Qw = lds + Q_OFF + wid * 8192;
    float* ws = (float*)(lds + 2 * SHM_V + 2 * SHM_K) + wid * 64; float* li_l = ws, * al_l = ws + 32;
    float m_reg = -1e30f, l_reg = 0; f32x16 o[4] = {};
    const int sr = tid >> 4, sc = (tid & 15) * 8, vst0 = v_st(sr, sc), vst1 = v_st(32 + sr, sc), kws = KSWZ(sr, sc * 2);
    const unsigned kvo = (unsigned)(sr * PLD + sc) * 2u, mro = (unsigned)r32 * 256u;
    const int vb0 = (int)(uintptr_t)V_lds + v_rd_base(lane);
    const bf16* Kh = cur.K;
    u32x2 mkA = S.mkA, mkB = (u32x2){0u, 0u};
    {
        const char* qg = (const char*)(cur.Q + (size_t)wid * QBLK * PLD) + (unsigned)(r32 * PLD + hi * 8) * 2u;
        bf16x8 qv[8];
#pragma unroll
        for (int d0 = 0; d0 < 8; ++d0) qv[d0] = *(const bf16x8*)(qg + d0 * 32);
#pragma unroll
        for (int d0 = 0; d0 < 8; ++d0) *(bf16x8*)(Qw + KSWZ(r32, (d0 * 16 + hi * 8) * 2)) = qv[d0];
        asm volatile("s_waitcnt lgkmcnt(0)" ::: "memory");
    }
#define RESC(a) do { if (__any((a) < 1.f)) { if (hi == 0) al_l[r32] = (a); asm volatile("s_waitcnt lgkmcnt(0)" ::: "memory");              \
                     for (int d_ = 0; d_ < 4; ++d_) for (int r = 0; r < 16; ++r) o[d_][r] *= al_l[crow(r, hi)]; } } while (0)
#define KBASE(t) ((t) * KVBLK)
#define MASKT(P0_, P1_, mk, t) do { const int kb_ = KBASE(t); const bool near_ = (kb_ <= qlo + QBLK - 1) && (kb_ > qlo - 176); \
        mask_bias_tile(P0_, P1_, mk, hi, near_, btab + (RMAX - (pos - kb_ - 4 * hi))); } while (0)
    f32x16 pA0, pA1, pB0, pB1; float mnA, mnB, alA, alB; bf16x8 pa0, pa1, pa2, pa3;
    SWRITE_HV(0); SBAR();
    if (NT > 1) { SLOAD_H(Kh, KBASE(1)); mkB = MLOAD(cur, 1); }
    SBAR(); qkt<0>(pA0, pA1, K_lds, Qw, r32, hi);
    MASKT(pA0, pA1, mkA, 0); partialSM(pA0, pA1, m_reg, mnA, alA);
    if (NT > 1) { VMW(); SWRITE_H(1); }
    __syncthreads();
#define HALF_STEP(PX0, PX1, mnX, alX, mkX, PY0, PY1, alY, mkY, t, KB, VB, SB) do {                                                      \
        SBAR(); qkt<KB>(PX0, PX1, K_lds, Qw, r32, hi);                                             \
        finishSM(PY0, PY1, alY, l_reg, pa0, pa1, pa2, pa3); SBAR();                                                           \
        if ((t) + 1 < NT) { SLOAD_H(Kh, KBASE((t) + 1)); mkY = MLOAD(cur, (t) + 1); SBAR(); }                                               \
        pv_tile<VB>(o, vb0, pa0, pa1, pa2, pa3); MASKT(PX0, PX1, mkX, (t)); partialSM(PX0, PX1, m_reg, mnX, alX);                                        \
        __syncthreads();                                                                                                      \
        if ((t) + 1 < NT) { VMW(); SWRITE_H(SB); }                                                                          \
        RESC(alX); __syncthreads(); } while (0)
    for (int t = 1; t + 1 < NT; t += 2) {
        HALF_STEP(pB0, pB1, mnB, alB, mkB, pA0, pA1, alA, mkA, t, 1, 0, 0);
        HALF_STEP(pA0, pA1, mnA, alA, mkA, pB0, pB1, alB, mkB, t + 1, 0, 1, 1);
    }
    const bool even = (NT & 1) == 0;
    if (even) { SBAR(); qkt<1>(pB0, pB1, K_lds, Qw, r32, hi); SBAR(); }
    SLOAD_H(nxt.K, 0); mkA = MLOAD(nxt, 0); SBAR();
    finishSM(pA0, pA1, alA, l_reg, pa0, pa1, pa2, pa3); SBAR();
    pv_tile<0>(o, vb0, pa0, pa1, pa2, pa3);
    if (even) { MASKT(pB0, pB1, mkB, NT - 1); partialSM(pB0, pB1, m_reg, mnB, alB); __syncthreads(); RESC(alB);
        finishSM(pB0, pB1, alB, l_reg, pa0, pa1, pa2, pa3); SBAR(); pv_tile<1>(o, vb0, pa0, pa1, pa2, pa3); }
    SBAR(); VMW(); SWRITE_HK(0); SBAR();
    S.mkA = mkA;
    if (hi == 0) li_l[r32] = l_reg; asm volatile("s_waitcnt lgkmcnt(0)" ::: "memory");
    float rli[16];
#pragma unroll
    for (int r = 0; r < 16; ++r) rli[r] = __builtin_amdgcn_rcpf(li_l[crow(r, hi)]);
    {
        bf16* ol = (bf16*)Qw;
#pragma unroll
        for (int r = 0; r < 16; ++r) { const int orow = crow(r, hi);
#pragma unroll
            for (int d0 = 0; d0 < 4; ++d0) ol[orow * D + d0 * 32 + r32] = (bf16)(cvt_pk_bf16(o[d0][r] * rli[r], 0.f) & 0xffffu); }
        asm volatile("s_waitcnt lgkmcnt(0)" ::: "memory");
        char* Ob = (char*)(cur.O + (size_t)(wid * QBLK) * DM);
        const unsigned ovo = (unsigned)((lane >> 4) * (DM * 2) + (lane & 15) * 16);
#pragma unroll
        for (int i = 0; i < 8; ++i) { const u32x4 w = *(const u32x4*)(Qw + i * 1024 + lane * 16);
            GAS char* Obi = (GAS char*)(Ob + (size_t)i * (4 * DM * 2)); asm volatile("" : "+s"(Obi));
            *(GAS u32x4*)(Obi + ovo) = w; }
        asm volatile("s_waitcnt lgkmcnt(0)" ::: "memory");
    }
    __syncthreads();
#undef RESC
#undef KBASE
#undef MASKT
#undef HALF_STEP
}
#undef VMW
#undef SLOAD_H
#undef SWRITE_HK
#undef SWRITE_HV
#undef SWRITE_H
#undef MLOAD
#undef KVROW
}

__device__ __forceinline__ int t5_bucket(int rel) {
    if (rel < 16) return rel;
    int v = 16 + (int)(logf((float)rel / 16.f) / logf(8.f) * 16.f);
    return v < 31 ? v : 31;
}
__device__ __forceinline__ att::BlockRef p4_ref(Frame& F, int it, int pass) {
    const int b = it >> 5, h = (it >> 2) & 7, p = it & 3, kvh = h >> 2, qb = pass ? 7 - p : p;
    const bf16* Pb = F.P + (size_t)b * SEQ * PLD;
    att::BlockRef r; r.P0 = qb * 256;
    r.Q = Pb + (size_t)r.P0 * PLD + C_Q + h * HD; r.K = Pb + C_K + kvh * HD;
    r.O = F.CAT + (size_t)(b * SEQ + r.P0) * DM + POOLW + h * HD; r.M = F.MASK + (size_t)(b * SEQ + r.P0) * 64;
    return r;
}
__device__ __forceinline__ void p4_attention(Frame& F, int nitems) {
    LAS float* btab = (LAS float*)(F.lds + MISC_BASE + MO_BIAS);
    char* lds = (char*)F.lds;
    int it = F.vcu, pass = 0;
    if (it >= nitems) return;
    att::Seam S;
    { const att::BlockRef c0 = p4_ref(F, it & 255, 0); att::attn_prime(c0, lds, S, F.wave, F.lane); }
    for (;;) {
        if (pass == 0) {
            const int h = (it >> 2) & 7;
            __syncthreads();
            for (int i = F.tid; i < att::NBIAS; i += NTHR) { const int rel = att::RMAX - i; float v = 0.f;
                if (rel >= 0) v = (F.rel_bias[t5_bucket(rel) * NHEAD + h] - F.rel_bias[31 * NHEAD + h]) * (1.f / att::SCALE);
                btab[i] = v; }
            __syncthreads();
        }
        const bool more_item = it + F.G < nitems, last = (pass == 1) && !more_item;
        const int itn = (pass == 0) ? it : (more_item ? it + F.G : it), passn = (pass == 0) ? 1 : (more_item ? 0 : 1);
        const att::BlockRef cur = p4_ref(F, it & 255, pass), nxt = p4_ref(F, itn & 255, passn);
        att::attn_block(cur, nxt, lds, btab, S, F.wave, F.lane);
        if (last) break;
        it = itn; pass = passn;
    }
}

constexpr int P6_ROWS = 32, P6_PITCH = 4112;
constexpr int P6_LOG = P6_ROWS * P6_PITCH;
static_assert(P6_LOG + P6_ROWS * 48 * 4 <= MISC_BASE, "P6 LDS");
__device__ __forceinline__ void p6_route(Frame& F, const LAS float* lg, int m) {
    float gmax = lg[0] + F.b_group[0]; int gsel = 0;
#pragma unroll
    for (int i = 1; i < NGRP; ++i) { const float v = lg[i] + F.b_group[i]; if (v > gmax) { gmax = v; gsel = i; } }
    float gz = 0.f;
#pragma unroll
    for (int i = 0; i < NGRP; ++i) gz += __expf(lg[i] + F.b_group[i] - gmax);
    const float pg = 1.f / gz;
    float e1v = -3.0e38f, e2v = -3.0e38f; int i1 = 0, i2 = 0;
#pragma unroll
    for (int i = 0; i < EPG; ++i) { const float v = lg[4 + gsel * EPG + i] + F.b_router[gsel * EPG + i];
        if (v > e1v) { e2v = e1v; i2 = i1; e1v = v; i1 = i; } else if (v > e2v) { e2v = v; i2 = i; } }
    const float w1 = 1.f / (1.f + __expf(e2v - e1v)), w2 = 1.f - w1;
    const int ex1 = gsel * EPG + i1, ex2 = gsel * EPG + i2;
    const unsigned p1 = atomicAdd(F.ctl + CW_ECNT + 16 * ex1, 1u), p2 = atomicAdd(F.ctl + CW_ECNT + 16 * ex2, 1u);
    F.TOKLIST[ex1 * NTOK + (int)p1] = m; F.TOKLIST[ex2 * NTOK + (int)p2] = m;
    unsigned* ti = F.TOKINFO + (size_t)m * 8;
    ti[0] = (unsigned)ex1; ti[1] = p1; ti[2] = (unsigned)ex2; ti[3] = p2; ti[4] = __float_as_uint(pg * w1); ti[5] = __float_as_uint(pg * w2);
}
__device__ __forceinline__ void p6_norm_router(Frame& F, bool route) {
    LAS unsigned char* tile = F.lds;
    LAS float* logit = (LAS float*)(F.lds + P6_LOG);
    const int lane = F.lane, wave = F.wave, fr = lane & 15, fq = lane >> 4;
    int prev_m0 = -1;
    for (int grp = F.bid; grp < NTOK / P6_ROWS; grp += F.G) {
        const int m0 = grp * P6_ROWS, b = m0 / SEQ;
        const float* modb = F.mod + (size_t)b * (6 * DM);
        u32x2 xb[4][8];
#pragma unroll
        for (int rr = 0; rr < 4; ++rr)
#pragma unroll
            for (int j = 0; j < 8; ++j) xb[rr][j] = *(const u32x2*)(F.X1 + (size_t)(m0 + 4 * wave + rr) * DM + 256 * j + 4 * lane);
        f32x4 gs[8], sh[8];
#pragma unroll
        for (int j = 0; j < 8; ++j) { const int col = 256 * j + 4 * lane; const f32x4 g = *(const f32x4*)(F.g_ffn + col), sc = *(const f32x4*)(modb + 4 * DM + col);
            gs[j] = g * (sc + 1.f); sh[j] = *(const f32x4*)(modb + 3 * DM + col); }
        if (route && prev_m0 >= 0 && lane < 4) p6_route(F, logit + (4 * wave + lane) * 48, prev_m0 + 4 * wave + lane);
#pragma unroll
        for (int rr = 0; rr < 4; ++rr) {
            const int lr = 4 * wave + rr, m = m0 + lr;
            f32x4 v[8]; float s = 0.f;
#pragma unroll
            for (int j = 0; j < 8; ++j) { const u32x2 q = xb[rr][j];
                v[j][0] = __uint_as_float(q.x << 16); v[j][1] = __uint_as_float(q.x & 0xffff0000u); v[j][2] = __uint_as_float(q.y << 16); v[j][3] = __uint_as_float(q.y & 0xffff0000u);
                s += (v[j][0] * v[j][0] + v[j][1] * v[j][1]) + (v[j][2] * v[j][2] + v[j][3] * v[j][3]); }
            const float rstd = 1.f / sqrtf(wave_sum(s) * (1.f / DM) + EPS);
            unsigned char* orow = (unsigned char*)F.H + (size_t)m * DM;
#pragma unroll
            for (int j = 0; j < 8; ++j) { const f32x4 y = v[j] * rstd * gs[j] + sh[j];
                u32x2 o; o.x = cvt_pk_bf16(y[0], y[1]); o.y = cvt_pk_bf16(y[2], y[3]);
                *(unsigned*)(orow + 256 * j + 4 * lane) = pk4_fp8(y[0], y[1], y[2], y[3]);
                *(LAS u32x2*)(tile + lr * P6_PITCH + (256 * j + 4 * lane) * 2) = o; }
        }
        __syncthreads();
        if (wave < 6) {
            const int rb = wave / 3, nb = wave - 3 * rb;
            f32x4 acc = (f32x4){0.f, 0.f, 0.f, 0.f};
            const LAS unsigned char* ap = tile + (rb * 16 + fr) * P6_PITCH + 16 * fq;
            const bf16* bp = F.RW + (size_t)(nb * 16 + fr) * DM + 8 * fq;
#pragma unroll 16
            for (int ks = 0; ks < 64; ++ks) acc = __builtin_amdgcn_mfma_f32_16x16x32_bf16(*(const LAS bf16x8*)(ap + 64 * ks), *(const bf16x8*)(bp + 32 * ks), acc, 0, 0, 0);
#pragma unroll
            for (int j = 0; j < 4; ++j) logit[(rb * 16 + 4 * fq + j) * 48 + nb * 16 + fr] = acc[j];
        }
        __syncthreads();
        prev_m0 = m0;
    }
    if (route && prev_m0 >= 0 && lane < 4) p6_route(F, logit + (4 * wave + lane) * 48, prev_m0 + 4 * wave + lane);
}
constexpr int S6_ROWS = 16, S6_LOG = S6_ROWS * P6_PITCH, S6_CTR = 69120, S6_SCR_HI = 69632;
static_assert(S6_LOG + S6_ROWS * 48 * 4 <= S6_CTR && S6_SCR_HI + 4 * 16640 <= MISC_BASE, "side-by-side LDS map");
__device__ __forceinline__ void bar4(volatile LAS unsigned* cnt, unsigned& target, int lane) {
    asm volatile("s_waitcnt lgkmcnt(0)" ::: "memory");
    target += 4u;
    if (lane == 0) (void)__hip_atomic_fetch_add((LAS unsigned*)cnt, 1u, __ATOMIC_RELAXED, __HIP_MEMORY_SCOPE_WORKGROUP);
    while (*cnt < target) __builtin_amdgcn_s_sleep(1);
    asm volatile("" ::: "memory");
}
__device__ __forceinline__ void s6_router(Frame& F, volatile LAS unsigned* bcnt) {
    LAS unsigned char* tile = F.lds;
    LAS float* logit = (LAS float*)(F.lds + S6_LOG);
    const int lane = F.lane, wave = F.wave, fr = lane & 15, fq = lane >> 4;
    unsigned btarget = 0u; int prev_m0 = -1;
    for (int grp = F.bid; grp < NTOK / S6_ROWS; grp += F.G) {
        const int m0 = grp * S6_ROWS, b = m0 / SEQ;
        const float* modb = F.mod + (size_t)b * (6 * DM);
        u32x2 xb[4][8];
#pragma unroll
        for (int rr = 0; rr < 4; ++rr)
#pragma unroll
            for (int j = 0; j < 8; ++j) xb[rr][j] = *(const u32x2*)(F.X1 + (size_t)(m0 + 4 * wave + rr) * DM + 256 * j + 4 * lane);
        f32x4 gs[8], sh[8];
#pragma unroll
        for (int j = 0; j < 8; ++j) { const int col = 256 * j + 4 * lane; const f32x4 g = *(const f32x4*)(F.g_ffn + col), sc = *(const f32x4*)(modb + 4 * DM + col);
            gs[j] = g * (sc + 1.f); sh[j] = *(const f32x4*)(modb + 3 * DM + col); }
        if (prev_m0 >= 0 && lane < 4) p6_route(F, logit + (4 * wave + lane) * 48, prev_m0 + 4 * wave + lane);
        bar4(bcnt, btarget, lane);
#pragma unroll
        for (int rr = 0; rr < 4; ++rr) {
            const int lr = 4 * wave + rr, m = m0 + lr;
            f32x4 v[8]; float s = 0.f;
#pragma unroll
            for (int j = 0; j < 8; ++j) { const u32x2 q = xb[rr][j];
                v[j][0] = __uint_as_float(q.x << 16); v[j][1] = __uint_as_float(q.x & 0xffff0000u); v[j][2] = __uint_as_float(q.y << 16); v[j][3] = __uint_as_float(q.y & 0xffff0000u);
                s += (v[j][0] * v[j][0] + v[j][1] * v[j][1]) + (v[j][2] * v[j][2] + v[j][3] * v[j][3]); }
            const float rstd = 1.f / sqrtf(wave_sum(s) * (1.f / DM) + EPS);
            unsigned char* orow = (unsigned char*)F.H + (size_t)m * DM;
#pragma unroll
            for (int j = 0; j < 8; ++j) { const f32x4 y = v[j] * rstd * gs[j] + sh[j];
                u32x2 o; o.x = cvt_pk_bf16(y[0], y[1]); o.y = cvt_pk_bf16(y[2], y[3]);
                *(unsigned*)(orow + 256 * j + 4 * lane) = pk4_fp8(y[0], y[1], y[2], y[3]);
                *(LAS u32x2*)(tile + lr * P6_PITCH + (256 * j + 4 * lane) * 2) = o; }
        }
        bar4(bcnt, btarget, lane);
        if (wave < 3) {
            const int nb = wave;
            f32x4 acc = (f32x4){0.f, 0.f, 0.f, 0.f};
            const LAS unsigned char* ap = tile + fr * P6_PITCH + 16 * fq;
            const bf16* bp = F.RW + (size_t)(nb * 16 + fr) * DM + 8 * fq;
#pragma unroll 16
            for (int ks = 0; ks < 64; ++ks) acc = __builtin_amdgcn_mfma_f32_16x16x32_bf16(*(const LAS bf16x8*)(ap + 64 * ks), *(const bf16x8*)(bp + 32 * ks), acc, 0, 0, 0);
#pragma unroll
            for (int j = 0; j < 4; ++j) logit[(4 * fq + j) * 48 + nb * 16 + fr] = acc[j];
        }
        bar4(bcnt, btarget, lane);
        prev_m0 = m0;
    }
    if (prev_m0 >= 0 && lane < 4) p6_route(F, logit + (4 * wave + lane) * 48, prev_m0 + 4 * wave + lane);
    bar4(bcnt, btarget, lane);
}
__device__ __forceinline__ int lds_pop(LAS unsigned* ctr, int lane) {
    int v = 0; if (lane == 0) v = (int)__hip_atomic_fetch_add(ctr, 1u, __ATOMIC_RELAXED, __HIP_MEMORY_SCOPE_WORKGROUP);
    return __builtin_amdgcn_readfirstlane(v);
}
__device__ __forceinline__ void s6_convert(Frame& F, LAS unsigned* ctr, int a0, int total) {
    f32x4 v[16]; u32x4 o[8]; P0Tile cur, nxt;
    int d = F.bid + F.G * lds_pop(ctr, F.lane);
    if (d >= total) return;
    cur = p0_decode(F, a0 + d); p0_tile_load(cur, v, F.lane);
    for (;;) {
        p0_tile_pack(cur, v, o);
        const int dn = F.bid + F.G * lds_pop(ctr, F.lane); const bool more = dn < total;
        if (more) { nxt = p0_decode(F, a0 + dn); p0_tile_load(nxt, v, F.lane); }
        p0_tile_store(cur, o, F.lane);
        if (!more) break;
        cur = nxt;
    }
}
__device__ __forceinline__ void p6_side_by_side(Frame& F) {
    LAS unsigned* ctrs = (LAS unsigned*)(F.lds + S6_CTR);
    __syncthreads();
    if (F.tid == 0) { ctrs[0] = 0u; ctrs[1] = 0u; }
    __syncthreads();
    constexpr int A0 = P0_EARLY_A + P0_R2;
    const int total = ((F.G == 256) ? P0_OFF_START : P0_EARLY_B0) - A0;
    if (F.wave < 4) { s6_router(F, (volatile LAS unsigned*)ctrs); s6_convert(F, ctrs + 1, A0, total); }
    else s6_convert(F, ctrs + 1, A0, total);
}

__device__ __forceinline__ pg8::MoeTabs moe_tabs(Frame& F) {
    pg8::MoeTabs T; T.tb = (const LAS int*)(F.lds + MISC_BASE + MO_TB); T.tf = T.tb + 40; T.hl = T.tb + 80; return T;
}
__device__ __forceinline__ void moe_tables(Frame& F) {
    LAS int* tb = (LAS int*)(F.lds + MISC_BASE + MO_TB); LAS int* tf = tb + 40; LAS int* hl = tb + 80; LAS int* cnt = (LAS int*)(F.lds + MISC_BASE + MO_CNT);
    __syncthreads();
    if (F.tid < NEXP) cnt[F.tid] = (int)__hip_atomic_load(F.ctl + CW_ECNT + 16 * F.tid, __ATOMIC_RELAXED, __HIP_MEMORY_SCOPE_AGENT);
    __syncthreads();
    if (F.tid == 0) { int s = 0, f = 0, nh = 0;
        for (int e = 0; e < NEXP; ++e) { const int c = cnt[e], t = (c + 255) >> 8, rem = c - ((t - 1) << 8), h = (t > 0 && rem <= 128) ? 1 : 0;
            tb[e] = s; tf[e] = f; s += t; f += t - h; if (h) hl[nh++] = e; }
        tb[NEXP] = s; tf[NEXP] = f; hl[NEXP] = nh; }
    __syncthreads();
}
__device__ __forceinline__ void p7_rowtab(Frame& F, int reps) {
    const pg8::MoeTabs T = moe_tabs(F); const LAS int* cnt = (const LAS int*)(F.lds + MISC_BASE + MO_CNT);
    LAS unsigned* rowtab = (LAS unsigned*)(F.lds + MISC_BASE + MO_ROWTAB);
    unsigned off[MAXU * 256 / NTHR];
#pragma unroll
    for (int q = 0; q < MAXU * 256 / NTHR; ++q) { const int idx = F.tid + q * NTHR, ord = idx >> 8, r = idx & 255; int pm, pn, e, half; off[q] = 0u;
        if (pg8::moe_unit(T, 4, ord * F.G + F.vcu, reps, pm, pn, e, half)) {
            const int slot = (pm - T.tb[e]) * 256 + r; if (slot < cnt[e]) off[q] = (unsigned)F.TOKLIST[e * NTOK + slot] * (unsigned)DM; } }
#pragma unroll
    for (int q = 0; q < MAXU * 256 / NTHR; ++q) rowtab[F.tid + q * NTHR] = off[q];
    __syncthreads();
}
struct P9Row { u32x2 x[8]; int ya[8], yc[8]; };
__device__ __forceinline__ void p9_load(Frame& F, const LAS int* tb, int m, int e1, int p1, int e2, int p2, P9Row& R, int lane) {
    const bf16* x1r = F.X1 + (size_t)m * DM;
    const unsigned char* y1 = (const unsigned char*)F.Y + ((size_t)tb[e1] * 256 + p1) * DM; const unsigned char* y2 = (const unsigned char*)F.Y + ((size_t)tb[e2] * 256 + p2) * DM;
#pragma unroll
    for (int j = 0; j < 8; ++j) { const int col = 256 * j + 4 * lane; R.x[j] = *(const u32x2*)(x1r + col); R.ya[j] = *(const int*)(y1 + col); R.yc[j] = *(const int*)(y2 + col); }
}
__device__ __forceinline__ void p9_final(Frame& F) {
    const LAS int* tb = (const LAS int*)(F.lds + MISC_BASE + MO_TB);
    const int gw = F.bid * NWAVES + F.wave, NGW = F.G * NWAVES, lane = F.lane;
    for (int grp = gw; grp < NTOK / 8; grp += NGW) {
        const int m0 = grp * 8, b = m0 / SEQ;
        const unsigned tiw = (lane < 48) ? F.TOKINFO[(size_t)(m0 + lane / 6) * 8 + (lane % 6)] : 0u;
        f32x4 gt[8], gf[8];
#pragma unroll
        for (int j = 0; j < 8; ++j) { const int col = 256 * j + 4 * lane; gt[j] = *(const f32x4*)(F.mod + (size_t)b * (6 * DM) + 5 * DM + col); gf[j] = *(const f32x4*)(F.g_final + col); }
        P9Row R[2];
#define P9_TI(r, w) __builtin_amdgcn_readlane((int)tiw, 6 * (r) + (w))
        p9_load(F, tb, m0, P9_TI(0, 0), P9_TI(0, 1), P9_TI(0, 2), P9_TI(0, 3), R[0], lane);
#pragma unroll
        for (int r = 0; r < 8; ++r) {
            if (r + 1 < 8) p9_load(F, tb, m0 + r + 1, P9_TI(r + 1, 0), P9_TI(r + 1, 1), P9_TI(r + 1, 2), P9_TI(r + 1, 3), R[(r + 1) & 1], lane);
            const P9Row& C = R[r & 1];
            const float g1s = __uint_as_float((unsigned)P9_TI(r, 4)) * (1.f / Y_SCALE), g2s = __uint_as_float((unsigned)P9_TI(r, 5)) * (1.f / Y_SCALE);
            f32x4 v[8]; float s = 0.f;
#pragma unroll
            for (int j = 0; j < 8; ++j) { const u32x2 xb = C.x[j]; const int a = C.ya[j], c = C.yc[j];
                f32x4 xv; xv[0] = __uint_as_float(xb.x << 16); xv[1] = __uint_as_float(xb.x & 0xffff0000u); xv[2] = __uint_as_float(xb.y << 16); xv[3] = __uint_as_float(xb.y & 0xffff0000u);
                f32x4 ya, yc;
                { const f32x2 lo = __builtin_amdgcn_cvt_pk_f32_fp8(a, false), hi = __builtin_amdgcn_cvt_pk_f32_fp8(a, true); ya[0] = lo[0]; ya[1] = lo[1]; ya[2] = hi[0]; ya[3] = hi[1]; }
                { const f32x2 lo = __builtin_amdgcn_cvt_pk_f32_fp8(c, false), hi = __builtin_amdgcn_cvt_pk_f32_fp8(c, true); yc[0] = lo[0]; yc[1] = lo[1]; yc[2] = hi[0]; yc[3] = hi[1]; }
                v[j] = xv + gt[j] * (ya * g1s + yc * g2s);
                s += (v[j][0] * v[j][0] + v[j][1] * v[j][1]) + (v[j][2] * v[j][2] + v[j][3] * v[j][3]); }
            const float rstd = 1.f / sqrtf(wave_sum(s) * (1.f / DM) + EPS);
            float* xr = F.out + (size_t)(m0 + r) * DM;
#pragma unroll
            for (int j = 0; j < 8; ++j) *(f32x4*)(xr + 256 * j + 4 * lane) = v[j] * rstd * gf[j];
        }
#undef P9_TI
    }
}

struct Args { const float* in[19]; float* out; unsigned char* ws; int ph_lo, ph_hi; };
constexpr int N_PHASES = 10;
__global__ void __launch_bounds__(NTHR, 2) fwd(Args args) {
    extern __shared__ __attribute__((aligned(16))) unsigned char lds_raw[];
    Frame F;
    F.lds = (LAS unsigned char*)lds_raw;
    F.wave = __builtin_amdgcn_readfirstlane((int)threadIdx.x >> 6); F.lane = lane_now(); F.tid = F.wave * 64 + F.lane; F.G = gridDim.x; F.bid = blockIdx.x; F.vcu = (F.G % 8 == 0) ? (F.bid % 8) * (F.G / 8) + F.bid / 8 : F.bid;
    unsigned char* ws = args.ws;
    F.ctl = (unsigned*)(ws + WS_CTL);
    F.x = args.in[0]; F.c = args.in[1]; F.w_ada = args.in[2]; F.b_ada = args.in[3]; F.g_mix = args.in[4]; F.w_in = args.in[5]; F.w_pool = args.in[6]; F.pool_scale = args.in[7];
    F.rel_bias = args.in[8]; F.w_out = args.in[9]; F.g_ffn = args.in[10]; F.w_group = args.in[11]; F.b_group = args.in[12]; F.w_router = args.in[13]; F.b_router = args.in[14];
    F.w_gate = args.in[15]; F.w_up = args.in[16]; F.w_down = args.in[17]; F.g_final = args.in[18];
    F.out = args.out; F.mod = (float*)(ws + WS_MOD);
    F.RW = (bf16*)(ws + WS_RW); F.WpT = (bf16*)(ws + WS_WPT); F.WinP = (bf16*)(ws + WS_WINP); F.Win = (bf16*)(ws + WS_WIN); F.Wout = (bf16*)(ws + WS_WOUT);
    F.Wgu = (bf16*)(ws + WS_WGU); F.Wd = (bf16*)(ws + WS_WD); F.H = (bf16*)(ws + WS_H); F.P = (bf16*)(ws + WS_P); F.CAT = (bf16*)(ws + WS_CAT); F.Y = (bf16*)(ws + WS_Y); F.A = (bf16*)(ws + WS_A); F.X1 = (bf16*)(ws + WS_X1);
    F.MASK = (unsigned*)(ws + WS_MASK); F.TOKLIST = (int*)(ws + WS_TOKLIST); F.TOKINFO = (unsigned*)(ws + WS_TOKINFO);
    volatile LAS unsigned* barw = (volatile LAS unsigned*)(F.lds + MISC_BASE + MO_BARW);
    if (F.tid < 4) barw[F.tid] = 0u;
    __syncthreads();
    XcdBarrier bar; bar.bar = F.ctl + CW_BAR; bar.x = 0; bar.st = nullptr; bar.wave = F.wave;
    if (MK_N_LAUNCHES == 1) bar = xcd_barrier_post(F.ctl + CW_BAR, barw, F.wave);
    const int lo = args.ph_lo, hi = args.ph_hi;
#ifndef PH_MASK
#define PH_MASK 0x3ff
#endif
#define IN(k) (((PH_MASK >> (k)) & 1) && lo <= (k) && (k) < hi && (F.lane = lane_now(), F.tid = F.wave * 64 + F.lane, true))
#define SEAM(k) do { if (MK_N_LAUNCHES == 1 && IN(k) && IN((k) + 1)) xcd_barrier(bar); } while (0)
    LAS unsigned char* ring = F.lds;

#define REP(k) for (int rep_ = 0; rep_ < ((PROBE_DUP == (k) && ((k) == 0 || (k) == 6 || (k) == 9 || (k) == 11)) ? 2 : 1); ++rep_)
#define NREP(k) ((PROBE_DUP == (k)) ? 2 : 1)
    if (IN(0)) { REP(0) { p0_prologue(F, CW_Q0 + 64 * rep_); } SEAM(0); }
    if (IN(1)) {
        REP(1) {
        { pg8::Gemm g{F.WpT, F.WinP, 256, 256, 1024, nullptr}; pg8::FoldOrder S{F.G, F.bid}; pg8::EpiBf16 E{F.Win, DM, F.pool_scale, 1.f};
          pg8::gemm_phase<pg8::EpiBf16, pg8::FoldOrder, false, true>(ring, g, S, E, F.wave); }
        REP(11) { p1_norm_rows(F, F.x, F.g_mix, 0, DM, F.H); }
        }
        SEAM(1);
    }
    if (IN(2)) {
        REP(2) {
        pg8::Gemm g{F.H, F.Win, DM, DM, DM, nullptr}; pg8::StaticOrder S; S.init(NTOK, PLD, F.G, F.bid); S.reps = NREP(2); pg8::EpiBf16 E{F.P, PLD, nullptr, 1.f};
        pg8::gemm_phase<pg8::EpiBf16, pg8::StaticOrder, false, true>(ring, g, S, E, F.wave);
        }
        p0_deferred(F);
        SEAM(2);
    }
    if (IN(3)) { if (PROBE_DUP == 3) { p3_window(F); p3_indexer(F); } if (PROBE_DUP == 33) p3_window(F); p3_window(F); p3_indexer(F); SEAM(3); }
    if (IN(4)) { p4_attention(F, PROBE_DUP == 4 ? 512 : 256); SEAM(4); }
    if (IN(5)) {
        REP(5) {
        pg8::Gemm g{F.CAT, F.Wout, DM, DM, DM, nullptr}; pg8::StaticOrder S; S.init(NTOK, DM, F.G, F.bid); S.reps = NREP(5); pg8::EpiResid E{F.x, F.X1, F.mod + 2 * DM};
        pg8::gemm_phase<pg8::EpiResid, pg8::StaticOrder, false, true>(ring, g, S, E, F.wave);
        }
        SEAM(5);
    }
    if (IN(6)) { if (PROBE_DUP == 6) { REP(6) { p6_norm_router(F, rep_ == 0); } p0_late(F); } else p6_side_by_side(F); SEAM(6); }
    if (IN(7)) {
        moe_tables(F); p7_rowtab(F, NREP(7));
        REP(7) {
        pg8::Gemm g{F.H, F.Wgu, DM / 2, DM / 2, DM / 2, (const LAS unsigned*)(F.lds + MISC_BASE + MO_ROWTAB)};
        pg8::GroupedOrder S{moe_tabs(F), 4, F.G, F.vcu, 1024, NREP(7)}; pg8::EpiGateUp E{(unsigned char*)F.A, 1.f / WGU_SCALE};
        pg8::gemm_phase<pg8::EpiGateUp, pg8::GroupedOrder, true, true, true>(ring, g, S, E, F.wave);
        }
        SEAM(7);
    }
    if (IN(8)) {
        if (MK_N_LAUNCHES != 1) moe_tables(F);
        REP(8) {
        pg8::Gemm g{F.A, F.Wd, DEXP / 2, DEXP / 2, DEXP / 2, nullptr};
        pg8::GroupedOrder S{moe_tabs(F), 8, F.G, F.vcu, DM, NREP(8)}; pg8::EpiFp8 E{(unsigned char*)F.Y, DM, Y_SCALE / WD_SCALE};
        pg8::gemm_phase<pg8::EpiFp8, pg8::GroupedOrder, false, P8_ALIGN, true>(ring, g, S, E, F.wave);
        }
        SEAM(8);
    }
    if (IN(9)) { if (MK_N_LAUNCHES != 1) moe_tables(F); REP(9) { p9_final(F); } }
#undef REP
#undef NREP
#undef IN
#undef SEAM
}

extern "C" void kernel_launch(void* const* d_in, const int* in_sizes, int n_in, void* d_out, int out_size, void* d_ws, size_t ws_size, hipStream_t stream) {
    static int grid = 0;
    if (grid == 0) {
        if (n_in != 19 || in_sizes[0] != NTOK * DM || out_size != NTOK * DM || ws_size < WS_END) {
            fprintf(stderr, "kernel_launch: unexpected shapes (n_in %d, in0 %d, out %d, ws %zu); nothing launched\n", n_in, n_in > 0 ? in_sizes[0] : -1, out_size, ws_size); grid = -1; return; }
        int dev = 0, cus = 0;
        if (hipGetDevice(&dev) != hipSuccess || hipDeviceGetAttribute(&cus, hipDeviceAttributeMultiprocessorCount, dev) != hipSuccess || cus < 128) { fprintf(stderr, "kernel_launch: device query failed or too few CUs (%d)\n", cus); grid = -1; return; }
        if (hipFuncSetAttribute((const void*)fwd, hipFuncAttributeMaxDynamicSharedMemorySize, LDS_TOTAL) != hipSuccess) { fprintf(stderr, "kernel_launch: hipFuncSetAttribute failed\n"); grid = -1; return; }
        int per_cu = 0;
        if (hipOccupancyMaxActiveBlocksPerMultiprocessor(&per_cu, (const void*)fwd, NTHR, LDS_TOTAL) != hipSuccess || per_cu < 1) fprintf(stderr, "kernel_launch: note: occupancy query reports %d blocks per CU\n", per_cu);
        (void)hipGetLastError();
        grid = cus;
    }
    if (grid < 0) return;
    if (hipMemsetAsync((char*)d_ws + WS_CTL, 0, CTL_ZERO_BYTES, stream) != hipSuccess) { fprintf(stderr, "kernel_launch: memset failed\n"); return; }
    Args a{};
    for (int i = 0; i < 19; ++i) a.in[i] = (const float*)d_in[i];
    a.out = (float*)d_out; a.ws = (unsigned char*)d_ws;
    const int nl = MK_N_LAUNCHES;
    for (int li = 0; li < nl; ++li) {
        a.ph_lo = (nl == 1) ? 0 : li; a.ph_hi = (nl == 1) ? N_PHASES : li + 1;
        hipLaunchKernelGGL(fwd, dim3(grid), dim3(NTHR), LDS_TOTAL, stream, a);
        const hipError_t le = hipPeekAtLastError();
        if (le != hipSuccess) { fprintf(stderr, "kernel_launch: launch %d failed: %s\n", li, hipGetErrorName(le)); break; }
    }
}
```

```cpp
#include <hip/hip_runtime.h>
#include <cstdio>
#include <cstdint>

#ifndef MK_N_LAUNCHES
#define MK_N_LAUNCHES 1
#endif

#ifndef P8_ALIGN
#define PROBE_TIME -1
#define P8_ALIGN true
#endif
#ifndef PROBE_DUP
#define PROBE_DUP -1
#endif
#define GAS __attribute__((address_space(1)))
#define LAS __attribute__((address_space(3)))
typedef unsigned short bf16;
typedef short bf16x8 __attribute__((ext_vector_type(8)));
typedef short s16x4 __attribute__((ext_vector_type(4)));
typedef float f32x4 __attribute__((ext_vector_type(4)));
typedef float f32x2 __attribute__((ext_vector_type(2)));
typedef float f32x16 __attribute__((ext_vector_type(16)));
typedef unsigned u32x4 __attribute__((ext_vector_type(4)));
typedef unsigned u32x2 __attribute__((ext_vector_type(2)));

constexpr int DM = 2048, NB = 8, SEQ = 2048, NTOK = NB * SEQ;
constexpr int POOLW = 1024, NHEAD = 8, HD = 128, NKV = 2, IDXH = 16, IDXD = 64, TOPK = 256;
constexpr int PIN = 3664, PLD = 3840;
constexpr int C_U = 0, C_Q = 1024, C_K = 2048, C_V = 2304, C_QI = 2560, C_KI = 3584, C_WI = 3648;
constexpr int NEXP = 32, DEXP = 512, NGRP = 4, EPG = 8;
constexpr int MAXSLOT = 40960;
constexpr float EPS = 1e-6f;

constexpr size_t MiB = 1u << 20;
constexpr size_t WS_CTL = 0, CTL_ZERO_BYTES = 1 * MiB;
constexpr size_t WS_MOD = 1 * MiB;
constexpr size_t WS_RW = 1 * MiB + 512 * 1024;
constexpr size_t WS_TOKINFO = 2 * MiB;
constexpr size_t WS_TOKLIST = 3 * MiB;
constexpr size_t WS_WPT = 5 * MiB;
constexpr size_t WS_MASK = 6 * MiB;
constexpr size_t WS_WINP = 10 * MiB;
constexpr size_t WS_WIN = 16 * MiB;
constexpr size_t WS_WOUT = 32 * MiB;
constexpr size_t WS_WGU = 40 * MiB;
constexpr size_t WS_WD = 168 * MiB;
constexpr size_t WS_H = 232 * MiB;
constexpr size_t WS_P = 296 * MiB;
constexpr size_t WS_CAT = 416 * MiB;
constexpr size_t WS_Y = 296 * MiB;
constexpr size_t WS_A = 480 * MiB;
constexpr size_t WS_X1 = 520 * MiB;
constexpr size_t WS_END = 584 * MiB;
static_assert(WS_Y + (size_t)MAXSLOT * DM * 2 <= WS_A && WS_P + (size_t)NTOK * PLD * 2 <= WS_CAT && WS_A + (size_t)MAXSLOT * DEXP * 2 <= WS_X1 && WS_X1 + (size_t)NTOK * DM * 2 <= WS_END, "ws map");
constexpr int CW_TMO = 0, CW_Q0 = 64, CW_BAR = 4096, CW_ECNT = 16384;

constexpr int RING_BYTES = 131072;
constexpr int MISC_OFF = RING_BYTES;
constexpr int LDS_BYTES = 147456;
constexpr int NWAVES = 8, NTHR = 512;

#define LDS_WAIT() asm volatile("s_waitcnt lgkmcnt(0)" ::: "memory")
#define VM_WAIT() asm volatile("s_waitcnt vmcnt(0)" ::: "memory")
__device__ __forceinline__ unsigned cvt_pk_bf16(float lo, float hi) { unsigned r; asm volatile("v_cvt_pk_bf16_f32 %0, %1, %2" : "=v"(r) : "v"(lo), "v"(hi)); return r; }
__device__ __forceinline__ float bf2f(bf16 v) { return __builtin_bit_cast(float, (unsigned)v << 16); }
__device__ __forceinline__ float wave_sum(float v) {
#pragma unroll
    for (int o = 1; o < 64; o <<= 1) v += __shfl_xor(v, o);
    return v;
}

__device__ __forceinline__ int lane_now() { int l; asm volatile("v_mbcnt_lo_u32_b32 %0, -1, 0\n\tv_mbcnt_hi_u32_b32 %0, -1, %0" : "=v"(l)); return l; }
namespace pg8 {
constexpr int BM = 256, BK = 64, HALF = 128, HTB = HALF * BK * 2, STAGE_BYTES = 8 * HTB, NXCD = 8, WGM = 4;
__host__ __device__ __forceinline__ int lds_byte(int r, int c) { const int st = (r >> 4) * 2 + (c >> 5), rr = r & 15, cc = c & 31, ob = rr * 64 + cc * 2; return st * 1024 + (ob ^ (((ob >> 9) & 1) << 5)); }
__host__ __device__ __forceinline__ void stage_rc(int b, int& R, int& C) { const int st = b / 1024, sb = b % 1024, swz = sb ^ (((sb >> 9) & 1) << 5); R = (st >> 1) * 16 + swz / 64; C = (st & 1) * 32 + (swz % 64) / 2; }
__host__ __device__ __forceinline__ int perm32(int rho) { const int n = rho >> 4, i = rho & 15; return 8 * (i >> 2) + 4 * n + (i & 3); }

typedef int v4i_t __attribute__((ext_vector_type(4)));
typedef int v8i_t __attribute__((ext_vector_type(8)));
struct Unit { int pm, pn, e, ord, half; };
struct Gemm { const bf16* A; const bf16* Bt; int K, lda, ldb; const LAS unsigned* rowtab; };

struct StaticOrder {
    int nM, nN, nwg, G, c, reps;
    __device__ void init(int M, int N, int G_, int c_) { nM = M / BM; nN = N / BM; nwg = nM * nN; G = G_; c = c_; reps = 1; }
    __device__ bool next(int i, Unit& u) const {
        const long L = (long)i * G + c; if (L >= (long)nwg * reps) return false;
        int wgid = (int)(L % nwg); { const int q = nwg / NXCD, r = nwg % NXCD, xcd = wgid % NXCD, off = wgid / NXCD; wgid = (xcd < r ? xcd * (q + 1) : r * (q + 1) + (xcd - r) * q) + off; }
        const int nig = WGM * nN, gid = wgid / nig, fm = gid * WGM, gsz = (nM - fm) < WGM ? (nM - fm) : WGM;
        u.pm = fm + ((wgid % nig) % gsz); u.pn = (wgid % nig) / gsz; u.e = 0; u.ord = i; u.half = 0; return true;
    }
    __device__ __forceinline__ size_t b_off(const Unit& u, int ldb) const { return (size_t)u.pn * BM * ldb * 2; }
};
struct FoldOrder {
    int G, c;
    __device__ bool next(int i, Unit& u) const { const int L = i * G + c; if (L >= 32) return false; u.pm = L >> 3; u.pn = L & 7; u.e = 0; u.ord = i; u.half = 0; return true; }
    __device__ __forceinline__ size_t b_off(const Unit& u, int ldb) const { return ((size_t)u.pn * BM * ldb + (size_t)u.pm * 256) * 2; }
};
struct MoeTabs { const LAS int* tb; const LAS int* tf; const LAS int* hl; const LAS int* te; };
__device__ __forceinline__ bool moe_unit(const MoeTabs& T, int NT, int L, int reps, int& pm, int& pn, int& e, int& half) {
    const int nf = T.tf[NEXP], nh = T.hl[NEXP], total = (nf + nh) * NT;
    if (L >= total * reps) return false;
    L %= total;
    const int mt = L / NT; pn = L - mt * NT;
    if (mt < nf) { const int x = T.te[mt]; e = x; pm = T.tb[x] + (mt - T.tf[x]); half = 0; }
    else { e = T.hl[mt - nf]; pm = T.tb[e + 1] - 1; half = 1; }
    return true;
}
struct GroupedOrder {
    MoeTabs T; int NT, G, c, rows_per_e, reps;
    __device__ bool next(int i, Unit& u) const { u.ord = i; return moe_unit(T, NT, i * G + c, reps, u.pm, u.pn, u.e, u.half); }
    __device__ __forceinline__ size_t b_off(const Unit& u, int ldb) const { return ((size_t)u.e * rows_per_e + (size_t)u.pn * BM) * ldb * 2; }
};

template <class Epi, class Sched, bool GATHER, bool ALIGN_EPI, bool FP8 = false>
__device__ __forceinline__ void gemm_phase(LAS unsigned char* lds, const Gemm g, const Sched& S, const Epi& E, const int wid) {
    const int lane = lane_now(), tid = wid * 64 + lane, wr = wid >> 2, wc = wid & 3, fr = lane & 15, fq = lane >> 4;
    const int K = g.K, nt = K / BK;
    int Rr[2], Cc[2];
    unsigned voffB[2];
    unsigned cva[2][2], nva[2][2];
#pragma unroll
    for (int i = 0; i < 2; ++i) { int R, C; stage_rc(tid * 16 + i * 8192, R, C); Rr[i] = R; Cc[i] = C; const int Rb = Epi::PERM ? ((R & ~31) + perm32(R & 31)) : R;
        voffB[i] = (unsigned)(Rb * g.ldb + C) * 2u; }
    const size_t kstep = (size_t)(BK * 2);
    const unsigned hstepA = (unsigned)HALF * g.lda * 2u;
    const size_t hstepB = (size_t)HALF * g.ldb * 2;
    const unsigned ldsw = (unsigned)wid * 1024u;
    const int aoff = lds_byte(wr * 64 + fr, fq * 8), boff = lds_byte(wc * 32 + fr, fq * 8);
#define PG8_SA(b, h) (((b) * 2 + (h)) * HTB)
#define PG8_SB(b, h) ((4 + (b) * 2 + (h)) * HTB)
#define PG8_STAGE(bufoff, gbase, v0, v1) do { \
        __builtin_amdgcn_global_load_lds((const unsigned*)((const char*)(gbase) + (v0)), (LAS unsigned*)(lds + (bufoff) + ldsw), 16, 0, 0); \
        __builtin_amdgcn_global_load_lds((const unsigned*)((const char*)(gbase) + (v1)), (LAS unsigned*)(lds + (bufoff) + ldsw + 8192), 16, 0, 0); } while (0)
#define PG8_STAGE_B(bufoff, gbase) PG8_STAGE(bufoff, gbase, voffB[0], voffB[1])
#define PG8_LD8(base) __builtin_shufflevector(*(const LAS v4i_t*)(base), *(const LAS v4i_t*)((base) + 1024), 0, 1, 2, 3, 4, 5, 6, 7)
#define PG8_LDA(dst, b, h) do { _Pragma("unroll") for (int m = 0; m < 4; ++m) dst[m] = PG8_LD8(lds + PG8_SA(b, h) + aoff + m * 2048); } while (0)
#define PG8_LDB(dst, b, h) do { _Pragma("unroll") for (int n = 0; n < 2; ++n) dst[n] = PG8_LD8(lds + PG8_SB(b, h) + boff + n * 2048); } while (0)
#define PG8_LO(x) __builtin_bit_cast(bf16x8, __builtin_shufflevector((x), (x), 0, 1, 2, 3))
#define PG8_HI(x) __builtin_bit_cast(bf16x8, __builtin_shufflevector((x), (x), 4, 5, 6, 7))
#define PG8_MMA(ai, bj, At, Bt) do { __builtin_amdgcn_s_setprio(1); _Pragma("unroll") for (int m = 0; m < 4; ++m) _Pragma("unroll") for (int n = 0; n < 2; ++n) { \
        if constexpr (FP8) asm volatile("v_mfma_scale_f32_16x16x128_f8f6f4 %0, %1, %2, %0, %3, %3 op_sel_hi:[0,0,0]" : "+v"(acc[ai][bj][m][n]) : "v"(Bt[n]), "v"(At[m]), "v"(sc8));   \
        else { acc[ai][bj][m][n] = __builtin_amdgcn_mfma_f32_16x16x32_bf16(PG8_LO(Bt[n]), PG8_LO(At[m]), acc[ai][bj][m][n], 0, 0, 0); \
               acc[ai][bj][m][n] = __builtin_amdgcn_mfma_f32_16x16x32_bf16(PG8_HI(Bt[n]), PG8_HI(At[m]), acc[ai][bj][m][n], 0, 0, 0); } } \
        __builtin_amdgcn_s_setprio(0); } while (0)
#define PG8_WAIT_V(n) asm volatile("s_waitcnt vmcnt(" #n ")" ::: "memory")
#define PG8_WAIT_L(n) asm volatile("s_waitcnt lgkmcnt(" #n ")" ::: "memory")
#define PG8_BAR __builtin_amdgcn_s_barrier()
#define PG8_SCHED __builtin_amdgcn_sched_barrier(0)
#define PG8_AOFF(dst, u) do { _Pragma("unroll") for (int h_ = 0; h_ < 2; ++h_) _Pragma("unroll") for (int i_ = 0; i_ < 2; ++i_) { \
        if constexpr (GATHER) dst[h_][i_] = g.rowtab[(u).ord * 256 + h_ * HALF + Rr[i_]] + (unsigned)Cc[i_] * 2u; \
        else dst[h_][i_] = (unsigned)(Rr[i_] * g.lda + Cc[i_]) * 2u + (unsigned)h_ * hstepA; } } while (0)
    Unit cur, nxt; int ui = 0;
    if (!S.next(0, cur)) return;
    const int sc8 = 0x7f7f7f7f;
    f32x4 acc[2][2][4][2];
#pragma unroll
    for (int a = 0; a < 2; ++a)
#pragma unroll
        for (int b = 0; b < 2; ++b)
#pragma unroll
            for (int m = 0; m < 4; ++m)
#pragma unroll
                for (int n = 0; n < 2; ++n) acc[a][b][m][n] = (f32x4){0.f, 0.f, 0.f, 0.f};
    v8i_t At[4], B0[2], B1[2];
    const size_t tstepA = (size_t)BM * g.lda * 2;
    const char* cA = GATHER ? (const char*)g.A : (const char*)g.A + (size_t)cur.pm * tstepA;
    const char* cB = (const char*)g.Bt + S.b_off(cur, g.ldb);
    PG8_AOFF(cva, cur);
#pragma unroll
    for (int h_ = 0; h_ < 2; ++h_)
#pragma unroll
        for (int i_ = 0; i_ < 2; ++i_) nva[h_][i_] = cva[h_][i_];
    if constexpr (GATHER) { LDS_WAIT(); }
    PG8_STAGE_B(PG8_SB(0, 0), cB); PG8_STAGE_B(PG8_SB(0, 1), cB + hstepB); PG8_STAGE(PG8_SA(0, 0), cA, cva[0][0], cva[0][1]); PG8_STAGE(PG8_SA(0, 1), cA, cva[1][0], cva[1][1]);
    if (wr == 1) PG8_BAR;
    PG8_WAIT_V(2); PG8_BAR;
    PG8_STAGE_B(PG8_SB(1, 0), cB + kstep); PG8_STAGE(PG8_SA(1, 0), cA + kstep, cva[0][0], cva[0][1]); PG8_STAGE_B(PG8_SB(1, 1), cB + hstepB + kstep);
    PG8_WAIT_V(6); PG8_BAR;
    for (;;) {
        const bool has_next = S.next(ui + 1, nxt);
        const bool full = (cur.half == 0);
        const char* nA = GATHER ? cA : (has_next ? (const char*)g.A + (size_t)nxt.pm * tstepA : cA);
        const char* nB = has_next ? (const char*)g.Bt + S.b_off(nxt, g.ldb) : cB;
#pragma nounroll
        for (int t = 0; t < nt; t += 2) {
            const bool last = (t == nt - 2);
            const char* a1 = cA + (size_t)(t + 1) * kstep;
            const char* a2 = last ? nA : cA + (size_t)(t + 2) * kstep; const char* b2 = last ? nB : cB + (size_t)(t + 2) * kstep;
            const char* a3 = a2 + kstep; const char* b3 = b2 + kstep;
            if (last) { if (has_next) { PG8_AOFF(nva, nxt); } else {
#pragma unroll
                for (int h_ = 0; h_ < 2; ++h_)
#pragma unroll
                    for (int i_ = 0; i_ < 2; ++i_) nva[h_][i_] = cva[h_][i_]; }
                if constexpr (GATHER) { LDS_WAIT(); } }
            unsigned v2[2][2];
#pragma unroll
            for (int h_ = 0; h_ < 2; ++h_)
#pragma unroll
                for (int i_ = 0; i_ < 2; ++i_) v2[h_][i_] = last ? nva[h_][i_] : cva[h_][i_];
            PG8_LDB(B0, 0, 0); PG8_LDB(B1, 0, 1); PG8_SCHED; PG8_LDA(At, 0, 0); PG8_STAGE(PG8_SA(1, 1), a1, cva[1][0], cva[1][1]);
            PG8_WAIT_V(8); PG8_WAIT_L(0); PG8_BAR; PG8_MMA(0, 0, At, B0); PG8_MMA(0, 1, At, B1); PG8_BAR; PG8_SCHED;
            PG8_LDA(At, 0, 1); PG8_STAGE_B(PG8_SB(0, 0), b2); PG8_STAGE_B(PG8_SB(0, 1), b2 + hstepB); PG8_STAGE(PG8_SA(0, 0), a2, v2[0][0], v2[0][1]);
            PG8_WAIT_V(8); PG8_WAIT_L(0); PG8_BAR; if (full) { PG8_MMA(1, 0, At, B0); PG8_MMA(1, 1, At, B1); } PG8_BAR; PG8_SCHED;
            PG8_LDB(B0, 1, 0); PG8_LDB(B1, 1, 1); PG8_SCHED; PG8_LDA(At, 1, 0); PG8_STAGE(PG8_SA(0, 1), a2, v2[1][0], v2[1][1]);
            PG8_WAIT_V(8); PG8_WAIT_L(0); PG8_BAR; PG8_MMA(0, 0, At, B0); PG8_MMA(0, 1, At, B1); PG8_BAR; PG8_SCHED;
            PG8_LDA(At, 1, 1); PG8_STAGE_B(PG8_SB(1, 0), b3); PG8_STAGE_B(PG8_SB(1, 1), b3 + hstepB); PG8_STAGE(PG8_SA(1, 0), a3, v2[0][0], v2[0][1]);
            PG8_WAIT_V(8); PG8_WAIT_L(0); PG8_BAR; if (full) { PG8_MMA(1, 0, At, B0); PG8_MMA(1, 1, At, B1); } PG8_BAR; PG8_SCHED;
        }
        if constexpr (FP8) asm volatile("s_nop 15\n\ts_nop 15" ::: "memory");
        if constexpr (ALIGN_EPI) { if (wr == 0) PG8_BAR; }
        E(acc, cur, wr, wc, fr, fq);
        if (!has_next) break;
#pragma unroll
        for (int a = 0; a < 2; ++a)
#pragma unroll
            for (int b = 0; b < 2; ++b)
#pragma unroll
                for (int m = 0; m < 4; ++m)
#pragma unroll
                    for (int n = 0; n < 2; ++n) acc[a][b][m][n] = (f32x4){0.f, 0.f, 0.f, 0.f};
        cur = nxt; cA = nA; cB = nB; ++ui;
#pragma unroll
        for (int h_ = 0; h_ < 2; ++h_)
#pragma unroll
            for (int i_ = 0; i_ < 2; ++i_) cva[h_][i_] = nva[h_][i_];
        if constexpr (ALIGN_EPI) { if (wr == 1) PG8_BAR; }
    }
    PG8_WAIT_V(0);
    if constexpr (!ALIGN_EPI) { if (wr == 0) PG8_BAR; }
    PG8_BAR;
#undef PG8_SA
#undef PG8_SB
#undef PG8_STAGE
#undef PG8_STAGE_B
#undef PG8_LDA
#undef PG8_LDB
#undef PG8_MMA
#undef PG8_LD8
#undef PG8_LO
#undef PG8_HI
#undef PG8_WAIT_V
#undef PG8_WAIT_L
#undef PG8_BAR
#undef PG8_SCHED
#undef PG8_AOFF
}

struct EpiBf16 {
    static constexpr bool PERM = true;
    bf16* O; int ldc; const float* rowscale; float oscale;
    __device__ __forceinline__ void operator()(const f32x4 (&acc)[2][2][4][2], const Unit& u, int wr, int wc, int fr, int fq) const {
        const int row0 = u.pm * BM + wr * 64 + fr, col0 = u.pn * BM + wc * 32 + 8 * fq;
#pragma unroll
        for (int ai = 0; ai < 2; ++ai)
#pragma unroll
            for (int m = 0; m < 4; ++m) { const int row = row0 + ai * HALF + m * 16; bf16* rowp = O + (size_t)row * ldc + col0; const float s = rowscale ? rowscale[row] * oscale : oscale;
#pragma unroll
                for (int bj = 0; bj < 2; ++bj) { const f32x4 v0 = acc[ai][bj][m][0] * s, v1 = acc[ai][bj][m][1] * s;
                    u32x4 w; w.x = cvt_pk_bf16(v0[0], v0[1]); w.y = cvt_pk_bf16(v0[2], v0[3]); w.z = cvt_pk_bf16(v1[0], v1[1]); w.w = cvt_pk_bf16(v1[2], v1[3]);
                    *(u32x4*)(rowp + bj * HALF) = w; } }
    }
};
struct EpiFp8 {
    static constexpr bool PERM = true;
    unsigned char* O; int ldc; float oscale;
    __device__ __forceinline__ void operator()(const f32x4 (&acc)[2][2][4][2], const Unit& u, int wr, int wc, int fr, int fq) const {
        const int row0 = u.pm * BM + wr * 64 + fr, col0 = u.pn * BM + wc * 32 + 8 * fq;
#pragma unroll
        for (int ai = 0; ai < 2; ++ai)
#pragma unroll
            for (int m = 0; m < 4; ++m) { unsigned char* rowp = O + (size_t)(row0 + ai * HALF + m * 16) * ldc + col0;
#pragma unroll
                for (int bj = 0; bj < 2; ++bj) { const f32x4 v0 = acc[ai][bj][m][0] * oscale, v1 = acc[ai][bj][m][1] * oscale; u32x2 w;
                    { int p = __builtin_amdgcn_cvt_pk_fp8_f32(v0[0], v0[1], 0, false); p = __builtin_amdgcn_cvt_pk_fp8_f32(v0[2], v0[3], p, true); w.x = (unsigned)p; }
                    { int p = __builtin_amdgcn_cvt_pk_fp8_f32(v1[0], v1[1], 0, false); p = __builtin_amdgcn_cvt_pk_fp8_f32(v1[2], v1[3], p, true); w.y = (unsigned)p; }
                    *(u32x2*)(rowp + bj * HALF) = w; } }
    }
};
struct EpiResid {
    static constexpr bool PERM = true;
    const float* X; bf16* X1; const float* gate;
    __device__ __forceinline__ void operator()(const f32x4 (&acc)[2][2][4][2], const Unit& u, int wr, int wc, int fr, int fq) const {
        const int row0 = u.pm * BM + wr * 64 + fr, col0 = u.pn * BM + wc * 32 + 8 * fq;
        const float* gp = gate + (size_t)((u.pm * BM) / SEQ) * (6 * DM) + col0;
        f32x4 gv[2][2];
#pragma unroll
        for (int bj = 0; bj < 2; ++bj)
#pragma unroll
            for (int n = 0; n < 2; ++n) gv[bj][n] = *(const f32x4*)(gp + bj * HALF + n * 4);
#pragma unroll
        for (int ai = 0; ai < 2; ++ai) {
            f32x4 xv[4][2][2];
#pragma unroll
            for (int m = 0; m < 4; ++m) { const size_t ro = (size_t)(row0 + ai * HALF + m * 16) * DM + col0;
#pragma unroll
                for (int bj = 0; bj < 2; ++bj) { xv[m][bj][0] = *(const f32x4*)(X + ro + bj * HALF); xv[m][bj][1] = *(const f32x4*)(X + ro + bj * HALF + 4); } }
#pragma unroll
            for (int m = 0; m < 4; ++m) { const size_t ro = (size_t)(row0 + ai * HALF + m * 16) * DM + col0;
#pragma unroll
                for (int bj = 0; bj < 2; ++bj) {
                    const f32x4 v0 = xv[m][bj][0] + gv[bj][0] * acc[ai][bj][m][0], v1 = xv[m][bj][1] + gv[bj][1] * acc[ai][bj][m][1];
                    u32x4 w; w.x = cvt_pk_bf16(v0[0], v0[1]); w.y = cvt_pk_bf16(v0[2], v0[3]); w.z = cvt_pk_bf16(v1[0], v1[1]); w.w = cvt_pk_bf16(v1[2], v1[3]);
                    *(u32x4*)(X1 + ro + bj * HALF) = w; } }
        }
    }
};
struct EpiGateUp {
    static constexpr bool PERM = true;
    unsigned char* O; float isc;
    __device__ __forceinline__ void operator()(const f32x4 (&acc)[2][2][4][2], const Unit& u, int wr, int wc, int fr, int fq) const {
        const int row0 = u.pm * BM + wr * 64 + fr, col0 = u.pn * HALF + wc * 32 + 8 * fq;
#pragma unroll
        for (int ai = 0; ai < 2; ++ai)
#pragma unroll
            for (int m = 0; m < 4; ++m) { unsigned char* rowp = O + (size_t)(row0 + ai * HALF + m * 16) * DEXP + col0; float r[8];
#pragma unroll
                for (int n = 0; n < 2; ++n)
#pragma unroll
                    for (int j = 0; j < 4; ++j) { const float gt = acc[ai][0][m][n][j] * isc, up = acc[ai][1][m][n][j] * isc;
                        r[n * 4 + j] = gt * __builtin_amdgcn_rcpf(1.f + __builtin_amdgcn_exp2f(-1.4426950408889634f * gt)) * up; }
                u32x2 w; { int p = __builtin_amdgcn_cvt_pk_fp8_f32(r[0], r[1], 0, false); p = __builtin_amdgcn_cvt_pk_fp8_f32(r[2], r[3], p, true); w.x = (unsigned)p; }
                { int p = __builtin_amdgcn_cvt_pk_fp8_f32(r[4], r[5], 0, false); p = __builtin_amdgcn_cvt_pk_fp8_f32(r[6], r[7], p, true); w.y = (unsigned)p; }
                *(u32x2*)rowp = w; }
    }
};
}

constexpr int MISC_BASE = 139264;
constexpr int LDS_TOTAL = 159744;
constexpr int MO_BARW = 0;
constexpr int MO_TB = 256;
constexpr int MO_CNT = 768;
constexpr int MO_ROWTAB = 1024;
constexpr int MO_BIAS = 10240;
constexpr int MAXU = 8;
static_assert(MISC_BASE + MO_BIAS + 304 * 4 <= LDS_TOTAL, "lds map");

#define XB_TMO      128
#define XB_XCNT(j)  (256  + 64 * (j))
#define XB_XSUB(j)  (1280 + 64 * (j))
#define XB_XGEN(j)  (2304 + 64 * (j))
#define XB_TOP      3328
#define XB_TOPGEN   3392
#define XCD_BAR_WORDS 3456
#define XB_SPIN_CAP (1u << 18)
__device__ __forceinline__ unsigned xb_ld(unsigned* p)              { return __hip_atomic_load(p, __ATOMIC_RELAXED, __HIP_MEMORY_SCOPE_AGENT); }
__device__ __forceinline__ unsigned xb_add(unsigned* p, unsigned v) { return __hip_atomic_fetch_add(p, v, __ATOMIC_RELAXED, __HIP_MEMORY_SCOPE_AGENT); }
__device__ __forceinline__ unsigned xb_xcc_id() { return (unsigned)__builtin_amdgcn_s_getreg((3 << 11) | 20) & 0xFu; }
#define XB_SPIN(cond, bar) do { unsigned _sp = 0; while (cond) { __builtin_amdgcn_s_sleep(1); \
    if ((++_sp & 255u) == 0u) { if (xb_ld(&(bar)[XB_TMO])) break; if (_sp > XB_SPIN_CAP) { atomicAdd(&(bar)[XB_TMO], 1u); break; } } } } while (0)
struct XcdBarrier { unsigned* bar; unsigned x; volatile LAS unsigned* st; int wave; };
__device__ __forceinline__ XcdBarrier xcd_barrier_post(unsigned* bar, volatile LAS unsigned* st, int wave) {
    XcdBarrier b; b.bar = bar; b.x = xb_xcc_id(); b.st = st; b.wave = wave;
    if (wave == 0 && lane_now() == 0) (void)xb_add(&bar[XB_XCNT(b.x)], 1u);
    return b;
}
__device__ __forceinline__ void xcd_barrier_complete(unsigned* bar, unsigned x, unsigned& nloc, unsigned& nx) {
    const unsigned G = gridDim.x * gridDim.y * gridDim.z;
    unsigned sum, cnt, mine, sp = 0u;
    for (;;) {
        sum = 0u; cnt = 0u; mine = 0u;
#pragma unroll
        for (unsigned j = 0; j < 16; ++j) { const unsigned c = xb_ld(&bar[XB_XCNT(j)]); sum += c; cnt += (c > 0u) ? 1u : 0u; mine = (j == x) ? c : mine; }
        if (sum == G) break;
        __builtin_amdgcn_s_sleep(1);
        if ((++sp & 255u) == 0u) { if (xb_ld(&bar[XB_TMO])) break; if (sp > XB_SPIN_CAP) { atomicAdd(&bar[XB_TMO], 1u); break; } }
    }
    nloc = mine > 0u ? mine : 1u; nx = cnt > 0u ? cnt : 1u;
}
__device__ __forceinline__ void xcd_barrier(const XcdBarrier& b) {
    asm volatile("s_waitcnt vmcnt(0)" ::: "memory");
    __syncthreads();
    if (b.wave == 0 && lane_now() == 0) {
        unsigned* bar = b.bar;
        __builtin_amdgcn_s_waitcnt(0);
        unsigned nloc = b.st[0], nx = b.st[1];
        if (nloc == 0u) { xcd_barrier_complete(bar, b.x, nloc, nx); b.st[0] = nloc; b.st[1] = nx; }
        const unsigned old = xb_add(&bar[XB_XSUB(b.x)], 1u);
        const unsigned gen = old / nloc;
        if (old + 1u == (gen + 1u) * nloc) {
            __builtin_amdgcn_fence(__ATOMIC_RELEASE, "agent");
            asm volatile("s_waitcnt vmcnt(0)" ::: "memory");
            const unsigned og = xb_add(&bar[XB_TOP], 1u);
            const unsigned tg = og / nx;
            if (og + 1u == (tg + 1u) * nx) xb_add(&bar[XB_TOPGEN], 1u);
            else XB_SPIN(xb_ld(&bar[XB_TOPGEN]) == tg, bar);
            __builtin_amdgcn_fence(__ATOMIC_ACQUIRE, "agent");
            xb_add(&bar[XB_XGEN(b.x)], 1u);
            asm volatile("s_waitcnt vmcnt(0)" ::: "memory");
        } else {
            XB_SPIN(xb_ld(&bar[XB_XGEN(b.x)]) == gen, bar);
            __builtin_amdgcn_fence(__ATOMIC_ACQUIRE, "agent");
            asm volatile("s_waitcnt vmcnt(0)" ::: "memory");
        }
    }
    __syncthreads();
}

struct Frame {
    LAS unsigned char* lds;
    unsigned* ctl;
    int tid, lane, wave, G, bid, vcu;
    const float *x, *c, *w_ada, *b_ada, *g_mix, *w_in, *w_pool, *pool_scale, *rel_bias, *w_out, *g_ffn, *w_group, *b_group, *w_router, *b_router, *w_gate, *w_up, *w_down, *g_final;
    float* out; float* mod;
    bf16 *RW, *WpT, *WinP, *Win, *Wout, *Wgu, *Wd, *H, *P, *CAT, *Y, *A, *X1;
    unsigned* MASK; int* TOKLIST; unsigned* TOKINFO;
};

constexpr float Y_SCALE = 8.f;
constexpr float WD_SCALE = 16.f;
constexpr float WGU_SCALE = 32.f;
__device__ __forceinline__ unsigned pk4_fp8(float a, float b, float c, float d) { int p = __builtin_amdgcn_cvt_pk_fp8_f32(a, b, 0, false); p = __builtin_amdgcn_cvt_pk_fp8_f32(c, d, p, true); return (unsigned)p; }
struct P0Tile { const float* src; unsigned char* dst; int ld_src, k0, n0, nvalid, ld_dst, himul, radd, fp8; float scale; };
constexpr int P0_R0 = 32 * 44, P0_R1 = 32 * 32, P0_R2 = 32 * 256, P0_R5 = 64, P0_R6 = 512, P0_R7 = 32;
constexpr int P0_TILES = P0_R0 + P0_R1 + 3 * P0_R2 + P0_R5;
constexpr int P0_ITEMS = P0_TILES + P0_R6 + P0_R7;
constexpr int P0_DEF_E0 = 16;
constexpr int P0_OFF_START = P0_R0 + P0_R1 + 2 * P0_R2 + P0_DEF_E0 * 256, P0_OFF_LEN = (32 - P0_DEF_E0) * 256;
__device__ __forceinline__ P0Tile p0_decode(Frame& F, int it) {
    P0Tile t; t.fp8 = 0; t.scale = 1.f; t.himul = 128; t.radd = 0;
    if (it < P0_R0) { const int kb = it / 44, nb = it % 44; t.src = F.w_in; t.ld_src = PIN; t.k0 = 64 * kb; t.n0 = 1024 + 64 * nb; t.nvalid = PIN; t.dst = (unsigned char*)F.Win; t.ld_dst = DM * 2; return t; } it -= P0_R0;
    if (it < P0_R1) { const int kb = it >> 5, nb = it & 31; t.src = F.w_out; t.ld_src = DM; t.k0 = 64 * kb; t.n0 = 64 * nb; t.nvalid = DM; t.dst = (unsigned char*)F.Wout; t.ld_dst = DM * 2; return t; } it -= P0_R1;
    if (it < 2 * P0_R2) { const int up = it >= P0_R2; if (up) it -= P0_R2; const int e = it >> 8, r = it & 255, kb = r >> 4, nb = r & 15;
        t.src = (up ? F.w_up : F.w_gate) + (size_t)e * DM * DEXP; t.ld_src = DEXP; t.k0 = 128 * kb; t.n0 = 32 * nb; t.nvalid = DEXP; t.dst = (unsigned char*)F.Wgu + (size_t)e * 1024 * DM; t.ld_dst = DM;
        t.himul = 256; t.radd = up ? 128 : 0; t.fp8 = 1; t.scale = WGU_SCALE; return t; } it -= 2 * P0_R2;
    if (it < P0_R2) { const int e = it >> 8, r = it & 255, kb = r >> 6, nb = r & 63;
        t.src = F.w_down + (size_t)e * DEXP * DM; t.ld_src = DM; t.k0 = 128 * kb; t.n0 = 32 * nb; t.nvalid = DM; t.dst = (unsigned char*)F.Wd + (size_t)e * DM * DEXP; t.ld_dst = DEXP; t.fp8 = 1; t.scale = WD_SCALE; return t; } it -= P0_R2;
    { const int g = it >> 4, r = it & 15, kb = r >> 2, nb = r & 3; t.src = F.w_pool + (size_t)g * 65536; t.ld_src = 256; t.k0 = 64 * kb; t.n0 = 64 * nb; t.nvalid = 256; t.dst = (unsigned char*)(F.WpT + (size_t)g * 65536); t.ld_dst = 512; return t; }
}
__device__ __forceinline__ void p0_tile_load(const P0Tile& t, f32x4 (&v)[16], int lane) {
    const int sh = t.fp8 ? 3 : 4, nn = (lane & ((1 << sh) - 1)) * 4, kr = lane >> sh;
#pragma unroll
    for (int i = 0; i < 16; ++i) { v[i] = (f32x4){0.f, 0.f, 0.f, 0.f}; if (t.n0 + nn < t.nvalid) v[i] = *(const f32x4*)(t.src + (size_t)(t.k0 + 16 * kr + i) * t.ld_src + t.n0 + nn); }
}
__device__ __forceinline__ void p0_tile_pack(const P0Tile& t, const f32x4 (&v)[16], u32x4 (&o)[8]) {
    if (t.fp8) {
        const float sc = t.scale;
#pragma unroll
        for (int j = 0; j < 4; ++j) { u32x4 p; p.x = pk4_fp8(v[0][j] * sc, v[1][j] * sc, v[2][j] * sc, v[3][j] * sc); p.y = pk4_fp8(v[4][j] * sc, v[5][j] * sc, v[6][j] * sc, v[7][j] * sc);
            p.z = pk4_fp8(v[8][j] * sc, v[9][j] * sc, v[10][j] * sc, v[11][j] * sc); p.w = pk4_fp8(v[12][j] * sc, v[13][j] * sc, v[14][j] * sc, v[15][j] * sc); o[2 * j] = p; o[2 * j + 1] = p; }
    } else {
#pragma unroll
        for (int j = 0; j < 4; ++j) {
            o[2 * j].x = cvt_pk_bf16(v[0][j], v[1][j]); o[2 * j].y = cvt_pk_bf16(v[2][j], v[3][j]); o[2 * j].z = cvt_pk_bf16(v[4][j], v[5][j]); o[2 * j].w = cvt_pk_bf16(v[6][j], v[7][j]);
            o[2 * j + 1].x = cvt_pk_bf16(v[8][j], v[9][j]); o[2 * j + 1].y = cvt_pk_bf16(v[10][j], v[11][j]); o[2 * j + 1].z = cvt_pk_bf16(v[12][j], v[13][j]); o[2 * j + 1].w = cvt_pk_bf16(v[14][j], v[15][j]); }
    }
}
__device__ __forceinline__ void p0_tile_store(const P0Tile& t, const u32x4 (&o)[8], int lane) {
    const int sh = t.fp8 ? 3 : 4, nn = (lane & ((1 << sh) - 1)) * 4, kr = lane >> sh;
#pragma unroll
    for (int j = 0; j < 4; ++j) { const int ng = t.n0 + nn + j, row = (ng >> 7) * t.himul + (ng & 127) + t.radd;
        unsigned char* d = t.dst + (size_t)row * t.ld_dst;
        const int ko = (t.k0 + 16 * kr) << (t.fp8 ? 0 : 1);
        *(u32x4*)(d + ko) = o[2 * j];
        if (!t.fp8) *(u32x4*)(d + ko + 16) = o[2 * j + 1]; }
}
__device__ __forceinline__ void p0_small_item(Frame& F, int it) {
    const int lane = F.lane;
    if (it < P0_R6) {
        f32x4 v[4][4];
#pragma unroll
        for (int rr = 0; rr < 4; ++rr)
#pragma unroll
            for (int j = 0; j < 4; ++j) v[rr][j] = *(const f32x4*)(F.w_in + (size_t)(it * 4 + rr) * PIN + j * 256 + lane * 4);
#pragma unroll
        for (int rr = 0; rr < 4; ++rr)
#pragma unroll
            for (int j = 0; j < 4; ++j) { u32x2 o; o.x = cvt_pk_bf16(v[rr][j][0], v[rr][j][1]); o.y = cvt_pk_bf16(v[rr][j][2], v[rr][j][3]);
                *(u32x2*)(F.WinP + (size_t)(it * 4 + rr) * 1024 + j * 256 + lane * 4) = o; }
        return; } it -= P0_R6;
    {
        const int k = it * 64 + lane;
        const f32x4 g = *(const f32x4*)(F.w_group + (size_t)k * 4);
        f32x4 r[8];
#pragma unroll
        for (int q = 0; q < 8; ++q) r[q] = *(const f32x4*)(F.w_router + (size_t)k * 32 + 4 * q);
#pragma unroll
        for (int j = 0; j < 48; ++j) { float v = 0.f; if (j < 4) v = g[j]; else if (j < 36) v = r[(j - 4) >> 2][(j - 4) & 3];
            F.RW[(size_t)j * DM + k] = (bf16)(cvt_pk_bf16(v, 0.f) & 0xffffu); }
    }
}
__device__ __forceinline__ void p0_mod_item(Frame& F, int m) {
    LAS float* sil = (LAS float*)F.lds;
    LAS float* part = (LAS float*)(F.lds + 65536);
    { float cv[NB * DM / NTHR];
#pragma unroll
      for (int q = 0; q < NB * DM / NTHR; ++q) cv[q] = F.c[F.tid + q * NTHR];
#pragma unroll
      for (int q = 0; q < NB * DM / NTHR; ++q) sil[F.tid + q * NTHR] = cv[q] / (1.f + __expf(-cv[q])); }
    __syncthreads();
    const int lane = F.lane, cq = lane & 15, rs = lane >> 4, j0 = 64 * m + 4 * cq;
    f32x4 acc[NB];
#pragma unroll
    for (int b = 0; b < NB; ++b) acc[b] = (f32x4){0.f, 0.f, 0.f, 0.f};
#pragma unroll 1
    for (int i0 = 0; i0 < 64; i0 += 16) {
        f32x4 w[16];
#pragma unroll
        for (int u = 0; u < 16; ++u) w[u] = *(const f32x4*)(F.w_ada + (size_t)(256 * F.wave + 4 * (i0 + u) + rs) * (6 * DM) + j0);
        __builtin_amdgcn_sched_barrier(0);
#pragma unroll
        for (int u = 0; u < 16; ++u) { const int k = 256 * F.wave + 4 * (i0 + u) + rs;
#pragma unroll
            for (int b = 0; b < NB; ++b) acc[b] += w[u] * sil[b * DM + k];
            if ((u & 1) == 1) __builtin_amdgcn_sched_barrier(0); }
    }
#pragma unroll
    for (int b = 0; b < NB; ++b)
#pragma unroll
        for (int j = 0; j < 4; ++j) { float v = acc[b][j]; v += __shfl_xor(v, 16); v += __shfl_xor(v, 32); acc[b][j] = v; }
    if (rs == 0) {
#pragma unroll
        for (int b = 0; b < NB; ++b) *(LAS f32x4*)(part + (F.wave * NB + b) * 64 + 4 * cq) = acc[b]; }
    __syncthreads();
    { const int b = F.tid >> 6, col = F.tid & 63; float s = F.b_ada[64 * m + col];
#pragma unroll
        for (int w = 0; w < NWAVES; ++w) s += part[(w * NB + b) * 64 + col];
        F.mod[(size_t)b * (6 * DM) + 64 * m + col] = s; }
    __syncthreads();
}
__device__ __forceinline__ void p0_run(Frame& F, int r, int stride, int a0, int lenA, int b0, int lenB) {
    const int total = lenA + lenB;
#define P0_MAP(d) ((d) < lenA ? a0 + (d) : b0 + ((d) - lenA))
    f32x4 v[16]; u32x4 o[8]; bool loaded = false; P0Tile cur, nxt;
    if (r < total && P0_MAP(r) < P0_TILES) { cur = p0_decode(F, P0_MAP(r)); p0_tile_load(cur, v, F.lane); loaded = true; }
    for (int d = r; d < total; d += stride) {
        const int it = P0_MAP(d);
        if (it < P0_TILES) {
            if (!loaded) { cur = p0_decode(F, it); p0_tile_load(cur, v, F.lane); }
            p0_tile_pack(cur, v, o);
            const int dn = d + stride; loaded = false;
            if (dn < total && P0_MAP(dn) < P0_TILES) { nxt = p0_decode(F, P0_MAP(dn)); p0_tile_load(nxt, v, F.lane); loaded = true; }
            p0_tile_store(cur, o, F.lane);
            cur = nxt;
        } else p0_small_item(F, it - P0_TILES);
    }
#undef P0_MAP
}
constexpr int P0_EARLY_A = P0_R0 + P0_R1, P0_EARLY_B0 = P0_R0 + P0_R1 + 3 * P0_R2, P0_EARLY_BLEN = P0_ITEMS - P0_EARLY_B0;
__device__ __forceinline__ void p0_prologue(Frame& F, int qword) {
    (void)qword;
    __syncthreads();
    for (int m = F.bid; m < 192; m += F.G) p0_mod_item(F, m);
    const int gw = F.bid * NWAVES + F.wave;
    const int r = (F.G == 256) ? ((F.bid >= 192) ? gw - 192 * NWAVES : gw + 64 * NWAVES) : gw;
    p0_run(F, r, F.G * NWAVES, 0, P0_EARLY_A, P0_EARLY_B0, P0_EARLY_BLEN);
}
__device__ __forceinline__ void p0_late(Frame& F) {
    __syncthreads();
    p0_run(F, F.bid * NWAVES + F.wave, F.G * NWAVES, P0_EARLY_A + P0_R2, P0_R2, 0, 0);
}
__device__ __forceinline__ void p0_deferred(Frame& F) {
    if (F.G != 256 || F.bid < 192) return;
    f32x4 va[16], vb[16]; u32x4 o[8]; P0Tile ta, tb, t; constexpr int ST = 64 * NWAVES;
    int ja = (F.bid - 192) * NWAVES + F.wave, jb = ja + ST;
    if (ja < P0_OFF_LEN) { ta = p0_decode(F, P0_OFF_START + ja); p0_tile_load(ta, va, F.lane); }
    if (jb < P0_OFF_LEN) { tb = p0_decode(F, P0_OFF_START + jb); p0_tile_load(tb, vb, F.lane); }
    while (ja < P0_OFF_LEN) {
        p0_tile_pack(ta, va, o); t = ta; ja += 2 * ST;
        if (ja < P0_OFF_LEN) { ta = p0_decode(F, P0_OFF_START + ja); p0_tile_load(ta, va, F.lane); }
        p0_tile_store(t, o, F.lane);
        if (jb >= P0_OFF_LEN) break;
        p0_tile_pack(tb, vb, o); t = tb; jb += 2 * ST;
        if (jb < P0_OFF_LEN) { tb = p0_decode(F, P0_OFF_START + jb); p0_tile_load(tb, vb, F.lane); }
        p0_tile_store(t, o, F.lane);
    }
}

__device__ __forceinline__ void p1_norm_rows(Frame& F, const float* xin, const float* gvec, int sh_off, int sc_off, bf16* hout) {
    const int gw = F.bid * NWAVES + F.wave, NGW = F.G * NWAVES, lane = F.lane;
    for (int grp = gw; grp < NTOK / 8; grp += NGW) {
        const int m0 = grp * 8, b = m0 / SEQ;
        const float* modb = F.mod + (size_t)b * (6 * DM);
        f32x4 gs[8], sh[8];
#pragma unroll
        for (int j = 0; j < 8; ++j) { const int col = 256 * j + 4 * lane; const f32x4 g = *(const f32x4*)(gvec + col), sc = *(const f32x4*)(modb + sc_off + col);
            gs[j] = g * (sc + 1.f); sh[j] = *(const f32x4*)(modb + sh_off + col); }
        f32x4 xa[8], xb[8];
#pragma unroll
        for (int j = 0; j < 8; ++j) xa[j] = *(const f32x4*)(xin + (size_t)m0 * DM + 256 * j + 4 * lane);
#define P1_ROW(CUR, NXT, r) do { \
            if ((r) + 1 < 8) { _Pragma("unroll") for (int j = 0; j < 8; ++j) NXT[j] = *(const f32x4*)(xin + (size_t)(m0 + (r) + 1) * DM + 256 * j + 4 * lane); } \
            float s = 0.f; \
            _Pragma("unroll") for (int j = 0; j < 8; ++j) s += (CUR[j][0] * CUR[j][0] + CUR[j][1] * CUR[j][1]) + (CUR[j][2] * CUR[j][2] + CUR[j][3] * CUR[j][3]); \
            const float rstd = 1.f / sqrtf(wave_sum(s) * (1.f / DM) + EPS); \
            bf16* orow = hout + (size_t)(m0 + (r)) * DM; \
            _Pragma("unroll") for (int j = 0; j < 8; ++j) { const f32x4 y = CUR[j] * rstd * gs[j] + sh[j]; \
                u32x2 o; o.x = cvt_pk_bf16(y[0], y[1]); o.y = cvt_pk_bf16(y[2], y[3]); *(u32x2*)(orow + 256 * j + 4 * lane) = o; } } while (0)
#pragma unroll 1
        for (int rp = 0; rp < 4; ++rp) { P1_ROW(xa, xb, 2 * rp); P1_ROW(xb, xa, 2 * rp + 1); }
#undef P1_ROW
    }
}

template <int W>
__device__ __forceinline__ void p3_window_load(Frame& F, int g, int tp, int lane, bf16x8 (&v)[W]) {
    const int m = 2 * tp + (lane >> 5), t = m & (SEQ - 1), c0 = g * 256 + 8 * (lane & 31);
    const char* up = (const char*)(F.P + (size_t)m * PLD + C_U + c0);
#pragma unroll
    for (int tau = 0; tau < W; ++tau) { const int back = (t - tau >= 0) ? tau : 0; v[tau] = *(const bf16x8*)(up - (size_t)back * (PLD * 2)); }
}
template <int W>
__device__ __forceinline__ void p3_window_finish(Frame& F, int g, int tp, int lane, const bf16x8 (&v)[W]) {
    const int m = 2 * tp + (lane >> 5), t = m & (SEQ - 1), c0 = g * 256 + 8 * (lane & 31);
    float sum[8], self[8];
#pragma unroll
    for (int j = 0; j < 8; ++j) { self[j] = bf2f((bf16)v[0][j]); sum[j] = self[j]; }
#pragma unroll
    for (int tau = 1; tau < W; ++tau) { const float wgt = (t - tau >= 0) ? 1.f : 0.f;
#pragma unroll
        for (int j = 0; j < 8; ++j) sum[j] = fmaf(wgt, bf2f((bf16)v[tau][j]), sum[j]); }
    const float inv = 1.f / (float)((t + 1) < W ? (t + 1) : W);
    u32x4 o; o.x = cvt_pk_bf16(sum[0] * inv - self[0], sum[1] * inv - self[1]); o.y = cvt_pk_bf16(sum[2] * inv - self[2], sum[3] * inv - self[3]);
    o.z = cvt_pk_bf16(sum[4] * inv - self[4], sum[5] * inv - self[5]); o.w = cvt_pk_bf16(sum[6] * inv - self[6], sum[7] * inv - self[7]);
    *(u32x4*)(F.CAT + (size_t)m * DM + c0) = o;
}
__device__ __forceinline__ void p3_window(Frame& F) {
    const int gw = F.bid * NWAVES + F.wave, NGW = F.G * NWAVES, lane = F.lane;
    for (int tp = gw; tp < NTOK / 2; tp += NGW) {
        bf16x8 v2[2], v4[4], v8[8], v16[16];
        p3_window_load<2>(F, 0, tp, lane, v2); p3_window_load<4>(F, 1, tp, lane, v4); p3_window_load<8>(F, 2, tp, lane, v8); p3_window_load<16>(F, 3, tp, lane, v16);
        p3_window_finish<2>(F, 0, tp, lane, v2); p3_window_finish<4>(F, 1, tp, lane, v4); p3_window_finish<8>(F, 2, tp, lane, v8); p3_window_finish<16>(F, 3, tp, lane, v16);
    }
}
__device__ __forceinline__ int half_sum32(int v) {
    v += __builtin_amdgcn_update_dpp(0, v, 0x128, 0xf, 0xf, false);
    v += __builtin_amdgcn_update_dpp(0, v, 0x124, 0xf, 0xf, false);
    v += __builtin_amdgcn_update_dpp(0, v, 0x122, 0xf, 0xf, false);
    v += __builtin_amdgcn_update_dpp(0, v, 0x121, 0xf, 0xf, false);
    v += __shfl_xor(v, 16);
    return v;
}
__device__ __forceinline__ float half_max32(float v) {
    v = fmaxf(v, __builtin_bit_cast(float, __builtin_amdgcn_update_dpp(0, __builtin_bit_cast(int, v), 0x128, 0xf, 0xf, false)));
    v = fmaxf(v, __builtin_bit_cast(float, __builtin_amdgcn_update_dpp(0, __builtin_bit_cast(int, v), 0x124, 0xf, 0xf, false)));
    v = fmaxf(v, __builtin_bit_cast(float, __builtin_amdgcn_update_dpp(0, __builtin_bit_cast(int, v), 0x122, 0xf, 0xf, false)));
    v = fmaxf(v, __builtin_bit_cast(float, __builtin_amdgcn_update_dpp(0, __builtin_bit_cast(int, v), 0x121, 0xf, 0xf, false)));
    v = fmaxf(v, __shfl_xor(v, 16));
    return v;
}
typedef short s16x2_t __attribute__((ext_vector_type(2)));
typedef float f32x2_t __attribute__((ext_vector_type(2)));
typedef __bf16 bf16x2_t __attribute__((ext_vector_type(2)));
__device__ __forceinline__ unsigned cvt_pk_bf16_v(float lo, float hi) { const f32x2_t v = {lo, hi}; return __builtin_bit_cast(unsigned, __builtin_convertvector(v, bf16x2_t)); }
__device__ __forceinline__ unsigned relu_pk(unsigned p) { s16x2_t v = __builtin_bit_cast(s16x2_t, p); v = __builtin_elementwise_max(v, (s16x2_t){0, 0}); return __builtin_bit_cast(unsigned, v); }
__device__ __forceinline__ float relu_asm(float x) { const int i = __builtin_bit_cast(int, x); return __builtin_bit_cast(float, i > 0 ? i : 0); }
constexpr int IDX_CH = 512;
__device__ __forceinline__ void p3_indexer_item(Frame& F, int conv_it, const bf16* Pb, unsigned* Mb, int tb, LAS unsigned char* kl, int tid, int wave, int lane) {
    asm volatile("" : "+v"(lane), "+v"(tid));
    const int r = lane & 31, hi = lane >> 5, t0 = tb + 2 * wave, ktd = t0 >> 5, tq = t0 + hi;
    const int nch = ((tb + 15) / IDX_CH) + 1;
    const GAS char* Pc = (const GAS char*)Pb;
    const unsigned srow = (unsigned)(tid >> 3), sch = (unsigned)(tid & 7);
    const unsigned sgo = (srow * PLD + C_KI + sch * 8) * 2u;
    const unsigned slo = srow * 128u + ((sch ^ ((srow >> 1) & 7u)) * 16u);
    bf16x8 stg[8];
#define IDX_LOAD(c) do { _Pragma("unroll") for (int i = 0; i < 8; ++i) { const GAS char* bp_ = Pc + (size_t)((c) * IDX_CH + 64 * i) * (PLD * 2); asm volatile("" : "+s"(bp_)); \
        stg[i] = *(const GAS bf16x8*)(bp_ + sgo); } } while (0)
    IDX_LOAD(0);
    bf16x8 aq[4];
    { const unsigned qoff = (unsigned)((t0 + (r >> 4)) * PLD + C_QI + (r & 15) * 64 + 8 * hi) * 2u;
#pragma unroll
      for (int j = 0; j < 4; ++j) aq[j] = *(const GAS bf16x8*)(Pc + qoff + 32 * j); }
    bf16x8 a0, a1;
    { const GAS char* w0p = Pc + (size_t)t0 * (PLD * 2) + (C_WI + 4 * hi) * 2; const GAS char* w1p = w0p + PLD * 2;
      const u32x2 x0 = *(const GAS u32x2*)w0p, x1 = *(const GAS u32x2*)(w0p + 16), y0 = *(const GAS u32x2*)w1p, y1 = *(const GAS u32x2*)(w1p + 16);
      u32x4 wa = {x0.x, x0.y, x1.x, x1.y}, wb = {y0.x, y0.y, y1.x, y1.y};
      if (r != 0) wa = (u32x4){0u, 0u, 0u, 0u};
      if (r != 4) wb = (u32x4){0u, 0u, 0u, 0u};
      a0 = *reinterpret_cast<bf16x8*>(&wa); a1 = *reinterpret_cast<bf16x8*>(&wb); }
    float key[64];
    float vmax = -__builtin_inff(), vmin = __builtin_inff(), s1 = 0.f, s2 = 0.f;
    unsigned kro[4];
#pragma unroll
    for (int j = 0; j < 4; ++j) kro[j] = (unsigned)r * 128u + ((((unsigned)(2 * j + hi)) ^ (((unsigned)r >> 1) & 7u)) * 16u);
    for (int crep = 0; crep < ((PROBE_DUP == 32) ? 2 : 1); ++crep) {
    if (crep) { IDX_LOAD(0); }
#pragma unroll
    for (int c = 0; c < SEQ / IDX_CH; ++c) {
        if (c < nch) {
            __syncthreads();
#pragma unroll
            for (int i = 0; i < 8; ++i) *(LAS bf16x8*)(kl + slo + i * 8192) = stg[i];
            __syncthreads();
            if (c + 1 < nch) IDX_LOAD(c + 1);
            if (c == 0 && crep == 0) {
                const int r_ = conv_it & 255; const GAS char* gsrc_ = (const GAS char*)(F.w_gate + (size_t)(conv_it >> 8) * DM * DEXP + (size_t)(128 * (r_ >> 4)) * DEXP + 32 * (r_ & 15))
                    + ((size_t)(16 * (lane >> 3)) * DEXP + (lane & 7) * 4) * 4;
#pragma unroll
                for (int i = 0; i < 8; ++i) { const GAS char* gp_ = gsrc_ + (size_t)i * (DEXP * 4); const unsigned la_ = (unsigned)(size_t)(kl + 65536 + wave * 8192 + i * 1024);
                    asm volatile("s_mov_b32 m0, %1\n\tglobal_load_lds_dwordx4 %0, off" :: "v"(gp_), "s"(la_) : "m0", "memory"); }
            }
#pragma unroll
            for (int g = 0; g < IDX_CH / 128; ++g) {
                const int kt0 = c * (IDX_CH / 32) + 4 * g;
                if (kt0 <= ktd) {
#define IDX_PACK(d, b0, b1) do { \
                        b0.x = relu_pk(cvt_pk_bf16_v(d[0], d[1])); b0.y = relu_pk(cvt_pk_bf16_v(d[2], d[3])); b0.z = relu_pk(cvt_pk_bf16_v(d[4], d[5])); b0.w = relu_pk(cvt_pk_bf16_v(d[6], d[7])); \
                        b1.x = relu_pk(cvt_pk_bf16_v(d[8], d[9])); b1.y = relu_pk(cvt_pk_bf16_v(d[10], d[11])); b1.z = relu_pk(cvt_pk_bf16_v(d[12], d[13])); b1.w = relu_pk(cvt_pk_bf16_v(d[14], d[15])); } while (0)
#define IDX_TAKE(kt, e) do { if ((kt) < ktd) { const float e0_ = e[0]; key[kt] = e0_; vmax = fmaxf(vmax, e0_); vmin = fminf(vmin, e0_); s1 += e0_; s2 = fmaf(e0_, e0_, s2); }   \
                        else { const bool ok = ((kt) * 32 + r <= tq); const float sv = ok ? e[0] : -__builtin_inff(); \
                        key[kt] = sv; vmax = fmaxf(vmax, sv); vmin = fminf(vmin, ok ? e[0] : __builtin_inff()); \
                        { const float z0 = ok ? e[0] : 0.f; s1 += z0; s2 = fmaf(z0, z0, s2); } } } while (0)
#define IDX_FRAGS(fr, tl) do { _Pragma("unroll") for (int j = 0; j < 4; ++j) { fr[j] = *(const LAS bf16x8*)((tl) + kro[j]); fr[4 + j] = *(const LAS bf16x8*)((tl) + 4096 + kro[j]); } } while (0)
#define IDX_SCORE(fr, dA, dB) do { _Pragma("unroll") for (int j = 0; j < 4; ++j) dA = __builtin_amdgcn_mfma_f32_32x32x16_bf16(aq[j], fr[j], dA, 0, 0, 0); \
                        _Pragma("unroll") for (int j = 0; j < 4; ++j) dB = __builtin_amdgcn_mfma_f32_32x32x16_bf16(aq[j], fr[4 + j], dB, 0, 0, 0); } while (0)
#define IDX_REDUCE(dA, dB, eA, eB) do { u32x4 b0, b1, c0, c1; \
                        IDX_PACK(dA, b0, b1); asm volatile("s_nop 1" ::: "memory"); \
                        eA = __builtin_amdgcn_mfma_f32_32x32x16_bf16(a0, *reinterpret_cast<bf16x8*>(&b0), eA, 0, 0, 0); \
                        eA = __builtin_amdgcn_mfma_f32_32x32x16_bf16(a1, *reinterpret_cast<bf16x8*>(&b1), eA, 0, 0, 0); \
                        IDX_PACK(dB, c0, c1); asm volatile("s_nop 1" ::: "memory"); \
                        eB = __builtin_amdgcn_mfma_f32_32x32x16_bf16(a0, *reinterpret_cast<bf16x8*>(&c0), eB, 0, 0, 0); \
                        eB = __builtin_amdgcn_mfma_f32_32x32x16_bf16(a1, *reinterpret_cast<bf16x8*>(&c1), eB, 0, 0, 0); } while (0)
                    {
                        const LAS unsigned char* tl = kl + (4 * g) * 4096;
                        bf16x8 fr[8];
                        IDX_FRAGS(fr, tl);
                        __builtin_amdgcn_sched_barrier(0);
                        f32x16 dA = {}, dB = {}, eA = {}, eB = {};
                        IDX_SCORE(fr, dA, dB);
                        __builtin_amdgcn_sched_barrier(0);
                        IDX_FRAGS(fr, tl + 8192);
                        IDX_REDUCE(dA, dB, eA, eB);
                        __builtin_amdgcn_sched_barrier(0);
                        IDX_TAKE(kt0, eA); IDX_TAKE(kt0 + 1, eB);
                        __builtin_amdgcn_sched_barrier(0);
                        f32x16 dC = {}, dD = {}, eC = {}, eD = {};
                        IDX_SCORE(fr, dC, dD);
                        __builtin_amdgcn_sched_barrier(0);
                        IDX_REDUCE(dC, dD, eC, eD);
                        __builtin_amdgcn_sched_barrier(0);
                        IDX_TAKE(kt0 + 2, eC); IDX_TAKE(kt0 + 3, eD);
                    }
#undef IDX_FRAGS
#undef IDX_SCORE
#undef IDX_REDUCE
#undef IDX_PACK
#undef IDX_TAKE
                } else {
#pragma unroll
                    for (int q = 0; q < 4; ++q) key[kt0 + q] = -__builtin_inff();
                }
            }
        } else {
#pragma unroll
            for (int q = 0; q < IDX_CH / 32; ++q) key[c * (IDX_CH / 32) + q] = -__builtin_inff();
        }
    }
    }
#undef IDX_LOAD
    int ln = lane; asm volatile("" : "+v"(ln));
    f32x4 cv[16];
    { const int r = conv_it & 255; const float* gsrc = F.w_gate + (size_t)(conv_it >> 8) * DM * DEXP + (size_t)(128 * (r >> 4)) * DEXP + 32 * (r & 15) + (size_t)(16 * (ln >> 3)) * DEXP + (ln & 7) * 4;
#pragma unroll
      for (int i = 8; i < 16; ++i) cv[i] = *(const f32x4*)(gsrc + (size_t)i * DEXP); }
    float T = -3.0e38f;
    const bool need = (tq + 1) > TOPK;
    for (int srep = 0; srep < ((PROBE_DUP == 31) ? 2 : 1); ++srep)
    if (__any(need)) {
#pragma unroll
        for (int o = 1; o < 32; o <<= 1) { vmax = fmaxf(vmax, __shfl_xor(vmax, o)); vmin = fminf(vmin, __shfl_xor(vmin, o)); s1 += __shfl_xor(s1, o); s2 += __shfl_xor(s2, o); }
        const float nf = (float)(tq + 1), mu = s1 / nf, sd = sqrtf(fmaxf(s2 / nf - mu * mu, 1e-20f));
        float zq; { const float pu = (float)TOPK / nf;
            const float q = fminf(pu, 1.f - pu), t = sqrtf(-2.f * __logf(fmaxf(q, 1e-6f)));
            const float zz = t - (2.515517f + t * (0.802853f + t * 0.010328f)) / (1.f + t * (1.432788f + t * (0.189269f + t * 0.001308f)));
            zq = (pu < 0.5f) ? zz : -zz; }
        const float dens = nf * 0.3989423f * __expf(-0.5f * zq * zq) / sd;
        float lo = vmin, hi = vmax, prev = mu + zq * sd, flo = (float)(tq + 1) - 255.5f, fhi = 1.f - 255.5f; int pcnt = TOPK, side = 0, chi = 1; bool done = !need;
        for (int it = 0; it < 96; ++it) {
            const float mid = 0.5f * lo + 0.5f * hi;
            float cand = ((it & 3) == 3) ? mid : lo + (hi - lo) * flo / (flo - fhi);
            if (it == 0) cand = prev;
            if (it == 1) cand = prev + ((float)(pcnt - TOPK) + 0.5f) / dens;
            if (!(cand > lo && cand < hi)) cand = mid;
            if (!(cand > lo && cand < hi)) done = true;
            if (__all(done)) break;
            int cnt = 0;
#pragma unroll
            for (int g = 0; g < 8; ++g) {
                if (8 * g <= ktd) {
#define CNT4(k0, k1, k2, k3) asm volatile("v_cmp_ge_f32_e64 s[88:89], %1, %5\n\tv_cmp_ge_f32_e64 s[90:91], %2, %5\n\tv_cmp_ge_f32_e64 s[92:93], %3, %5\n\tv_cmp_ge_f32_e64 s[94:95], %4, %5\n\t" \
                        "v_addc_co_u32_e64 %0, s[88:89], 0, %0, s[88:89]\n\tv_addc_co_u32_e64 %0, s[90:91], 0, %0, s[90:91]\n\tv_addc_co_u32_e64 %0, s[92:93], 0, %0, s[92:93]\n\tv_addc_co_u32_e64 %0, s[94:95], 0, %0, s[94:95]" \
                        : "+v"(cnt) : "v"(k0), "v"(k1), "v"(k2), "v"(k3), "v"(cand) : "s88", "s89", "s90", "s91", "s92", "s93", "s94", "s95")
                    CNT4(key[8 * g + 0], key[8 * g + 1], key[8 * g + 2], key[8 * g + 3]);
                    CNT4(key[8 * g + 4], key[8 * g + 5], key[8 * g + 6], key[8 * g + 7]);
#undef CNT4
                }
            }
            cnt = half_sum32(cnt);
            if (!done) {
                if (cnt >= TOPK) { lo = cand; flo = (float)cnt - 255.5f; if (side == 1) fhi *= 0.5f; side = 1; }
                else { hi = cand; fhi = (float)cnt - 255.5f; chi = cnt; if (side == 2) flo *= 0.5f; side = 2; }
                if (cnt == TOPK) done = true; }
            prev = cand; pcnt = cnt;
            const bool snap = !done && chi == TOPK - 1;
            if (__any(snap)) {
                float m = -__builtin_inff();
#pragma unroll
                for (int g = 0; g < 8; ++g) {
                    if (8 * g <= ktd) {
#pragma unroll
                        for (int q = 0; q < 8; ++q) m = fmaxf(m, key[8 * g + q] < hi ? key[8 * g + q] : -__builtin_inff());
                    }
                }
                m = half_max32(m);
                if (snap) { lo = m; done = true; }
            }
        }
        if (need) T = lo;
    }
    unsigned mw0 = 0u, mw1 = 0u;
#pragma unroll
    for (int kt = 0; kt < 64; ++kt) {
        if (kt <= ktd) { const unsigned long long bal = __ballot(key[kt] >= T);
            const unsigned blo = (unsigned)bal, bhi = (unsigned)(bal >> 32);
            asm volatile("s_nop 4\n\tv_writelane_b32 %0, %2, %4\n\tv_writelane_b32 %1, %3, %4" : "+v"(mw0), "+v"(mw1) : "s"(blo), "s"(bhi), "n"(kt)); }
    }
    Mb[(size_t)t0 * 64 + ln] = mw0; Mb[(size_t)(t0 + 1) * 64 + ln] = mw1;
    { P0Tile t; const int r = conv_it & 255; t.src = nullptr; t.ld_src = DEXP; t.k0 = 128 * (r >> 4); t.n0 = 32 * (r & 15); t.nvalid = DEXP; t.dst = (unsigned char*)F.Wgu + (size_t)(conv_it >> 8) * 1024 * DM; t.ld_dst = DM;
      t.himul = 256; t.radd = 0; t.fp8 = 1; t.scale = WGU_SCALE;
      asm volatile("s_waitcnt vmcnt(0)" ::: "memory");
#pragma unroll
      for (int i = 0; i < 8; ++i) cv[i] = *(const LAS f32x4*)(kl + 65536 + wave * 8192 + i * 1024 + ln * 16);
      u32x4 co[8]; p0_tile_pack(t, cv, co); p0_tile_store(t, co, ln); }
}
__device__ __forceinline__ void p3_indexer(Frame& F) {
    for (int wgi = F.vcu; wgi < 256; wgi += F.G) {
        const int b = wgi >> 5, j = wgi & 31;
#pragma unroll 1
        for (int s = 0; s < 4; ++s) { const int q16 = (s == 0) ? j : (s == 1) ? 63 - j : (s == 2) ? 64 + j : 127 - j;
            p3_indexer_item(F, (wgi * 4 + s) * NWAVES + F.wave, F.P + (size_t)b * SEQ * PLD, F.MASK + (size_t)b * SEQ * 64, q16 * 16, F.lds, F.tid, F.wave, F.lane); }
    }
}

namespace att {
constexpr int D = 128, QBLK = 32, KVBLK = 64, QB = 256;
constexpr int SHM_V = KVBLK * D * 2, SHM_K = KVBLK * D * 2;
constexpr int ATT_LDS = 2 * SHM_V + 2 * SHM_K + NWAVES * 64 * 4;
constexpr float SCALE = 0.08838834764831845f, THR = 8.f;
constexpr int RMAX = 207, NBIAS = 304;
#define KSWZ(row, colB) ((row) * 256 + ((colB) ^ (((row) & 7) << 4)))
#define SBAR() __builtin_amdgcn_sched_barrier(0)
__device__ __forceinline__ int v_st(int k, int c) { const int kk = (k & ~0xC) | ((k & 4) << 1) | ((k & 8) >> 1); return ((kk >> 3) * 4 + (c >> 5)) * 512 + ((kk & 7) * 32 + (c & 31)) * 2; }
__device__ __forceinline__ int v_rd_base(int lane) { return ((lane & 3) << 3) | (((lane >> 2) & 3) << 6) | (((lane >> 4) & 1) << 5) | (((lane >> 5) & 1) << 8); }
constexpr int v_rd_off(int d0, int ks, int half) { return d0 * 512 + ks * 4096 + half * 2048; }
__device__ __forceinline__ int crow(int r, int hi) { return (r & 3) + 8 * (r >> 2) + 4 * hi; }

__device__ __forceinline__ void mask_bias_tile(f32x16& p0, f32x16& p1, u32x2 mk, int hi, bool near, const LAS float* tb) {
    const float NEG = -__builtin_inff();
    const unsigned w0 = mk.x >> (4 * hi), w1 = mk.y >> (4 * hi);
    if (near) {
#pragma unroll
        for (int r = 0; r < 16; ++r) { const int c = (r & 3) + 8 * (r >> 2); p0[r] += tb[c]; p1[r] += tb[c + 32]; }
    }
    const int negb = __float_as_int(NEG);
#pragma unroll
    for (int r = 0; r < 16; ++r) { const int c = (r & 3) + 8 * (r >> 2);
        const int m0 = __builtin_amdgcn_sbfe((int)w0, c, 1), m1 = __builtin_amdgcn_sbfe((int)w1, c, 1);
        const float x0 = p0[r], x1 = p1[r];
        p0[r] = __int_as_float((__float_as_int(x0) & m0) | (negb & ~m0));
        p1[r] = __int_as_float((__float_as_int(x1) & m1) | (negb & ~m1)); }
}
__device__ __forceinline__ void partialSM(f32x16& p0, f32x16& p1, float& m_reg, float& mn, float& alpha) {
    float pmax = p0[0];
#pragma unroll
    for (int r = 1; r < 16; ++r) pmax = fmaxf(pmax, p0[r]);
#pragma unroll
    for (int r = 0; r < 16; ++r) pmax = fmaxf(pmax, p1[r]);
    { auto rr = __builtin_amdgcn_permlane32_swap(__float_as_uint(pmax), __float_as_uint(pmax), false, false);
      pmax = fmaxf(__uint_as_float(rr[0]), __uint_as_float(rr[1])); }
    constexpr float C2 = 1.4426950408889634f * SCALE;
    if (__builtin_expect(__all((pmax - m_reg) * SCALE <= THR), 1)) { mn = m_reg; alpha = 1.f; }
    else { mn = fmaxf(m_reg, pmax); alpha = __builtin_amdgcn_exp2f((m_reg - mn) * C2); m_reg = mn; }
    const float mnL = -mn * C2;
#pragma unroll
    for (int r = 0; r < 16; ++r) p0[r] = fmaf(p0[r], C2, mnL);
#pragma unroll
    for (int r = 0; r < 16; ++r) p1[r] = fmaf(p1[r], C2, mnL);
#pragma unroll
    for (int r = 0; r < 16; ++r) p0[r] = __builtin_amdgcn_exp2f(p0[r]);
}
__device__ __forceinline__ void finishSM(f32x16& p0, f32x16& p1, float alpha, float& l_reg, bf16x8& pa0, bf16x8& pa1, bf16x8& pa2, bf16x8& pa3) {
#pragma unroll
    for (int r = 0; r < 16; ++r) p1[r] = __builtin_amdgcn_exp2f(p1[r]);
    float ps = 0;
#pragma unroll
    for (int r = 0; r < 16; ++r) ps += p0[r];
#pragma unroll
    for (int r = 0; r < 16; ++r) ps += p1[r];
    { auto rr = __builtin_amdgcn_permlane32_swap(__float_as_uint(ps), __float_as_uint(ps), false, false);
      ps = __uint_as_float(rr[0]) + __uint_as_float(rr[1]); }
    l_reg = l_reg * alpha + ps;
#define PK4(P, B_, OUT) do { unsigned a0 = cvt_pk_bf16(P[B_+0], P[B_+1]), a1 = cvt_pk_bf16(P[B_+2], P[B_+3]);                          \
        unsigned b0 = cvt_pk_bf16(P[B_+4], P[B_+5]), b1 = cvt_pk_bf16(P[B_+6], P[B_+7]);                                             \
        auto r0 = __builtin_amdgcn_permlane32_swap(a0, b0, false, false); auto r1 = __builtin_amdgcn_permlane32_swap(a1, b1, false, false); \
        u32x4 w = {r0[0], r1[0], r0[1], r1[1]}; OUT = *reinterpret_cast<bf16x8*>(&w); } while (0)
    PK4(p0, 0, pa0); PK4(p0, 8, pa1); PK4(p1, 0, pa2); PK4(p1, 8, pa3);
#undef PK4
}
template <int KB>
__device__ __forceinline__ void qkt(f32x16& p0, f32x16& p1, const char* K_lds, const char* Qw, int r32, int hi) {
    p0 = f32x16{}; p1 = f32x16{};
    const char* kb[4]; const char* qb[4];
#pragma unroll
    for (int dd = 0; dd < 4; ++dd) { kb[dd] = K_lds + KB * SHM_K + KSWZ(r32, (dd * 16 + hi * 8) * 2); qb[dd] = Qw + KSWZ(r32, (dd * 16 + hi * 8) * 2); }
#pragma unroll
    for (int d0 = 0; d0 < 8; ++d0) { const char* a = kb[d0 & 3] + (d0 >> 2) * 128;
        bf16x8 b0 = *reinterpret_cast<const bf16x8*>(a);
        bf16x8 b1 = *reinterpret_cast<const bf16x8*>(a + 32 * 256);
        bf16x8 q = *reinterpret_cast<const bf16x8*>(qb[d0 & 3] + (d0 >> 2) * 128);
        p0 = __builtin_amdgcn_mfma_f32_32x32x16_bf16(b0, q, p0, 0, 0, 0);
        p1 = __builtin_amdgcn_mfma_f32_32x32x16_bf16(b1, q, p1, 0, 0, 0); }
    __builtin_amdgcn_sched_group_barrier(0x100, 3, 0);
#pragma unroll
    for (int d0 = 0; d0 < 7; ++d0) { __builtin_amdgcn_sched_group_barrier(0x100, 3, 0); __builtin_amdgcn_sched_group_barrier(0x008, 2, 0); }
    __builtin_amdgcn_sched_group_barrier(0x008, 2, 0);
}
template <int VB>
__device__ __forceinline__ void pv_tile(f32x16* o, int vb0, bf16x8 pa0, bf16x8 pa1, bf16x8 pa2, bf16x8 pa3) {
#define TRRD(dst, off) asm volatile("ds_read_b64_tr_b16 %0, %1 offset:%2" : "=&v"(dst) : "v"(vb0), "i"(off) : "memory")
#define PV_D0(d0) do { s16x4 l0, l1, l2, l3, h0, h1, h2, h3; constexpr int b_ = VB * SHM_V + v_rd_off(d0, 0, 0); \
        TRRD(l0, b_); TRRD(h0, b_ + 2048); TRRD(l1, b_ + 4096); TRRD(h1, b_ + 6144); TRRD(l2, b_ + 8192); TRRD(h2, b_ + 10240); TRRD(l3, b_ + 12288); TRRD(h3, b_ + 14336); \
        asm volatile("s_waitcnt lgkmcnt(0)" ::: "memory"); SBAR();   \
        o[d0] = __builtin_amdgcn_mfma_f32_32x32x16_bf16(pa0, (bf16x8){l0[0], l0[1], l0[2], l0[3], h0[0], h0[1], h0[2], h0[3]}, o[d0], 0, 0, 0);   \
        o[d0] = __builtin_amdgcn_mfma_f32_32x32x16_bf16(pa1, (bf16x8){l1[0], l1[1], l1[2], l1[3], h1[0], h1[1], h1[2], h1[3]}, o[d0], 0, 0, 0);   \
        o[d0] = __builtin_amdgcn_mfma_f32_32x32x16_bf16(pa2, (bf16x8){l2[0], l2[1], l2[2], l2[3], h2[0], h2[1], h2[2], h2[3]}, o[d0], 0, 0, 0);   \
        o[d0] = __builtin_amdgcn_mfma_f32_32x32x16_bf16(pa3, (bf16x8){l3[0], l3[1], l3[2], l3[3], h3[0], h3[1], h3[2], h3[3]}, o[d0], 0, 0, 0); } while (0)
    PV_D0(0); PV_D0(1); PV_D0(2); PV_D0(3);
#undef PV_D0
#undef TRRD
}
struct BlockRef { const bf16* Q; const bf16* K; bf16* O; const unsigned* M; int P0; };
struct Seam { bf16x8 st_v0, st_v1, st_k0, st_k1; u32x2 mkA; };
constexpr int Q_OFF = 2 * SHM_V + 2 * SHM_K + NWAVES * 64 * 4;
constexpr int ATT_LDS_ALL = Q_OFF + NWAVES * 8192;
#define VMW() asm volatile("s_waitcnt vmcnt(0)" ::: "memory")
#define KVROW (PLD * 2)
#define SLOAD_H(Kp, k0) do { const char* kt_ = (const char*)(Kp) + (size_t)(k0) * KVROW; \
        S.st_k0 = *(const bf16x8*)(kt_ + kvo); S.st_k1 = *(const bf16x8*)(kt_ + 32 * KVROW + kvo); \
        S.st_v0 = *(const bf16x8*)(kt_ + (C_V - C_K) * 2 + kvo); S.st_v1 = *(const bf16x8*)(kt_ + 32 * KVROW + (C_V - C_K) * 2 + kvo); } while (0)
#define SWRITE_HK(bf) do { *(bf16x8*)(K_lds + (bf) * SHM_K + kws) = S.st_k0; *(bf16x8*)(K_lds + (bf) * SHM_K + kws + 32 * 256) = S.st_k1; } while (0)
#define SWRITE_HV(bf) do { *(bf16x8*)(V_lds + (bf) * SHM_V + vst0) = S.st_v0; *(bf16x8*)(V_lds + (bf) * SHM_V + vst1) = S.st_v1; } while (0)
#define SWRITE_H(bf) do { SWRITE_HV(bf); SWRITE_HK(bf); } while (0)
#define MLOAD(ref, tile) (*(const u32x2*)((const char*)((ref).M + (size_t)wid * QBLK * 64 + 2 * (tile)) + mro))
__device__ __forceinline__ void attn_prime(const BlockRef& cur, char* lds, Seam& S, const int wid, const int lane) {
    const int tid = wid * 64 + lane, r32 = lane & 31;
    const int sr = tid >> 4, sc = (tid & 15) * 8, kws = KSWZ(sr, sc * 2); char* K_lds = lds + 2 * SHM_V;
    const unsigned kvo = (unsigned)(sr * PLD + sc) * 2u, mro = (unsigned)r32 * 256u;
    SLOAD_H(cur.K, 0); S.mkA = MLOAD(cur, 0); VMW(); SWRITE_HK(0);
    __syncthreads();
}
__device__ __forceinline__ void attn_block(const BlockRef& cur, const BlockRef& nxt, char* lds, const LAS float* btab, Seam& S, const int wid, const int lane) {
    const int tid = wid * 64 + lane, r32 = lane & 31, hi = lane >> 5;
    const int NT = (cur.P0 + QB - 1) / KVBLK + 1;
    const int qlo = cur.P0 + wid * QBLK, pos = qlo + r32;
    char* V_lds = lds; char* K_lds = lds + 2 * SHM_V; char* Qw = lds + Q_OFF + wid * 8192;
    float* ws = (float*)(lds + 2 * SHM_V + 2 * SHM_K) + wid * 64; float* li_l = ws, * al_l = ws + 32;
    float m_reg = -1e30f, l_reg = 0; f32x16 o[4] = {};
    const int sr = tid >> 4, sc = (tid & 15) * 8, vst0 = v_st(sr, sc), vst1 = v_st(32 + sr, sc), kws = KSWZ(sr, sc * 2);
    const unsigned kvo = (unsigned)(sr * PLD + sc) * 2u, mro = (unsigned)r32 * 256u;
    const int vb0 = (int)(uintptr_t)V_lds + v_rd_base(lane);
    const bf16* Kh = cur.K;
    u32x2 mkA = S.mkA, mkB = (u32x2){0u, 0u};
    {
        const char* qg = (const char*)(cur.Q + (size_t)wid * QBLK * PLD) + (unsigned)(r32 * PLD + hi * 8) * 2u;
        bf16x8 qv[8];
#pragma unroll
        for (int d0 = 0; d0 < 8; ++d0) qv[d0] = *(const bf16x8*)(qg + d0 * 32);
#pragma unroll
        for (int d0 = 0; d0 < 8; ++d0) *(bf16x8*)(Qw + KSWZ(r32, (d0 * 16 + hi * 8) * 2)) = qv[d0];
        asm volatile("s_waitcnt lgkmcnt(0)" ::: "memory");
    }
#define RESC(a) do { if (__any((a) < 1.f)) { if (hi == 0) al_l[r32] = (a); asm volatile("s_waitcnt lgkmcnt(0)" ::: "memory");              \
                     for (int d_ = 0; d_ < 4; ++d_) for (int r = 0; r < 16; ++r) o[d_][r] *= al_l[crow(r, hi)]; } } while (0)
#define KBASE(t) ((t) * KVBLK)
#define MASKT(P0_, P1_, mk, t) do { const int kb_ = KBASE(t); const bool near_ = (kb_ <= qlo + QBLK - 1) && (kb_ > qlo - 176); \
        mask_bias_tile(P0_, P1_, mk, hi, near_, btab + (RMAX - (pos - kb_ - 4 * hi))); } while (0)
    f32x16 pA0, pA1, pB0, pB1; float mnA, mnB, alA, alB; bf16x8 pa0, pa1, pa2, pa3;
    SWRITE_HV(0); SBAR();
    if (NT > 1) { SLOAD_H(Kh, KBASE(1)); mkB = MLOAD(cur, 1); }
    SBAR(); qkt<0>(pA0, pA1, K_lds, Qw, r32, hi);
    MASKT(pA0, pA1, mkA, 0); partialSM(pA0, pA1, m_reg, mnA, alA);
    if (NT > 1) { VMW(); SWRITE_H(1); }
    __syncthreads();
#define HALF_STEP(PX0, PX1, mnX, alX, mkX, PY0, PY1, alY, mkY, t, KB, VB, SB) do {                                                      \
        SBAR(); qkt<KB>(PX0, PX1, K_lds, Qw, r32, hi);                                             \
        finishSM(PY0, PY1, alY, l_reg, pa0, pa1, pa2, pa3); SBAR();                                                           \
        if ((t) + 1 < NT) { SLOAD_H(Kh, KBASE((t) + 1)); mkY = MLOAD(cur, (t) + 1); SBAR(); }                                               \
        pv_tile<VB>(o, vb0, pa0, pa1, pa2, pa3); MASKT(PX0, PX1, mkX, (t)); partialSM(PX0, PX1, m_reg, mnX, alX);                                        \
        __syncthreads();                                                                                                      \
        if ((t) + 1 < NT) { VMW(); SWRITE_H(SB); }                                                                          \
        RESC(alX); __syncthreads(); } while (0)
    for (int t = 1; t + 1 < NT; t += 2) {
        HALF_STEP(pB0, pB1, mnB, alB, mkB, pA0, pA1, alA, mkA, t, 1, 0, 0);
        HALF_STEP(pA0, pA1, mnA, alA, mkA, pB0, pB1, alB, mkB, t + 1, 0, 1, 1);
    }
    const bool even = (NT & 1) == 0;
    if (even) { SBAR(); qkt<1>(pB0, pB1, K_lds, Qw, r32, hi); SBAR(); }
    SLOAD_H(nxt.K, 0); mkA = MLOAD(nxt, 0); SBAR();
    finishSM(pA0, pA1, alA, l_reg, pa0, pa1, pa2, pa3); SBAR();
    pv_tile<0>(o, vb0, pa0, pa1, pa2, pa3);
    if (even) { MASKT(pB0, pB1, mkB, NT - 1); partialSM(pB0, pB1, m_reg, mnB, alB); __syncthreads(); RESC(alB);
        finishSM(pB0, pB1, alB, l_reg, pa0, pa1, pa2, pa3); SBAR(); pv_tile<1>(o, vb0, pa0, pa1, pa2, pa3); }
    SBAR(); VMW(); SWRITE_HK(0); SBAR();
    S.mkA = mkA;
    if (hi == 0) li_l[r32] = l_reg; asm volatile("s_waitcnt lgkmcnt(0)" ::: "memory");
    float rli[16];
#pragma unroll
    for (int r = 0; r < 16; ++r) rli[r] = __builtin_amdgcn_rcpf(li_l[crow(r, hi)]);
    {
        bf16* ol = (bf16*)Qw;
#pragma unroll
        for (int r = 0; r < 16; ++r) { const int orow = crow(r, hi);
#pragma unroll
            for (int d0 = 0; d0 < 4; ++d0) ol[orow * D + d0 * 32 + r32] = (bf16)(cvt_pk_bf16(o[d0][r] * rli[r], 0.f) & 0xffffu); }
        asm volatile("s_waitcnt lgkmcnt(0)" ::: "memory");
        char* Ob = (char*)(cur.O + (size_t)(wid * QBLK) * DM);
        const unsigned ovo = (unsigned)((lane >> 4) * (DM * 2) + (lane & 15) * 16);
#pragma unroll
        for (int i = 0; i < 8; ++i) { const u32x4 w = *(const u32x4*)(Qw + i * 1024 + lane * 16);
            GAS char* Obi = (GAS char*)(Ob + (size_t)i * (4 * DM * 2)); asm volatile("" : "+s"(Obi));
            *(GAS u32x4*)(Obi + ovo) = w; }
        asm volatile("s_waitcnt lgkmcnt(0)" ::: "memory");
    }
    __syncthreads();
#undef RESC
#undef KBASE
#undef MASKT
#undef HALF_STEP
}
#undef VMW
#undef SLOAD_H
#undef SWRITE_HK
#undef SWRITE_HV
#undef SWRITE_H
#undef MLOAD
#undef KVROW
}

__device__ __forceinline__ int t5_bucket(int rel) {
    if (rel < 16) return rel;
    int v = 16 + (int)(logf((float)rel / 16.f) / logf(8.f) * 16.f);
    return v < 31 ? v : 31;
}
__device__ __forceinline__ att::BlockRef p4_ref(Frame& F, int it, int pass) {
    const int b = it >> 5, h = (it >> 2) & 7, p = it & 3, kvh = h >> 2, qb = pass ? 7 - p : p;
    const bf16* Pb = F.P + (size_t)b * SEQ * PLD;
    att::BlockRef r; r.P0 = qb * 256;
    r.Q = Pb + (size_t)r.P0 * PLD + C_Q + h * HD; r.K = Pb + C_K + kvh * HD;
    r.O = F.CAT + (size_t)(b * SEQ + r.P0) * DM + POOLW + h * HD; r.M = F.MASK + (size_t)(b * SEQ + r.P0) * 64;
    return r;
}
__device__ __forceinline__ void p4_attention(Frame& F, int nitems) {
    LAS float* btab = (LAS float*)(F.lds + MISC_BASE + MO_BIAS);
    char* lds = (char*)F.lds;
    int it = F.vcu, pass = 0;
    if (it >= nitems) return;
    att::Seam S;
    { const att::BlockRef c0 = p4_ref(F, it & 255, 0); att::attn_prime(c0, lds, S, F.wave, F.lane); }
    for (;;) {
        if (pass == 0) {
            const int h = (it >> 2) & 7;
            __syncthreads();
            for (int i = F.tid; i < att::NBIAS; i += NTHR) { const int rel = att::RMAX - i; float v = 0.f;
                if (rel >= 0) v = (F.rel_bias[t5_bucket(rel) * NHEAD + h] - F.rel_bias[31 * NHEAD + h]) * (1.f / att::SCALE);
                btab[i] = v; }
            __syncthreads();
        }
        const bool more_item = it + F.G < nitems, last = (pass == 1) && !more_item;
        const int itn = (pass == 0) ? it : (more_item ? it + F.G : it), passn = (pass == 0) ? 1 : (more_item ? 0 : 1);
        const att::BlockRef cur = p4_ref(F, it & 255, pass), nxt = p4_ref(F, itn & 255, passn);
        att::attn_block(cur, nxt, lds, btab, S, F.wave, F.lane);
        if (last) break;
        it = itn; pass = passn;
    }
}

constexpr int P6_ROWS = 32, P6_PITCH = 4112;
constexpr int P6_LOG = P6_ROWS * P6_PITCH;
static_assert(P6_LOG + P6_ROWS * 48 * 4 <= MISC_BASE, "P6 LDS");
__device__ __forceinline__ void p6_route(Frame& F, const LAS float* lg, int m) {
    float gmax = lg[0] + F.b_group[0]; int gsel = 0;
#pragma unroll
    for (int i = 1; i < NGRP; ++i) { const float v = lg[i] + F.b_group[i]; if (v > gmax) { gmax = v; gsel = i; } }
    float gz = 0.f;
#pragma unroll
    for (int i = 0; i < NGRP; ++i) gz += __expf(lg[i] + F.b_group[i] - gmax);
    const float pg = 1.f / gz;
    float e1v = -3.0e38f, e2v = -3.0e38f; int i1 = 0, i2 = 0;
#pragma unroll
    for (int i = 0; i < EPG; ++i) { const float v = lg[4 + gsel * EPG + i] + F.b_router[gsel * EPG + i];
        if (v > e1v) { e2v = e1v; i2 = i1; e1v = v; i1 = i; } else if (v > e2v) { e2v = v; i2 = i; } }
    const float w1 = 1.f / (1.f + __expf(e2v - e1v)), w2 = 1.f - w1;
    const int ex1 = gsel * EPG + i1, ex2 = gsel * EPG + i2;
    const unsigned p1 = atomicAdd(F.ctl + CW_ECNT + 16 * ex1, 1u), p2 = atomicAdd(F.ctl + CW_ECNT + 16 * ex2, 1u);
    F.TOKLIST[ex1 * NTOK + (int)p1] = m; F.TOKLIST[ex2 * NTOK + (int)p2] = m;
    unsigned* ti = F.TOKINFO + (size_t)m * 8;
    ti[0] = (unsigned)ex1; ti[1] = p1; ti[2] = (unsigned)ex2; ti[3] = p2; ti[4] = __float_as_uint(pg * w1); ti[5] = __float_as_uint(pg * w2);
}
__device__ __forceinline__ void p6_norm_router(Frame& F, bool route) {
    LAS unsigned char* tile = F.lds;
    LAS float* logit = (LAS float*)(F.lds + P6_LOG);
    const int lane = F.lane, wave = F.wave, fr = lane & 15, fq = lane >> 4;
    int prev_m0 = -1;
    for (int grp = F.bid; grp < NTOK / P6_ROWS; grp += F.G) {
        const int m0 = grp * P6_ROWS, b = m0 / SEQ;
        const float* modb = F.mod + (size_t)b * (6 * DM);
        u32x2 xb[4][8];
#pragma unroll
        for (int rr = 0; rr < 4; ++rr)
#pragma unroll
            for (int j = 0; j < 8; ++j) xb[rr][j] = *(const u32x2*)(F.X1 + (size_t)(m0 + 4 * wave + rr) * DM + 256 * j + 4 * lane);
        f32x4 gs[8], sh[8];
#pragma unroll
        for (int j = 0; j < 8; ++j) { const int col = 256 * j + 4 * lane; const f32x4 g = *(const f32x4*)(F.g_ffn + col), sc = *(const f32x4*)(modb + 4 * DM + col);
            gs[j] = g * (sc + 1.f); sh[j] = *(const f32x4*)(modb + 3 * DM + col); }
        if (route && prev_m0 >= 0 && lane < 4) p6_route(F, logit + (4 * wave + lane) * 48, prev_m0 + 4 * wave + lane);
#pragma unroll
        for (int rr = 0; rr < 4; ++rr) {
            const int lr = 4 * wave + rr, m = m0 + lr;
            f32x4 v[8]; float s = 0.f;
#pragma unroll
            for (int j = 0; j < 8; ++j) { const u32x2 q = xb[rr][j];
                v[j][0] = __uint_as_float(q.x << 16); v[j][1] = __uint_as_float(q.x & 0xffff0000u); v[j][2] = __uint_as_float(q.y << 16); v[j][3] = __uint_as_float(q.y & 0xffff0000u);
                s += (v[j][0] * v[j][0] + v[j][1] * v[j][1]) + (v[j][2] * v[j][2] + v[j][3] * v[j][3]); }
            const float rstd = 1.f / sqrtf(wave_sum(s) * (1.f / DM) + EPS);
            unsigned char* orow = (unsigned char*)F.H + (size_t)m * DM;
#pragma unroll
            for (int j = 0; j < 8; ++j) { const f32x4 y = v[j] * rstd * gs[j] + sh[j];
                u32x2 o; o.x = cvt_pk_bf16(y[0], y[1]); o.y = cvt_pk_bf16(y[2], y[3]);
                *(unsigned*)(orow + 256 * j + 4 * lane) = pk4_fp8(y[0], y[1], y[2], y[3]);
                *(LAS u32x2*)(tile + lr * P6_PITCH + (256 * j + 4 * lane) * 2) = o; }
        }
        __syncthreads();
        if (wave < 6) {
            const int rb = wave / 3, nb = wave - 3 * rb;
            f32x4 acc = (f32x4){0.f, 0.f, 0.f, 0.f};
            const LAS unsigned char* ap = tile + (rb * 16 + fr) * P6_PITCH + 16 * fq;
            const bf16* bp = F.RW + (size_t)(nb * 16 + fr) * DM + 8 * fq;
#pragma unroll 16
            for (int ks = 0; ks < 64; ++ks) acc = __builtin_amdgcn_mfma_f32_16x16x32_bf16(*(const LAS bf16x8*)(ap + 64 * ks), *(const bf16x8*)(bp + 32 * ks), acc, 0, 0, 0);
#pragma unroll
            for (int j = 0; j < 4; ++j) logit[(rb * 16 + 4 * fq + j) * 48 + nb * 16 + fr] = acc[j];
        }
        __syncthreads();
        prev_m0 = m0;
    }
    if (route && prev_m0 >= 0 && lane < 4) p6_route(F, logit + (4 * wave + lane) * 48, prev_m0 + 4 * wave + lane);
}
constexpr int S6_ROWS = 16, S6_LOG = S6_ROWS * P6_PITCH, S6_CTR = 69120, S6_SCR_HI = 69632;
static_assert(S6_LOG + S6_ROWS * 48 * 4 <= S6_CTR && S6_SCR_HI + 4 * 16640 <= MISC_BASE, "side-by-side LDS map");
__device__ __forceinline__ void bar4(volatile LAS unsigned* cnt, unsigned& target, int lane) {
    asm volatile("s_waitcnt lgkmcnt(0)" ::: "memory");
    target += 4u;
    if (lane == 0) (void)__hip_atomic_fetch_add((LAS unsigned*)cnt, 1u, __ATOMIC_RELAXED, __HIP_MEMORY_SCOPE_WORKGROUP);
    while (*cnt < target) __builtin_amdgcn_s_sleep(1);
    asm volatile("" ::: "memory");
}
__device__ __forceinline__ void s6_router(Frame& F, volatile LAS unsigned* bcnt) {
    LAS unsigned char* tile = F.lds;
    LAS float* logit = (LAS float*)(F.lds + S6_LOG);
    const int lane = F.lane, wave = F.wave, fr = lane & 15, fq = lane >> 4;
    unsigned btarget = 0u; int prev_m0 = -1;
    u32x2 xb[4][8];
#define S6_LOADX(g_) do { _Pragma("unroll") for (int rr = 0; rr < 4; ++rr) _Pragma("unroll") for (int j = 0; j < 8; ++j) \
        xb[rr][j] = *(const u32x2*)(F.X1 + (size_t)((g_) * S6_ROWS + 4 * wave + rr) * DM + 256 * j + 4 * lane); } while (0)
    if (F.bid < NTOK / S6_ROWS) S6_LOADX(F.bid);
    for (int grp = F.bid; grp < NTOK / S6_ROWS; grp += F.G) {
        const int m0 = grp * S6_ROWS, b = m0 / SEQ;
        const float* modb = F.mod + (size_t)b * (6 * DM);
        f32x4 gs[8], sh[8];
#pragma unroll
        for (int j = 0; j < 8; ++j) { const int col = 256 * j + 4 * lane; const f32x4 g = *(const f32x4*)(F.g_ffn + col), sc = *(const f32x4*)(modb + 4 * DM + col);
            gs[j] = g * (sc + 1.f); sh[j] = *(const f32x4*)(modb + 3 * DM + col); }
        if (prev_m0 >= 0 && lane < 4) p6_route(F, logit + (4 * wave + lane) * 48, prev_m0 + 4 * wave + lane);
        bar4(bcnt, btarget, lane);
#pragma unroll
        for (int rr = 0; rr < 4; ++rr) {
            const int lr = 4 * wave + rr, m = m0 + lr;
            f32x4 v[8]; float s = 0.f;
#pragma unroll
            for (int j = 0; j < 8; ++j) { const u32x2 q = xb[rr][j];
                v[j][0] = __uint_as_float(q.x << 16); v[j][1] = __uint_as_float(q.x & 0xffff0000u); v[j][2] = __uint_as_float(q.y << 16); v[j][3] = __uint_as_float(q.y & 0xffff0000u);
                s += (v[j][0] * v[j][0] + v[j][1] * v[j][1]) + (v[j][2] * v[j][2] + v[j][3] * v[j][3]); }
            const float rstd = 1.f / sqrtf(wave_sum(s) * (1.f / DM) + EPS);
            unsigned char* orow = (unsigned char*)F.H + (size_t)m * DM;
#pragma unroll
            for (int j = 0; j < 8; ++j) { const f32x4 y = v[j] * rstd * gs[j] + sh[j];
                u32x2 o; o.x = cvt_pk_bf16(y[0], y[1]); o.y = cvt_pk_bf16(y[2], y[3]);
                *(unsigned*)(orow + 256 * j + 4 * lane) = pk4_fp8(y[0], y[1], y[2], y[3]);
                *(LAS u32x2*)(tile + lr * P6_PITCH + (256 * j + 4 * lane) * 2) = o; }
        }
        if (grp + F.G < NTOK / S6_ROWS) S6_LOADX(grp + F.G);
        bar4(bcnt, btarget, lane);
        if (wave < 3) {
            const int nb = wave;
            f32x4 acc = (f32x4){0.f, 0.f, 0.f, 0.f};
            const LAS unsigned char* ap = tile + fr * P6_PITCH + 16 * fq;
            const bf16* bp = F.RW + (size_t)(nb * 16 + fr) * DM + 8 * fq;
#pragma unroll 16
            for (int ks = 0; ks < 64; ++ks) acc = __builtin_amdgcn_mfma_f32_16x16x32_bf16(*(const LAS bf16x8*)(ap + 64 * ks), *(const bf16x8*)(bp + 32 * ks), acc, 0, 0, 0);
#pragma unroll
            for (int j = 0; j < 4; ++j) logit[(4 * fq + j) * 48 + nb * 16 + fr] = acc[j];
        }
        bar4(bcnt, btarget, lane);
        prev_m0 = m0;
    }
    if (prev_m0 >= 0 && lane < 4) p6_route(F, logit + (4 * wave + lane) * 48, prev_m0 + 4 * wave + lane);
    bar4(bcnt, btarget, lane);
#undef S6_LOADX
}
__device__ __forceinline__ int lds_pop(LAS unsigned* ctr, int lane) {
    int v = 0; if (lane == 0) v = (int)__hip_atomic_fetch_add(ctr, 1u, __ATOMIC_RELAXED, __HIP_MEMORY_SCOPE_WORKGROUP);
    return __builtin_amdgcn_readfirstlane(v);
}
__device__ __forceinline__ void s6_convert(Frame& F, LAS unsigned* ctr, int a0, int total) {
    f32x4 v[16]; u32x4 o[8]; P0Tile cur, nxt;
    int d = F.bid + F.G * lds_pop(ctr, F.lane);
    if (d >= total) return;
    cur = p0_decode(F, a0 + d); p0_tile_load(cur, v, F.lane);
    for (;;) {
        p0_tile_pack(cur, v, o);
        const int dn = F.bid + F.G * lds_pop(ctr, F.lane); const bool more = dn < total;
        if (more) { nxt = p0_decode(F, a0 + dn); p0_tile_load(nxt, v, F.lane); }
        p0_tile_store(cur, o, F.lane);
        if (!more) break;
        cur = nxt;
    }
}
__device__ __forceinline__ void p6_side_by_side(Frame& F) {
    LAS unsigned* ctrs = (LAS unsigned*)(F.lds + S6_CTR);
    __syncthreads();
    if (F.tid == 0) { ctrs[0] = 0u; ctrs[1] = 0u; }
    __syncthreads();
    constexpr int A0 = P0_EARLY_A + P0_R2;
    const int total = P0_R2;
    if (F.wave < 4) { s6_router(F, (volatile LAS unsigned*)ctrs); s6_convert(F, ctrs + 1, A0, total); }
    else s6_convert(F, ctrs + 1, A0, total);
}

__device__ __forceinline__ pg8::MoeTabs moe_tabs(Frame& F) {
    pg8::MoeTabs T; T.tb = (const LAS int*)(F.lds + MISC_BASE + MO_TB); T.tf = T.tb + 40; T.hl = T.tb + 80; T.te = (const LAS int*)(F.lds + MISC_BASE + MO_BIAS); return T;
}
__device__ __forceinline__ void p7_tail_convert(Frame& F) {
    const pg8::MoeTabs T = moe_tabs(F);
    const int total = (T.tf[NEXP] + T.hl[NEXP]) * 4, rem = total % F.G;
    int rank = F.vcu, cnt = F.G;
    if (rem != 0 && F.G - rem >= F.G / 4) { if (F.vcu < rem) return; rank = F.vcu - rem; cnt = F.G - rem; }
    const int a0 = P0_R0 + P0_R1 + 2 * P0_R2, len = (F.G == 256) ? P0_DEF_E0 * 256 : P0_R2;
    p0_run(F, rank * NWAVES + F.wave, cnt * NWAVES, a0, len, 0, 0);
}
__device__ __forceinline__ void moe_tables(Frame& F) {
    LAS int* tb = (LAS int*)(F.lds + MISC_BASE + MO_TB); LAS int* tf = tb + 40; LAS int* hl = tb + 80; LAS int* cnt = (LAS int*)(F.lds + MISC_BASE + MO_CNT);
    __syncthreads();
    if (F.tid < NEXP) cnt[F.tid] = (int)__hip_atomic_load(F.ctl + CW_ECNT + 16 * F.tid, __ATOMIC_RELAXED, __HIP_MEMORY_SCOPE_AGENT);
    __syncthreads();
    if (F.tid == 0) { int s = 0, f = 0, nh = 0;
        for (int e = 0; e < NEXP; ++e) { const int c = cnt[e], t = (c + 255) >> 8, rem = c - ((t - 1) << 8), h = (t > 0 && rem <= 128) ? 1 : 0;
            tb[e] = s; tf[e] = f; s += t; f += t - h; if (h) hl[nh++] = e; }
        tb[NEXP] = s; tf[NEXP] = f; hl[NEXP] = nh; }
    __syncthreads();
    { LAS int* te = (LAS int*)(F.lds + MISC_BASE + MO_BIAS);
      if (F.tid < MAXSLOT / 256) { int x = 0; while (x < NEXP - 1 && tf[x + 1] <= F.tid) ++x; te[F.tid] = x; } }
    __syncthreads();
}
__device__ __forceinline__ void p7_rowtab(Frame& F, int reps) {
    const pg8::MoeTabs T = moe_tabs(F); const LAS int* cnt = (const LAS int*)(F.lds + MISC_BASE + MO_CNT);
    LAS unsigned* rowtab = (LAS unsigned*)(F.lds + MISC_BASE + MO_ROWTAB);
    unsigned off[MAXU * 256 / NTHR];
#pragma unroll
    for (int q = 0; q < MAXU * 256 / NTHR; ++q) { const int idx = F.tid + q * NTHR, ord = idx >> 8, r = idx & 255; int pm, pn, e, half; off[q] = 0u;
        if (pg8::moe_unit(T, 4, ord * F.G + F.vcu, reps, pm, pn, e, half)) {
            const int slot = (pm - T.tb[e]) * 256 + r; if (slot < cnt[e]) off[q] = (unsigned)F.TOKLIST[e * NTOK + slot] * (unsigned)DM; } }
#pragma unroll
    for (int q = 0; q < MAXU * 256 / NTHR; ++q) rowtab[F.tid + q * NTHR] = off[q];
    __syncthreads();
}
struct P9Row { u32x2 x[8]; int ya[8], yc[8]; };
__device__ __forceinline__ void p9_load(Frame& F, const LAS int* tb, int m, int e1, int p1, int e2, int p2, P9Row& R, int lane) {
    const bf16* x1r = F.X1 + (size_t)m * DM;
    const unsigned char* y1 = (const unsigned char*)F.Y + ((size_t)tb[e1] * 256 + p1) * DM; const unsigned char* y2 = (const unsigned char*)F.Y + ((size_t)tb[e2] * 256 + p2) * DM;
#pragma unroll
    for (int j = 0; j < 8; ++j) { const int col = 256 * j + 4 * lane; R.x[j] = *(const u32x2*)(x1r + col); R.ya[j] = *(const int*)(y1 + col); R.yc[j] = *(const int*)(y2 + col); }
}
__device__ __forceinline__ void p9_final(Frame& F) {
    const LAS int* tb = (const LAS int*)(F.lds + MISC_BASE + MO_TB);
    const int gw = F.bid * NWAVES + F.wave, NGW = F.G * NWAVES, lane = F.lane;
    for (int grp = gw; grp < NTOK / 8; grp += NGW) {
        const int m0 = grp * 8, b = m0 / SEQ;
        const unsigned tiw = (lane < 48) ? F.TOKINFO[(size_t)(m0 + lane / 6) * 8 + (lane % 6)] : 0u;
        f32x4 gt[8], gf[8];
#pragma unroll
        for (int j = 0; j < 8; ++j) { const int col = 256 * j + 4 * lane; gt[j] = *(const f32x4*)(F.mod + (size_t)b * (6 * DM) + 5 * DM + col); gf[j] = *(const f32x4*)(F.g_final + col); }
        P9Row R[2];
#define P9_TI(r, w) __builtin_amdgcn_readlane((int)tiw, 6 * (r) + (w))
        p9_load(F, tb, m0, P9_TI(0, 0), P9_TI(0, 1), P9_TI(0, 2), P9_TI(0, 3), R[0], lane);
#pragma unroll
        for (int r = 0; r < 8; ++r) {
            if (r + 1 < 8) p9_load(F, tb, m0 + r + 1, P9_TI(r + 1, 0), P9_TI(r + 1, 1), P9_TI(r + 1, 2), P9_TI(r + 1, 3), R[(r + 1) & 1], lane);
            const P9Row& C = R[r & 1];
            const float g1s = __uint_as_float((unsigned)P9_TI(r, 4)) * (1.f / Y_SCALE), g2s = __uint_as_float((unsigned)P9_TI(r, 5)) * (1.f / Y_SCALE);
            f32x4 v[8]; float s = 0.f;
#pragma unroll
            for (int j = 0; j < 8; ++j) { const u32x2 xb = C.x[j]; const int a = C.ya[j], c = C.yc[j];
                f32x4 xv; xv[0] = __uint_as_float(xb.x << 16); xv[1] = __uint_as_float(xb.x & 0xffff0000u); xv[2] = __uint_as_float(xb.y << 16); xv[3] = __uint_as_float(xb.y & 0xffff0000u);
                f32x4 ya, yc;
                { const f32x2 lo = __builtin_amdgcn_cvt_pk_f32_fp8(a, false), hi = __builtin_amdgcn_cvt_pk_f32_fp8(a, true); ya[0] = lo[0]; ya[1] = lo[1]; ya[2] = hi[0]; ya[3] = hi[1]; }
                { const f32x2 lo = __builtin_amdgcn_cvt_pk_f32_fp8(c, false), hi = __builtin_amdgcn_cvt_pk_f32_fp8(c, true); yc[0] = lo[0]; yc[1] = lo[1]; yc[2] = hi[0]; yc[3] = hi[1]; }
                v[j] = xv + gt[j] * (ya * g1s + yc * g2s);
                s += (v[j][0] * v[j][0] + v[j][1] * v[j][1]) + (v[j][2] * v[j][2] + v[j][3] * v[j][3]); }
            const float rstd = 1.f / sqrtf(wave_sum(s) * (1.f / DM) + EPS);
            float* xr = F.out + (size_t)(m0 + r) * DM;
#pragma unroll
            for (int j = 0; j < 8; ++j) *(f32x4*)(xr + 256 * j + 4 * lane) = v[j] * rstd * gf[j];
        }
#undef P9_TI
    }
}

struct Args { const float* in[19]; float* out; unsigned char* ws; int ph_lo, ph_hi; };
constexpr int N_PHASES = 10;
__global__ void __launch_bounds__(NTHR, 2) fwd(Args args) {
    extern __shared__ __attribute__((aligned(16))) unsigned char lds_raw[];
    Frame F;
    F.lds = (LAS unsigned char*)lds_raw;
    F.wave = __builtin_amdgcn_readfirstlane((int)threadIdx.x >> 6); F.lane = lane_now(); F.tid = F.wave * 64 + F.lane; F.G = gridDim.x; F.bid = blockIdx.x; F.vcu = (F.G % 8 == 0) ? (F.bid % 8) * (F.G / 8) + F.bid / 8 : F.bid;
    unsigned char* ws = args.ws;
    F.ctl = (unsigned*)(ws + WS_CTL);
    F.x = args.in[0]; F.c = args.in[1]; F.w_ada = args.in[2]; F.b_ada = args.in[3]; F.g_mix = args.in[4]; F.w_in = args.in[5]; F.w_pool = args.in[6]; F.pool_scale = args.in[7];
    F.rel_bias = args.in[8]; F.w_out = args.in[9]; F.g_ffn = args.in[10]; F.w_group = args.in[11]; F.b_group = args.in[12]; F.w_router = args.in[13]; F.b_router = args.in[14];
    F.w_gate = args.in[15]; F.w_up = args.in[16]; F.w_down = args.in[17]; F.g_final = args.in[18];
    F.out = args.out; F.mod = (float*)(ws + WS_MOD);
    F.RW = (bf16*)(ws + WS_RW); F.WpT = (bf16*)(ws + WS_WPT); F.WinP = (bf16*)(ws + WS_WINP); F.Win = (bf16*)(ws + WS_WIN); F.Wout = (bf16*)(ws + WS_WOUT);
    F.Wgu = (bf16*)(ws + WS_WGU); F.Wd = (bf16*)(ws + WS_WD); F.H = (bf16*)(ws + WS_H); F.P = (bf16*)(ws + WS_P); F.CAT = (bf16*)(ws + WS_CAT); F.Y = (bf16*)(ws + WS_Y); F.A = (bf16*)(ws + WS_A); F.X1 = (bf16*)(ws + WS_X1);
    F.MASK = (unsigned*)(ws + WS_MASK); F.TOKLIST = (int*)(ws + WS_TOKLIST); F.TOKINFO = (unsigned*)(ws + WS_TOKINFO);
    volatile LAS unsigned* barw = (volatile LAS unsigned*)(F.lds + MISC_BASE + MO_BARW);
    if (F.tid < 4) barw[F.tid] = 0u;
    __syncthreads();
    XcdBarrier bar; bar.bar = F.ctl + CW_BAR; bar.x = 0; bar.st = nullptr; bar.wave = F.wave;
    if (MK_N_LAUNCHES == 1) bar = xcd_barrier_post(F.ctl + CW_BAR, barw, F.wave);
    const int lo = args.ph_lo, hi = args.ph_hi;
#ifndef PH_MASK
#define PH_MASK 0x3ff
#endif
#define IN(k) (((PH_MASK >> (k)) & 1) && lo <= (k) && (k) < hi && (F.lane = lane_now(), F.tid = F.wave * 64 + F.lane, true))
#define SEAM(k) do { if (MK_N_LAUNCHES == 1 && IN(k) && IN((k) + 1)) xcd_barrier(bar); } while (0)
    LAS unsigned char* ring = F.lds;

#define REP(k) for (int rep_ = 0; rep_ < ((PROBE_DUP == (k) && ((k) == 0 || (k) == 6 || (k) == 9 || (k) == 11)) ? 2 : 1); ++rep_)
#define NREP(k) ((PROBE_DUP == (k)) ? 2 : 1)
    unsigned long long pt0_ = 0ull;
#define PT_BEGIN(k) do { if (PROBE_TIME >= 0) { if ((k) > 0 && PROBE_TIME == (k) - 1) { const unsigned long long t1_ = __builtin_amdgcn_s_memrealtime(); \
        if (F.bid == 0) { const unsigned long long until_ = t1_ + 4ull * (t1_ - pt0_); while (__builtin_amdgcn_s_memrealtime() < until_) __builtin_amdgcn_s_sleep(8); } } \
        if (PROBE_TIME == (k)) pt0_ = __builtin_amdgcn_s_memrealtime(); } } while (0)
    PT_BEGIN(0);
    if (IN(0)) { REP(0) { p0_prologue(F, CW_Q0 + 64 * rep_); } SEAM(0); }
    PT_BEGIN(1);
    if (IN(1)) {
        REP(1) {
        { pg8::Gemm g{F.WpT, F.WinP, 256, 256, 1024, nullptr}; pg8::FoldOrder S{F.G, F.bid}; pg8::EpiBf16 E{F.Win, DM, F.pool_scale, 1.f};
          pg8::gemm_phase<pg8::EpiBf16, pg8::FoldOrder, false, true>(ring, g, S, E, F.wave); }
        REP(11) { p1_norm_rows(F, F.x, F.g_mix, 0, DM, F.H); }
        }
        SEAM(1);
    }
    PT_BEGIN(2);
    if (IN(2)) {
        REP(2) {
        pg8::Gemm g{F.H, F.Win, DM, DM, DM, nullptr}; pg8::StaticOrder S; S.init(NTOK, PLD, F.G, F.bid); S.reps = NREP(2); pg8::EpiBf16 E{F.P, PLD, nullptr, 1.f};
        pg8::gemm_phase<pg8::EpiBf16, pg8::StaticOrder, false, true>(ring, g, S, E, F.wave);
        }
        p0_deferred(F);
        SEAM(2);
    }
    PT_BEGIN(3);
    if (IN(3)) { if (PROBE_DUP == 3) { p3_window(F); p3_indexer(F); } if (PROBE_DUP == 33) p3_window(F); p3_window(F); p3_indexer(F); SEAM(3); }
    PT_BEGIN(4);
    if (IN(4)) { p4_attention(F, PROBE_DUP == 4 ? 512 : 256); SEAM(4); }
    PT_BEGIN(5);
    if (IN(5)) {
        REP(5) {
        pg8::Gemm g{F.CAT, F.Wout, DM, DM, DM, nullptr}; pg8::StaticOrder S; S.init(NTOK, DM, F.G, F.bid); S.reps = NREP(5); pg8::EpiResid E{F.x, F.X1, F.mod + 2 * DM};
        pg8::gemm_phase<pg8::EpiResid, pg8::StaticOrder, false, true>(ring, g, S, E, F.wave);
        }
        SEAM(5);
    }
    PT_BEGIN(6);
    if (IN(6)) { if (PROBE_DUP == 6) { REP(6) { p6_norm_router(F, rep_ == 0); } p0_late(F); } else p6_side_by_side(F); SEAM(6); }
    PT_BEGIN(7);
    if (IN(7)) {
        moe_tables(F); p7_rowtab(F, NREP(7));
        REP(7) {
        pg8::Gemm g{F.H, F.Wgu, DM / 2, DM / 2, DM / 2, (const LAS unsigned*)(F.lds + MISC_BASE + MO_ROWTAB)};
        pg8::GroupedOrder S{moe_tabs(F), 4, F.G, F.vcu, 1024, NREP(7)}; pg8::EpiGateUp E{(unsigned char*)F.A, 1.f / WGU_SCALE};
        pg8::gemm_phase<pg8::EpiGateUp, pg8::GroupedOrder, true, true, true>(ring, g, S, E, F.wave);
        }
        p7_tail_convert(F);
        SEAM(7);
    }
    PT_BEGIN(8);
    if (IN(8)) {
        if (MK_N_LAUNCHES != 1) moe_tables(F);
        REP(8) {
        pg8::Gemm g{F.A, F.Wd, DEXP / 2, DEXP / 2, DEXP / 2, nullptr};
        pg8::GroupedOrder S{moe_tabs(F), 8, F.G, F.vcu, DM, NREP(8)}; pg8::EpiFp8 E{(unsigned char*)F.Y, DM, Y_SCALE / WD_SCALE};
        pg8::gemm_phase<pg8::EpiFp8, pg8::GroupedOrder, false, P8_ALIGN, true>(ring, g, S, E, F.wave);
        }
        SEAM(8);
    }
    PT_BEGIN(9);
    if (IN(9)) { if (MK_N_LAUNCHES != 1) moe_tables(F); REP(9) { p9_final(F); } }
    PT_BEGIN(10);
#undef REP
#undef NREP
#undef PT_BEGIN
#undef IN
#undef SEAM
}

extern "C" void kernel_launch(void* const* d_in, const int* in_sizes, int n_in, void* d_out, int out_size, void* d_ws, size_t ws_size, hipStream_t stream) {
    static int grid = 0;
    if (grid == 0) {
        if (n_in != 19 || in_sizes[0] != NTOK * DM || out_size != NTOK * DM || ws_size < WS_END) {
            fprintf(stderr, "kernel_launch: unexpected shapes (n_in %d, in0 %d, out %d, ws %zu); nothing launched\n", n_in, n_in > 0 ? in_sizes[0] : -1, out_size, ws_size); grid = -1; return; }
        int dev = 0, cus = 0;
        if (hipGetDevice(&dev) != hipSuccess || hipDeviceGetAttribute(&cus, hipDeviceAttributeMultiprocessorCount, dev) != hipSuccess || cus < 128) { fprintf(stderr, "kernel_launch: device query failed or too few CUs (%d)\n", cus); grid = -1; return; }
        if (hipFuncSetAttribute((const void*)fwd, hipFuncAttributeMaxDynamicSharedMemorySize, LDS_TOTAL) != hipSuccess) { fprintf(stderr, "kernel_launch: hipFuncSetAttribute failed\n"); grid = -1; return; }
        int per_cu = 0;
        if (hipOccupancyMaxActiveBlocksPerMultiprocessor(&per_cu, (const void*)fwd, NTHR, LDS_TOTAL) != hipSuccess || per_cu < 1) fprintf(stderr, "kernel_launch: note: occupancy query reports %d blocks per CU\n", per_cu);
        (void)hipGetLastError();
        grid = cus;
    }
    if (grid < 0) return;
    if (hipMemsetAsync((char*)d_ws + WS_CTL, 0, CTL_ZERO_BYTES, stream) != hipSuccess) { fprintf(stderr, "kernel_launch: memset failed\n"); return; }
    Args a{};
    for (int i = 0; i < 19; ++i) a.in[i] = (const float*)d_in[i];
    a.out = (float*)d_out; a.ws = (unsigned char*)d_ws;
    const int nl = MK_N_LAUNCHES;
    for (int li = 0; li < nl; ++li) {
        a.ph_lo = (nl == 1) ? 0 : li; a.ph_hi = (nl == 1) ? N_PHASES : li + 1;
        hipLaunchKernelGGL(fwd, dim3(grid), dim3(NTHR), LDS_TOTAL, stream, a);
        const hipError_t le = hipPeekAtLastError();
        if (le != hipSuccess) { fprintf(stderr, "kernel_launch: launch %d failed: %s\n", li, hipGetErrorName(le)); break; }
    }
}
```

```cpp
#include <hip/hip_runtime.h>
#include <cstdio>
#include <cstdint>

#ifndef MK_N_LAUNCHES
#define MK_N_LAUNCHES 1
#endif

#ifndef P8_ALIGN
#define PROBE_TIME -1
#define P8_ALIGN true
#endif
#ifndef PROBE_DUP
#define PROBE_DUP -1
#endif
#define GAS __attribute__((address_space(1)))
#define LAS __attribute__((address_space(3)))
typedef unsigned short bf16;
typedef short bf16x8 __attribute__((ext_vector_type(8)));
typedef short s16x4 __attribute__((ext_vector_type(4)));
typedef float f32x4 __attribute__((ext_vector_type(4)));
typedef float f32x2 __attribute__((ext_vector_type(2)));
typedef float f32x16 __attribute__((ext_vector_type(16)));
typedef unsigned u32x4 __attribute__((ext_vector_type(4)));
typedef unsigned u32x2 __attribute__((ext_vector_type(2)));

constexpr int DM = 2048, NB = 8, SEQ = 2048, NTOK = NB * SEQ;
constexpr int POOLW = 1024, NHEAD = 8, HD = 128, NKV = 2, IDXH = 16, IDXD = 64, TOPK = 256;
constexpr int PIN = 3664, PLD = 3840;
constexpr int C_U = 0, C_Q = 1024, C_K = 2048, C_V = 2304, C_QI = 2560, C_KI = 3584, C_WI = 3648;
constexpr int NEXP = 32, DEXP = 512, NGRP = 4, EPG = 8;
constexpr int MAXSLOT = 40960;
constexpr float EPS = 1e-6f;

constexpr size_t MiB = 1u << 20;
constexpr size_t WS_CTL = 0, CTL_ZERO_BYTES = 1 * MiB;
constexpr size_t WS_MOD = 1 * MiB;
constexpr size_t WS_RW = 1 * MiB + 512 * 1024;
constexpr size_t WS_TOKINFO = 2 * MiB;
constexpr size_t WS_TOKLIST = 3 * MiB;
constexpr size_t WS_WPT = 5 * MiB;
constexpr size_t WS_MASK = 6 * MiB;
constexpr size_t WS_WINP = 10 * MiB;
constexpr size_t WS_WIN = 16 * MiB;
constexpr size_t WS_WOUT = 32 * MiB;
constexpr size_t WS_WGU = 40 * MiB;
constexpr size_t WS_WD = 168 * MiB;
constexpr size_t WS_H = 232 * MiB;
constexpr size_t WS_P = 296 * MiB;
constexpr size_t WS_CAT = 416 * MiB;
constexpr size_t WS_Y = 296 * MiB;
constexpr size_t WS_A = 480 * MiB;
constexpr size_t WS_X1 = 520 * MiB;
constexpr size_t WS_END = 584 * MiB;
static_assert(WS_Y + (size_t)MAXSLOT * DM * 2 <= WS_A && WS_P + (size_t)NTOK * PLD * 2 <= WS_CAT && WS_A + (size_t)MAXSLOT * DEXP * 2 <= WS_X1 && WS_X1 + (size_t)NTOK * DM * 2 <= WS_END, "ws map");
constexpr int CW_TMO = 0, CW_Q0 = 64, CW_BAR = 4096, CW_ECNT = 16384;

constexpr int RING_BYTES = 131072;
constexpr int MISC_OFF = RING_BYTES;
constexpr int LDS_BYTES = 147456;
constexpr int NWAVES = 8, NTHR = 512;

#define LDS_WAIT() asm volatile("s_waitcnt lgkmcnt(0)" ::: "memory")
#define VM_WAIT() asm volatile("s_waitcnt vmcnt(0)" ::: "memory")
__device__ __forceinline__ unsigned cvt_pk_bf16(float lo, float hi) { unsigned r; asm volatile("v_cvt_pk_bf16_f32 %0, %1, %2" : "=v"(r) : "v"(lo), "v"(hi)); return r; }
__device__ __forceinline__ float bf2f(bf16 v) { return __builtin_bit_cast(float, (unsigned)v << 16); }
__device__ __forceinline__ float wave_sum(float v) {
#pragma unroll
    for (int o = 1; o < 64; o <<= 1) v += __shfl_xor(v, o);
    return v;
}

__device__ __forceinline__ int lane_now() { int l; asm volatile("v_mbcnt_lo_u32_b32 %0, -1, 0\n\tv_mbcnt_hi_u32_b32 %0, -1, %0" : "=v"(l)); return l; }
namespace pg8 {
constexpr int BM = 256, BK = 64, HALF = 128, HTB = HALF * BK * 2, STAGE_BYTES = 8 * HTB, NXCD = 8, WGM = 4;
__host__ __device__ __forceinline__ int lds_byte(int r, int c) { const int st = (r >> 4) * 2 + (c >> 5), rr = r & 15, cc = c & 31, ob = rr * 64 + cc * 2; return st * 1024 + (ob ^ (((ob >> 9) & 1) << 5)); }
__host__ __device__ __forceinline__ void stage_rc(int b, int& R, int& C) { const int st = b / 1024, sb = b % 1024, swz = sb ^ (((sb >> 9) & 1) << 5); R = (st >> 1) * 16 + swz / 64; C = (st & 1) * 32 + (swz % 64) / 2; }
__host__ __device__ __forceinline__ int perm32(int rho) { const int n = rho >> 4, i = rho & 15; return 8 * (i >> 2) + 4 * n + (i & 3); }

typedef int v4i_t __attribute__((ext_vector_type(4)));
typedef int v8i_t __attribute__((ext_vector_type(8)));
struct Unit { int pm, pn, e, ord, half; };
struct Gemm { const bf16* A; const bf16* Bt; int K, lda, ldb; const LAS unsigned* rowtab; };

struct StaticOrder {
    int nM, nN, nwg, G, c, reps;
    __device__ void init(int M, int N, int G_, int c_) { nM = M / BM; nN = N / BM; nwg = nM * nN; G = G_; c = c_; reps = 1; }
    __device__ bool next(int i, Unit& u) const {
        const long L = (long)i * G + c; if (L >= (long)nwg * reps) return false;
        int wgid = (int)(L % nwg); { const int q = nwg / NXCD, r = nwg % NXCD, xcd = wgid % NXCD, off = wgid / NXCD; wgid = (xcd < r ? xcd * (q + 1) : r * (q + 1) + (xcd - r) * q) + off; }
        const int nig = WGM * nN, gid = wgid / nig, fm = gid * WGM, gsz = (nM - fm) < WGM ? (nM - fm) : WGM;
        u.pm = fm + ((wgid % nig) % gsz); u.pn = (wgid % nig) / gsz; u.e = 0; u.ord = i; u.half = 0; return true;
    }
    __device__ __forceinline__ size_t b_off(const Unit& u, int ldb) const { return (size_t)u.pn * BM * ldb * 2; }
};
struct FoldOrder {
    int G, c;
    __device__ bool next(int i, Unit& u) const { const int L = i * G + c; if (L >= 32) return false; u.pm = L >> 3; u.pn = L & 7; u.e = 0; u.ord = i; u.half = 0; return true; }
    __device__ __forceinline__ size_t b_off(const Unit& u, int ldb) const { return ((size_t)u.pn * BM * ldb + (size_t)u.pm * 256) * 2; }
};
struct MoeTabs { const LAS int* tb; const LAS int* tf; const LAS int* hl; const LAS int* te; };
__device__ __forceinline__ bool moe_unit(const MoeTabs& T, int NT, int L, int reps, int& pm, int& pn, int& e, int& half) {
    const int nf = T.tf[NEXP], nh = T.hl[NEXP], total = (nf + nh) * NT;
    if (L >= total * reps) return false;
    L %= total;
    const int mt = L / NT; pn = L - mt * NT;
    if (mt < nf) { const int x = T.te[mt]; e = x; pm = T.tb[x] + (mt - T.tf[x]); half = 0; }
    else { e = T.hl[mt - nf]; pm = T.tb[e + 1] - 1; half = 1; }
    return true;
}
struct GroupedOrder {
    MoeTabs T; int NT, G, c, rows_per_e, reps;
    __device__ bool next(int i, Unit& u) const { u.ord = i; return moe_unit(T, NT, i * G + c, reps, u.pm, u.pn, u.e, u.half); }
    __device__ __forceinline__ size_t b_off(const Unit& u, int ldb) const { return ((size_t)u.e * rows_per_e + (size_t)u.pn * BM) * ldb * 2; }
};

template <class Epi, class Sched, bool GATHER, bool ALIGN_EPI, bool FP8 = false>
__device__ __forceinline__ void gemm_phase(LAS unsigned char* lds, const Gemm g, const Sched& S, const Epi& E, const int wid) {
    const int lane = lane_now(), tid = wid * 64 + lane, wr = wid >> 2, wc = wid & 3, fr = lane & 15, fq = lane >> 4;
    const int K = g.K, nt = K / BK;
    int Rr[2], Cc[2];
    unsigned voffB[2];
    unsigned cva[2][2], nva[2][2];
#pragma unroll
    for (int i = 0; i < 2; ++i) { int R, C; stage_rc(tid * 16 + i * 8192, R, C); Rr[i] = R; Cc[i] = C; const int Rb = Epi::PERM ? ((R & ~31) + perm32(R & 31)) : R;
        voffB[i] = (unsigned)(Rb * g.ldb + C) * 2u; }
    const size_t kstep = (size_t)(BK * 2);
    const unsigned hstepA = (unsigned)HALF * g.lda * 2u;
    const size_t hstepB = (size_t)HALF * g.ldb * 2;
    const unsigned ldsw = (unsigned)wid * 1024u;
    const int aoff = lds_byte(wr * 64 + fr, fq * 8), boff = lds_byte(wc * 32 + fr, fq * 8);
#define PG8_SA(b, h) (((b) * 2 + (h)) * HTB)
#define PG8_SB(b, h) ((4 + (b) * 2 + (h)) * HTB)
#define PG8_STAGE(bufoff, gbase, v0, v1) do { \
        __builtin_amdgcn_global_load_lds((const unsigned*)((const char*)(gbase) + (v0)), (LAS unsigned*)(lds + (bufoff) + ldsw), 16, 0, 0); \
        __builtin_amdgcn_global_load_lds((const unsigned*)((const char*)(gbase) + (v1)), (LAS unsigned*)(lds + (bufoff) + ldsw + 8192), 16, 0, 0); } while (0)
#define PG8_STAGE_B(bufoff, gbase) PG8_STAGE(bufoff, gbase, voffB[0], voffB[1])
#define PG8_LD8(base) __builtin_shufflevector(*(const LAS v4i_t*)(base), *(const LAS v4i_t*)((base) + 1024), 0, 1, 2, 3, 4, 5, 6, 7)
#define PG8_LDA(dst, b, h) do { _Pragma("unroll") for (int m = 0; m < 4; ++m) dst[m] = PG8_LD8(lds + PG8_SA(b, h) + aoff + m * 2048); } while (0)
#define PG8_LDB(dst, b, h) do { _Pragma("unroll") for (int n = 0; n < 2; ++n) dst[n] = PG8_LD8(lds + PG8_SB(b, h) + boff + n * 2048); } while (0)
#define PG8_LO(x) __builtin_bit_cast(bf16x8, __builtin_shufflevector((x), (x), 0, 1, 2, 3))
#define PG8_HI(x) __builtin_bit_cast(bf16x8, __builtin_shufflevector((x), (x), 4, 5, 6, 7))
#define PG8_MMA(ai, bj, At, Bt) do { __builtin_amdgcn_s_setprio(1); _Pragma("unroll") for (int m = 0; m < 4; ++m) _Pragma("unroll") for (int n = 0; n < 2; ++n) { \
        if constexpr (FP8) asm volatile("v_mfma_scale_f32_16x16x128_f8f6f4 %0, %1, %2, %0, %3, %3 op_sel_hi:[0,0,0]" : "+v"(acc[ai][bj][m][n]) : "v"(Bt[n]), "v"(At[m]), "v"(sc8));   \
        else { acc[ai][bj][m][n] = __builtin_amdgcn_mfma_f32_16x16x32_bf16(PG8_LO(Bt[n]), PG8_LO(At[m]), acc[ai][bj][m][n], 0, 0, 0); \
               acc[ai][bj][m][n] = __builtin_amdgcn_mfma_f32_16x16x32_bf16(PG8_HI(Bt[n]), PG8_HI(At[m]), acc[ai][bj][m][n], 0, 0, 0); } } \
        __builtin_amdgcn_s_setprio(0); } while (0)
#define PG8_WAIT_V(n) asm volatile("s_waitcnt vmcnt(" #n ")" ::: "memory")
#define PG8_WAIT_L(n) asm volatile("s_waitcnt lgkmcnt(" #n ")" ::: "memory")
#define PG8_BAR __builtin_amdgcn_s_barrier()
#define PG8_SCHED __builtin_amdgcn_sched_barrier(0)
#define PG8_AOFF(dst, u) do { _Pragma("unroll") for (int h_ = 0; h_ < 2; ++h_) _Pragma("unroll") for (int i_ = 0; i_ < 2; ++i_) { \
        if constexpr (GATHER) dst[h_][i_] = g.rowtab[(u).ord * 256 + h_ * HALF + Rr[i_]] + (unsigned)Cc[i_] * 2u; \
        else dst[h_][i_] = (unsigned)(Rr[i_] * g.lda + Cc[i_]) * 2u + (unsigned)h_ * hstepA; } } while (0)
    Unit cur, nxt; int ui = 0;
    if (!S.next(0, cur)) return;
    const int sc8 = 0x7f7f7f7f;
    f32x4 acc[2][2][4][2];
#pragma unroll
    for (int a = 0; a < 2; ++a)
#pragma unroll
        for (int b = 0; b < 2; ++b)
#pragma unroll
            for (int m = 0; m < 4; ++m)
#pragma unroll
                for (int n = 0; n < 2; ++n) acc[a][b][m][n] = (f32x4){0.f, 0.f, 0.f, 0.f};
    v8i_t At[4], B0[2], B1[2];
    const size_t tstepA = (size_t)BM * g.lda * 2;
    const char* cA = GATHER ? (const char*)g.A : (const char*)g.A + (size_t)cur.pm * tstepA;
    const char* cB = (const char*)g.Bt + S.b_off(cur, g.ldb);
    PG8_AOFF(cva, cur);
#pragma unroll
    for (int h_ = 0; h_ < 2; ++h_)
#pragma unroll
        for (int i_ = 0; i_ < 2; ++i_) nva[h_][i_] = cva[h_][i_];
    if constexpr (GATHER) { LDS_WAIT(); }
    PG8_STAGE_B(PG8_SB(0, 0), cB); PG8_STAGE_B(PG8_SB(0, 1), cB + hstepB); PG8_STAGE(PG8_SA(0, 0), cA, cva[0][0], cva[0][1]); PG8_STAGE(PG8_SA(0, 1), cA, cva[1][0], cva[1][1]);
    if (wr == 1) PG8_BAR;
    PG8_WAIT_V(2); PG8_BAR;
    PG8_STAGE_B(PG8_SB(1, 0), cB + kstep); PG8_STAGE(PG8_SA(1, 0), cA + kstep, cva[0][0], cva[0][1]); PG8_STAGE_B(PG8_SB(1, 1), cB + hstepB + kstep);
    PG8_WAIT_V(6); PG8_BAR;
    for (;;) {
        const bool has_next = S.next(ui + 1, nxt);
        const bool full = (cur.half == 0);
        const char* nA = GATHER ? cA : (has_next ? (const char*)g.A + (size_t)nxt.pm * tstepA : cA);
        const char* nB = has_next ? (const char*)g.Bt + S.b_off(nxt, g.ldb) : cB;
#pragma nounroll
        for (int t = 0; t < nt; t += 2) {
            const bool last = (t == nt - 2);
            const char* a1 = cA + (size_t)(t + 1) * kstep;
            const char* a2 = last ? nA : cA + (size_t)(t + 2) * kstep; const char* b2 = last ? nB : cB + (size_t)(t + 2) * kstep;
            const char* a3 = a2 + kstep; const char* b3 = b2 + kstep;
            if (last) { if (has_next) { PG8_AOFF(nva, nxt); } else {
#pragma unroll
                for (int h_ = 0; h_ < 2; ++h_)
#pragma unroll
                    for (int i_ = 0; i_ < 2; ++i_) nva[h_][i_] = cva[h_][i_]; }
                if constexpr (GATHER) { LDS_WAIT(); } }
            unsigned v2[2][2];
#pragma unroll
            for (int h_ = 0; h_ < 2; ++h_)
#pragma unroll
                for (int i_ = 0; i_ < 2; ++i_) v2[h_][i_] = last ? nva[h_][i_] : cva[h_][i_];
            PG8_LDB(B0, 0, 0); PG8_LDB(B1, 0, 1); PG8_SCHED; PG8_LDA(At, 0, 0); PG8_STAGE(PG8_SA(1, 1), a1, cva[1][0], cva[1][1]);
            PG8_WAIT_V(8); PG8_WAIT_L(0); PG8_BAR; PG8_MMA(0, 0, At, B0); PG8_MMA(0, 1, At, B1); PG8_BAR; PG8_SCHED;
            PG8_LDA(At, 0, 1); PG8_STAGE_B(PG8_SB(0, 0), b2); PG8_STAGE_B(PG8_SB(0, 1), b2 + hstepB); PG8_STAGE(PG8_SA(0, 0), a2, v2[0][0], v2[0][1]);
            PG8_WAIT_V(8); PG8_WAIT_L(0); PG8_BAR; if (full) { PG8_MMA(1, 0, At, B0); PG8_MMA(1, 1, At, B1); } PG8_BAR; PG8_SCHED;
            PG8_LDB(B0, 1, 0); PG8_LDB(B1, 1, 1); PG8_SCHED; PG8_LDA(At, 1, 0); PG8_STAGE(PG8_SA(0, 1), a2, v2[1][0], v2[1][1]);
            PG8_WAIT_V(8); PG8_WAIT_L(0); PG8_BAR; PG8_MMA(0, 0, At, B0); PG8_MMA(0, 1, At, B1); PG8_BAR; PG8_SCHED;
            PG8_LDA(At, 1, 1); PG8_STAGE_B(PG8_SB(1, 0), b3); PG8_STAGE_B(PG8_SB(1, 1), b3 + hstepB); PG8_STAGE(PG8_SA(1, 0), a3, v2[0][0], v2[0][1]);
            PG8_WAIT_V(8); PG8_WAIT_L(0); PG8_BAR; if (full) { PG8_MMA(1, 0, At, B0); PG8_MMA(1, 1, At, B1); } PG8_BAR; PG8_SCHED;
        }
        if constexpr (FP8) asm volatile("s_nop 15\n\ts_nop 15" ::: "memory");
        if constexpr (ALIGN_EPI) { if (wr == 0) PG8_BAR; }
        if constexpr (Epi::EPI_PRIO > 0) __builtin_amdgcn_s_setprio(Epi::EPI_PRIO);
        E(acc, cur, wr, wc, fr, fq);
        if constexpr (Epi::EPI_PRIO > 0) __builtin_amdgcn_s_setprio(0);
        if (!has_next) break;
#pragma unroll
        for (int a = 0; a < 2; ++a)
#pragma unroll
            for (int b = 0; b < 2; ++b)
#pragma unroll
                for (int m = 0; m < 4; ++m)
#pragma unroll
                    for (int n = 0; n < 2; ++n) acc[a][b][m][n] = (f32x4){0.f, 0.f, 0.f, 0.f};
        cur = nxt; cA = nA; cB = nB; ++ui;
#pragma unroll
        for (int h_ = 0; h_ < 2; ++h_)
#pragma unroll
            for (int i_ = 0; i_ < 2; ++i_) cva[h_][i_] = nva[h_][i_];
        if constexpr (ALIGN_EPI) { if (wr == 1) PG8_BAR; }
    }
    PG8_WAIT_V(0);
    if constexpr (!ALIGN_EPI) { if (wr == 0) PG8_BAR; }
    PG8_BAR;
#undef PG8_SA
#undef PG8_SB
#undef PG8_STAGE
#undef PG8_STAGE_B
#undef PG8_LDA
#undef PG8_LDB
#undef PG8_MMA
#undef PG8_LD8
#undef PG8_LO
#undef PG8_HI
#undef PG8_WAIT_V
#undef PG8_WAIT_L
#undef PG8_BAR
#undef PG8_SCHED
#undef PG8_AOFF
}

struct EpiBf16 {
    static constexpr bool PERM = true; static constexpr int EPI_PRIO = 0;
    bf16* O; int ldc; const float* rowscale; float oscale;
    __device__ __forceinline__ void operator()(const f32x4 (&acc)[2][2][4][2], const Unit& u, int wr, int wc, int fr, int fq) const {
        const int row0 = u.pm * BM + wr * 64 + fr, col0 = u.pn * BM + wc * 32 + 8 * fq;
#pragma unroll
        for (int ai = 0; ai < 2; ++ai)
#pragma unroll
            for (int m = 0; m < 4; ++m) { const int row = row0 + ai * HALF + m * 16; bf16* rowp = O + (size_t)row * ldc + col0; const float s = rowscale ? rowscale[row] * oscale : oscale;
#pragma unroll
                for (int bj = 0; bj < 2; ++bj) { const f32x4 v0 = acc[ai][bj][m][0] * s, v1 = acc[ai][bj][m][1] * s;
                    u32x4 w; w.x = cvt_pk_bf16(v0[0], v0[1]); w.y = cvt_pk_bf16(v0[2], v0[3]); w.z = cvt_pk_bf16(v1[0], v1[1]); w.w = cvt_pk_bf16(v1[2], v1[3]);
                    *(u32x4*)(rowp + bj * HALF) = w; } }
    }
};
struct EpiFp8 {
    static constexpr bool PERM = true; static constexpr int EPI_PRIO = 0;
    unsigned char* O; int ldc; float oscale;
    __device__ __forceinline__ void operator()(const f32x4 (&acc)[2][2][4][2], const Unit& u, int wr, int wc, int fr, int fq) const {
        const int row0 = u.pm * BM + wr * 64 + fr, col0 = u.pn * BM + wc * 32 + 8 * fq;
#pragma unroll
        for (int ai = 0; ai < 2; ++ai)
#pragma unroll
            for (int m = 0; m < 4; ++m) { unsigned char* rowp = O + (size_t)(row0 + ai * HALF + m * 16) * ldc + col0;
#pragma unroll
                for (int bj = 0; bj < 2; ++bj) { const f32x4 v0 = acc[ai][bj][m][0] * oscale, v1 = acc[ai][bj][m][1] * oscale; u32x2 w;
                    { int p = __builtin_amdgcn_cvt_pk_fp8_f32(v0[0], v0[1], 0, false); p = __builtin_amdgcn_cvt_pk_fp8_f32(v0[2], v0[3], p, true); w.x = (unsigned)p; }
                    { int p = __builtin_amdgcn_cvt_pk_fp8_f32(v1[0], v1[1], 0, false); p = __builtin_amdgcn_cvt_pk_fp8_f32(v1[2], v1[3], p, true); w.y = (unsigned)p; }
                    *(u32x2*)(rowp + bj * HALF) = w; } }
    }
};
struct EpiResid {
    static constexpr bool PERM = true; static constexpr int EPI_PRIO = 2;
    const float* X; bf16* X1; const float* gate;
    __device__ __forceinline__ void operator()(const f32x4 (&acc)[2][2][4][2], const Unit& u, int wr, int wc, int fr, int fq) const {
        const int row0 = u.pm * BM + wr * 64 + fr, col0 = u.pn * BM + wc * 32 + 8 * fq;
        const float* gp = gate + (size_t)((u.pm * BM) / SEQ) * (6 * DM) + col0;
        f32x4 gv[2][2];
#pragma unroll
        for (int bj = 0; bj < 2; ++bj)
#pragma unroll
            for (int n = 0; n < 2; ++n) gv[bj][n] = *(const f32x4*)(gp + bj * HALF + n * 4);
#pragma unroll
        for (int ai = 0; ai < 2; ++ai) {
            f32x4 xv[4][2][2];
#pragma unroll
            for (int m = 0; m < 4; ++m) { const size_t ro = (size_t)(row0 + ai * HALF + m * 16) * DM + col0;
#pragma unroll
                for (int bj = 0; bj < 2; ++bj) { xv[m][bj][0] = *(const f32x4*)(X + ro + bj * HALF); xv[m][bj][1] = *(const f32x4*)(X + ro + bj * HALF + 4); } }
#pragma unroll
            for (int m = 0; m < 4; ++m) { const size_t ro = (size_t)(row0 + ai * HALF + m * 16) * DM + col0;
#pragma unroll
                for (int bj = 0; bj < 2; ++bj) {
                    const f32x4 v0 = xv[m][bj][0] + gv[bj][0] * acc[ai][bj][m][0], v1 = xv[m][bj][1] + gv[bj][1] * acc[ai][bj][m][1];
                    u32x4 w; w.x = cvt_pk_bf16(v0[0], v0[1]); w.y = cvt_pk_bf16(v0[2], v0[3]); w.z = cvt_pk_bf16(v1[0], v1[1]); w.w = cvt_pk_bf16(v1[2], v1[3]);
                    *(u32x4*)(X1 + ro + bj * HALF) = w; } }
        }
    }
};
struct EpiGateUp {
    static constexpr bool PERM = true; static constexpr int EPI_PRIO = 0;
    unsigned char* O; float isc;
    __device__ __forceinline__ void operator()(const f32x4 (&acc)[2][2][4][2], const Unit& u, int wr, int wc, int fr, int fq) const {
        const int row0 = u.pm * BM + wr * 64 + fr, col0 = u.pn * HALF + wc * 32 + 8 * fq;
#pragma unroll
        for (int ai = 0; ai < 2; ++ai)
#pragma unroll
            for (int m = 0; m < 4; ++m) { unsigned char* rowp = O + (size_t)(row0 + ai * HALF + m * 16) * DEXP + col0; float r[8];
#pragma unroll
                for (int n = 0; n < 2; ++n)
#pragma unroll
                    for (int j = 0; j < 4; ++j) { const float gt = acc[ai][0][m][n][j] * isc, up = acc[ai][1][m][n][j] * isc;
                        r[n * 4 + j] = gt * __builtin_amdgcn_rcpf(1.f + __builtin_amdgcn_exp2f(-1.4426950408889634f * gt)) * up; }
                u32x2 w; { int p = __builtin_amdgcn_cvt_pk_fp8_f32(r[0], r[1], 0, false); p = __builtin_amdgcn_cvt_pk_fp8_f32(r[2], r[3], p, true); w.x = (unsigned)p; }
                { int p = __builtin_amdgcn_cvt_pk_fp8_f32(r[4], r[5], 0, false); p = __builtin_amdgcn_cvt_pk_fp8_f32(r[6], r[7], p, true); w.y = (unsigned)p; }
                *(u32x2*)rowp = w; }
    }
};
}

constexpr int MISC_BASE = 139264;
constexpr int LDS_TOTAL = 159744;
constexpr int MO_BARW = 0;
constexpr int MO_TB = 256;
constexpr int MO_CNT = 768;
constexpr int MO_ROWTAB = 1024;
constexpr int MO_BIAS = 10240;
constexpr int MAXU = 8;
static_assert(MISC_BASE + MO_BIAS + 304 * 4 <= LDS_TOTAL, "lds map");

#define XB_TMO      128
#define XB_XCNT(j)  (256  + 64 * (j))
#define XB_XSUB(j)  (1280 + 64 * (j))
#define XB_XGEN(j)  (2304 + 64 * (j))
#define XB_TOP      3328
#define XB_TOPGEN   3392
#define XCD_BAR_WORDS 3456
#define XB_SPIN_CAP (1u << 18)
__device__ __forceinline__ unsigned xb_ld(unsigned* p)              { return __hip_atomic_load(p, __ATOMIC_RELAXED, __HIP_MEMORY_SCOPE_AGENT); }
__device__ __forceinline__ unsigned xb_add(unsigned* p, unsigned v) { return __hip_atomic_fetch_add(p, v, __ATOMIC_RELAXED, __HIP_MEMORY_SCOPE_AGENT); }
__device__ __forceinline__ unsigned xb_xcc_id() { return (unsigned)__builtin_amdgcn_s_getreg((3 << 11) | 20) & 0xFu; }
#define XB_SPIN(cond, bar) do { unsigned _sp = 0; while (cond) { __builtin_amdgcn_s_sleep(1); \
    if ((++_sp & 255u) == 0u) { if (xb_ld(&(bar)[XB_TMO])) break; if (_sp > XB_SPIN_CAP) { atomicAdd(&(bar)[XB_TMO], 1u); break; } } } } while (0)
struct XcdBarrier { unsigned* bar; unsigned x; volatile LAS unsigned* st; int wave; };
__device__ __forceinline__ XcdBarrier xcd_barrier_post(unsigned* bar, volatile LAS unsigned* st, int wave) {
    XcdBarrier b; b.bar = bar; b.x = xb_xcc_id(); b.st = st; b.wave = wave;
    if (wave == 0 && lane_now() == 0) (void)xb_add(&bar[XB_XCNT(b.x)], 1u);
    return b;
}
__device__ __forceinline__ void xcd_barrier_complete(unsigned* bar, unsigned x, unsigned& nloc, unsigned& nx) {
    const unsigned G = gridDim.x * gridDim.y * gridDim.z;
    unsigned sum, cnt, mine, sp = 0u;
    for (;;) {
        sum = 0u; cnt = 0u; mine = 0u;
#pragma unroll
        for (unsigned j = 0; j < 16; ++j) { const unsigned c = xb_ld(&bar[XB_XCNT(j)]); sum += c; cnt += (c > 0u) ? 1u : 0u; mine = (j == x) ? c : mine; }
        if (sum == G) break;
        __builtin_amdgcn_s_sleep(1);
        if ((++sp & 255u) == 0u) { if (xb_ld(&bar[XB_TMO])) break; if (sp > XB_SPIN_CAP) { atomicAdd(&bar[XB_TMO], 1u); break; } }
    }
    nloc = mine > 0u ? mine : 1u; nx = cnt > 0u ? cnt : 1u;
}
__device__ __forceinline__ void xcd_barrier(const XcdBarrier& b) {
    asm volatile("s_waitcnt vmcnt(0)" ::: "memory");
    __syncthreads();
    if (b.wave == 0 && lane_now() == 0) {
        unsigned* bar = b.bar;
        __builtin_amdgcn_s_waitcnt(0);
        unsigned nloc = b.st[0], nx = b.st[1];
        if (nloc == 0u) { xcd_barrier_complete(bar, b.x, nloc, nx); b.st[0] = nloc; b.st[1] = nx; }
        const unsigned old = xb_add(&bar[XB_XSUB(b.x)], 1u);
        const unsigned gen = old / nloc;
        if (old + 1u == (gen + 1u) * nloc) {
            __builtin_amdgcn_fence(__ATOMIC_RELEASE, "agent");
            asm volatile("s_waitcnt vmcnt(0)" ::: "memory");
            const unsigned og = xb_add(&bar[XB_TOP], 1u);
            const unsigned tg = og / nx;
            if (og + 1u == (tg + 1u) * nx) xb_add(&bar[XB_TOPGEN], 1u);
            else XB_SPIN(xb_ld(&bar[XB_TOPGEN]) == tg, bar);
            __builtin_amdgcn_fence(__ATOMIC_ACQUIRE, "agent");
            xb_add(&bar[XB_XGEN(b.x)], 1u);
            asm volatile("s_waitcnt vmcnt(0)" ::: "memory");
        } else {
            XB_SPIN(xb_ld(&bar[XB_XGEN(b.x)]) == gen, bar);
            __builtin_amdgcn_fence(__ATOMIC_ACQUIRE, "agent");
            asm volatile("s_waitcnt vmcnt(0)" ::: "memory");
        }
    }
    __syncthreads();
}

struct Frame {
    LAS unsigned char* lds;
    unsigned* ctl;
    int tid, lane, wave, G, bid, vcu;
    const float *x, *c, *w_ada, *b_ada, *g_mix, *w_in, *w_pool, *pool_scale, *rel_bias, *w_out, *g_ffn, *w_group, *b_group, *w_router, *b_router, *w_gate, *w_up, *w_down, *g_final;
    float* out; float* mod;
    bf16 *RW, *WpT, *WinP, *Win, *Wout, *Wgu, *Wd, *H, *P, *CAT, *Y, *A, *X1;
    unsigned* MASK; int* TOKLIST; unsigned* TOKINFO;
};

constexpr float Y_SCALE = 8.f;
constexpr float WD_SCALE = 16.f;
constexpr float WGU_SCALE = 32.f;
__device__ __forceinline__ unsigned pk4_fp8(float a, float b, float c, float d) { int p = __builtin_amdgcn_cvt_pk_fp8_f32(a, b, 0, false); p = __builtin_amdgcn_cvt_pk_fp8_f32(c, d, p, true); return (unsigned)p; }
struct P0Tile { const float* src; unsigned char* dst; int ld_src, k0, n0, nvalid, ld_dst, himul, radd, fp8; float scale; };
constexpr int P0_R0 = 32 * 44, P0_R1 = 32 * 32, P0_R2 = 32 * 256, P0_R5 = 64, P0_R6 = 512, P0_R7 = 32;
constexpr int P0_TILES = P0_R0 + P0_R1 + 3 * P0_R2 + P0_R5;
constexpr int P0_ITEMS = P0_TILES + P0_R6 + P0_R7;
constexpr int P0_DEF_E0 = 16;
constexpr int P0_OFF_START = P0_R0 + P0_R1 + 2 * P0_R2 + P0_DEF_E0 * 256, P0_OFF_LEN = (32 - P0_DEF_E0) * 256;
__device__ __forceinline__ P0Tile p0_decode(Frame& F, int it) {
    P0Tile t; t.fp8 = 0; t.scale = 1.f; t.himul = 128; t.radd = 0;
    if (it < P0_R0) { const int kb = it / 44, nb = it % 44; t.src = F.w_in; t.ld_src = PIN; t.k0 = 64 * kb; t.n0 = 1024 + 64 * nb; t.nvalid = PIN; t.dst = (unsigned char*)F.Win; t.ld_dst = DM * 2; return t; } it -= P0_R0;
    if (it < P0_R1) { const int kb = it >> 5, nb = it & 31; t.src = F.w_out; t.ld_src = DM; t.k0 = 64 * kb; t.n0 = 64 * nb; t.nvalid = DM; t.dst = (unsigned char*)F.Wout; t.ld_dst = DM * 2; return t; } it -= P0_R1;
    if (it < 2 * P0_R2) { const int up = it >= P0_R2; if (up) it -= P0_R2; const int e = it >> 8, r = it & 255, kb = r >> 4, nb = r & 15;
        t.src = (up ? F.w_up : F.w_gate) + (size_t)e * DM * DEXP; t.ld_src = DEXP; t.k0 = 128 * kb; t.n0 = 32 * nb; t.nvalid = DEXP; t.dst = (unsigned char*)F.Wgu + (size_t)e * 1024 * DM; t.ld_dst = DM;
        t.himul = 256; t.radd = up ? 128 : 0; t.fp8 = 1; t.scale = WGU_SCALE; return t; } it -= 2 * P0_R2;
    if (it < P0_R2) { const int e = it >> 8, r = it & 255, kb = r >> 6, nb = r & 63;
        t.src = F.w_down + (size_t)e * DEXP * DM; t.ld_src = DM; t.k0 = 128 * kb; t.n0 = 32 * nb; t.nvalid = DM; t.dst = (unsigned char*)F.Wd + (size_t)e * DM * DEXP; t.ld_dst = DEXP; t.fp8 = 1; t.scale = WD_SCALE; return t; } it -= P0_R2;
    { const int g = it >> 4, r = it & 15, kb = r >> 2, nb = r & 3; t.src = F.w_pool + (size_t)g * 65536; t.ld_src = 256; t.k0 = 64 * kb; t.n0 = 64 * nb; t.nvalid = 256; t.dst = (unsigned char*)(F.WpT + (size_t)g * 65536); t.ld_dst = 512; return t; }
}
__device__ __forceinline__ void p0_tile_load(const P0Tile& t, f32x4 (&v)[16], int lane) {
    const int sh = t.fp8 ? 3 : 4, nn = (lane & ((1 << sh) - 1)) * 4, kr = lane >> sh;
#pragma unroll
    for (int i = 0; i < 16; ++i) { v[i] = (f32x4){0.f, 0.f, 0.f, 0.f}; if (t.n0 + nn < t.nvalid) v[i] = *(const f32x4*)(t.src + (size_t)(t.k0 + 16 * kr + i) * t.ld_src + t.n0 + nn); }
}
__device__ __forceinline__ void p0_tile_pack(const P0Tile& t, const f32x4 (&v)[16], u32x4 (&o)[8]) {
    if (t.fp8) {
        const float sc = t.scale;
#pragma unroll
        for (int j = 0; j < 4; ++j) { u32x4 p; p.x = pk4_fp8(v[0][j] * sc, v[1][j] * sc, v[2][j] * sc, v[3][j] * sc); p.y = pk4_fp8(v[4][j] * sc, v[5][j] * sc, v[6][j] * sc, v[7][j] * sc);
            p.z = pk4_fp8(v[8][j] * sc, v[9][j] * sc, v[10][j] * sc, v[11][j] * sc); p.w = pk4_fp8(v[12][j] * sc, v[13][j] * sc, v[14][j] * sc, v[15][j] * sc); o[2 * j] = p; o[2 * j + 1] = p; }
    } else {
#pragma unroll
        for (int j = 0; j < 4; ++j) {
            o[2 * j].x = cvt_pk_bf16(v[0][j], v[1][j]); o[2 * j].y = cvt_pk_bf16(v[2][j], v[3][j]); o[2 * j].z = cvt_pk_bf16(v[4][j], v[5][j]); o[2 * j].w = cvt_pk_bf16(v[6][j], v[7][j]);
            o[2 * j + 1].x = cvt_pk_bf16(v[8][j], v[9][j]); o[2 * j + 1].y = cvt_pk_bf16(v[10][j], v[11][j]); o[2 * j + 1].z = cvt_pk_bf16(v[12][j], v[13][j]); o[2 * j + 1].w = cvt_pk_bf16(v[14][j], v[15][j]); }
    }
}
__device__ __forceinline__ void p0_tile_store(const P0Tile& t, const u32x4 (&o)[8], int lane) {
    const int sh = t.fp8 ? 3 : 4, nn = (lane & ((1 << sh) - 1)) * 4, kr = lane >> sh;
#pragma unroll
    for (int j = 0; j < 4; ++j) { const int ng = t.n0 + nn + j, row = (ng >> 7) * t.himul + (ng & 127) + t.radd;
        unsigned char* d = t.dst + (size_t)row * t.ld_dst;
        const int ko = (t.k0 + 16 * kr) << (t.fp8 ? 0 : 1);
        *(u32x4*)(d + ko) = o[2 * j];
        if (!t.fp8) *(u32x4*)(d + ko + 16) = o[2 * j + 1]; }
}
__device__ __forceinline__ void p0_small_item(Frame& F, int it) {
    const int lane = F.lane;
    if (it < P0_R6) {
        f32x4 v[4][4];
#pragma unroll
        for (int rr = 0; rr < 4; ++rr)
#pragma unroll
            for (int j = 0; j < 4; ++j) v[rr][j] = *(const f32x4*)(F.w_in + (size_t)(it * 4 + rr) * PIN + j * 256 + lane * 4);
#pragma unroll
        for (int rr = 0; rr < 4; ++rr)
#pragma unroll
            for (int j = 0; j < 4; ++j) { u32x2 o; o.x = cvt_pk_bf16(v[rr][j][0], v[rr][j][1]); o.y = cvt_pk_bf16(v[rr][j][2], v[rr][j][3]);
                *(u32x2*)(F.WinP + (size_t)(it * 4 + rr) * 1024 + j * 256 + lane * 4) = o; }
        return; } it -= P0_R6;
    {
        const int k = it * 64 + lane;
        const f32x4 g = *(const f32x4*)(F.w_group + (size_t)k * 4);
        f32x4 r[8];
#pragma unroll
        for (int q = 0; q < 8; ++q) r[q] = *(const f32x4*)(F.w_router + (size_t)k * 32 + 4 * q);
#pragma unroll
        for (int j = 0; j < 48; ++j) { float v = 0.f; if (j < 4) v = g[j]; else if (j < 36) v = r[(j - 4) >> 2][(j - 4) & 3];
            F.RW[(size_t)j * DM + k] = (bf16)(cvt_pk_bf16(v, 0.f) & 0xffffu); }
    }
}
__device__ __forceinline__ void p0_mod_item(Frame& F, int m) {
    LAS float* sil = (LAS float*)F.lds;
    LAS float* part = (LAS float*)(F.lds + 65536);
    const int lane = F.lane, cq = lane & 15, rs = lane >> 4, j0 = 64 * m + 4 * cq;
    const GAS char* wp = (const GAS char*)(F.w_ada + (size_t)(256 * F.wave) * (6 * DM) + 64 * m);
    const unsigned wvo = (unsigned)(rs * (6 * DM) + 4 * cq) * 4u;
#define MOD_LOADW(w, i0) do { _Pragma("unroll") for (int u = 0; u < 16; ++u) { const GAS char* bp_ = wp + (size_t)(4 * ((i0) + u)) * (6 * DM * 4); asm volatile("" : "+s"(bp_)); \
        w[u] = *(const GAS f32x4*)(bp_ + wvo); } } while (0)
#define MOD_FMA(w, i0) do { _Pragma("unroll") for (int u = 0; u < 16; ++u) { const int k = 256 * F.wave + 4 * ((i0) + u) + rs; \
        _Pragma("unroll") for (int b = 0; b < NB; ++b) acc[b] += w[u] * sil[b * DM + k]; \
        if ((u & 1) == 1) __builtin_amdgcn_sched_barrier(0); } } while (0)
    f32x4 wa[16], wb[16];
    { float cv[NB * DM / NTHR];
#pragma unroll
      for (int q = 0; q < NB * DM / NTHR; ++q) { const GAS char* cb_ = (const GAS char*)F.c + (size_t)q * (NTHR * 4); asm volatile("" : "+s"(cb_)); cv[q] = *(const GAS float*)(cb_ + (unsigned)F.tid * 4u); }
      __builtin_amdgcn_sched_barrier(0);
      MOD_LOADW(wa, 0);
      __builtin_amdgcn_sched_barrier(0);
#pragma unroll
      for (int q = 0; q < NB * DM / NTHR; ++q) sil[F.tid + q * NTHR] = cv[q] / (1.f + __expf(-cv[q])); }
    __syncthreads();
    f32x4 acc[NB];
#pragma unroll
    for (int b = 0; b < NB; ++b) acc[b] = (f32x4){0.f, 0.f, 0.f, 0.f};
    MOD_LOADW(wb, 16); __builtin_amdgcn_sched_barrier(0);
    MOD_FMA(wa, 0);
    MOD_LOADW(wa, 32); __builtin_amdgcn_sched_barrier(0);
    MOD_FMA(wb, 16);
    MOD_LOADW(wb, 48); __builtin_amdgcn_sched_barrier(0);
    MOD_FMA(wa, 32);
    MOD_FMA(wb, 48);
#undef MOD_LOADW
#undef MOD_FMA
#pragma unroll
    for (int b = 0; b < NB; ++b)
#pragma unroll
        for (int j = 0; j < 4; ++j) { float v = acc[b][j]; v += __shfl_xor(v, 16); v += __shfl_xor(v, 32); acc[b][j] = v; }
    if (rs == 0) {
#pragma unroll
        for (int b = 0; b < NB; ++b) *(LAS f32x4*)(part + (F.wave * NB + b) * 64 + 4 * cq) = acc[b]; }
    __syncthreads();
    { const int b = F.tid >> 6, col = F.tid & 63; float s = F.b_ada[64 * m + col];
#pragma unroll
        for (int w = 0; w < NWAVES; ++w) s += part[(w * NB + b) * 64 + col];
        F.mod[(size_t)b * (6 * DM) + 64 * m + col] = s; }
    __syncthreads();
}
__device__ __forceinline__ void p0_run(Frame& F, int r, int stride, int a0, int lenA, int b0, int lenB) {
    const int total = lenA + lenB;
#define P0_MAP(d) ((d) < lenA ? a0 + (d) : b0 + ((d) - lenA))
    f32x4 v[16]; u32x4 o[8]; bool loaded = false; P0Tile cur, nxt;
    if (r < total && P0_MAP(r) < P0_TILES) { cur = p0_decode(F, P0_MAP(r)); p0_tile_load(cur, v, F.lane); loaded = true; }
    for (int d = r; d < total; d += stride) {
        const int it = P0_MAP(d);
        if (it < P0_TILES) {
            if (!loaded) { cur = p0_decode(F, it); p0_tile_load(cur, v, F.lane); }
            p0_tile_pack(cur, v, o);
            const int dn = d + stride; loaded = false;
            if (dn < total && P0_MAP(dn) < P0_TILES) { nxt = p0_decode(F, P0_MAP(dn)); p0_tile_load(nxt, v, F.lane); loaded = true; }
            p0_tile_store(cur, o, F.lane);
            cur = nxt;
        } else p0_small_item(F, it - P0_TILES);
    }
#undef P0_MAP
}
constexpr int P0_EARLY_A = P0_R0 + P0_R1, P0_EARLY_B0 = P0_R0 + P0_R1 + 3 * P0_R2, P0_EARLY_BLEN = P0_ITEMS - P0_EARLY_B0;
__device__ __forceinline__ void p0_prologue(Frame& F, int qword) {
    (void)qword;
    __syncthreads();
    for (int m = F.bid; m < 192; m += F.G) p0_mod_item(F, m);
    const int gw = F.bid * NWAVES + F.wave;
    const int r = (F.G == 256) ? ((F.bid >= 192) ? gw - 192 * NWAVES : gw + 64 * NWAVES) : gw;
    p0_run(F, r, F.G * NWAVES, 0, P0_EARLY_A, P0_EARLY_B0, P0_EARLY_BLEN);
}
__device__ __forceinline__ void p0_late(Frame& F) {
    __syncthreads();
    p0_run(F, F.bid * NWAVES + F.wave, F.G * NWAVES, P0_EARLY_A + P0_R2, P0_R2, 0, 0);
}
__device__ __forceinline__ void p0_deferred(Frame& F) {
    if (F.G != 256 || F.bid < 192) return;
    f32x4 va[16], vb[16]; u32x4 o[8]; P0Tile ta, tb, t; constexpr int ST = 64 * NWAVES;
    int ja = (F.bid - 192) * NWAVES + F.wave, jb = ja + ST;
    if (ja < P0_OFF_LEN) { ta = p0_decode(F, P0_OFF_START + ja); p0_tile_load(ta, va, F.lane); }
    if (jb < P0_OFF_LEN) { tb = p0_decode(F, P0_OFF_START + jb); p0_tile_load(tb, vb, F.lane); }
    while (ja < P0_OFF_LEN) {
        p0_tile_pack(ta, va, o); t = ta; ja += 2 * ST;
        if (ja < P0_OFF_LEN) { ta = p0_decode(F, P0_OFF_START + ja); p0_tile_load(ta, va, F.lane); }
        p0_tile_store(t, o, F.lane);
        if (jb >= P0_OFF_LEN) break;
        p0_tile_pack(tb, vb, o); t = tb; jb += 2 * ST;
        if (jb < P0_OFF_LEN) { tb = p0_decode(F, P0_OFF_START + jb); p0_tile_load(tb, vb, F.lane); }
        p0_tile_store(t, o, F.lane);
    }
}

__device__ __forceinline__ void p1_norm_rows(Frame& F, const float* xin, const float* gvec, int sh_off, int sc_off, bf16* hout) {
    const int gw = F.bid * NWAVES + F.wave, NGW = F.G * NWAVES, lane = F.lane;
    for (int grp = gw; grp < NTOK / 8; grp += NGW) {
        const int m0 = grp * 8, b = m0 / SEQ;
        const float* modb = F.mod + (size_t)b * (6 * DM);
        f32x4 gs[8], sh[8];
#pragma unroll
        for (int j = 0; j < 8; ++j) { const int col = 256 * j + 4 * lane; const f32x4 g = *(const f32x4*)(gvec + col), sc = *(const f32x4*)(modb + sc_off + col);
            gs[j] = g * (sc + 1.f); sh[j] = *(const f32x4*)(modb + sh_off + col); }
        f32x4 xa[8], xb[8];
#pragma unroll
        for (int j = 0; j < 8; ++j) xa[j] = *(const f32x4*)(xin + (size_t)m0 * DM + 256 * j + 4 * lane);
#define P1_ROW(CUR, NXT, r) do { \
            if ((r) + 1 < 8) { _Pragma("unroll") for (int j = 0; j < 8; ++j) NXT[j] = *(const f32x4*)(xin + (size_t)(m0 + (r) + 1) * DM + 256 * j + 4 * lane); } \
            float s = 0.f; \
            _Pragma("unroll") for (int j = 0; j < 8; ++j) s += (CUR[j][0] * CUR[j][0] + CUR[j][1] * CUR[j][1]) + (CUR[j][2] * CUR[j][2] + CUR[j][3] * CUR[j][3]); \
            const float rstd = 1.f / sqrtf(wave_sum(s) * (1.f / DM) + EPS); \
            bf16* orow = hout + (size_t)(m0 + (r)) * DM; \
            _Pragma("unroll") for (int j = 0; j < 8; ++j) { const f32x4 y = CUR[j] * rstd * gs[j] + sh[j]; \
                u32x2 o; o.x = cvt_pk_bf16(y[0], y[1]); o.y = cvt_pk_bf16(y[2], y[3]); *(u32x2*)(orow + 256 * j + 4 * lane) = o; } } while (0)
#pragma unroll 1
        for (int rp = 0; rp < 4; ++rp) { P1_ROW(xa, xb, 2 * rp); P1_ROW(xb, xa, 2 * rp + 1); }
#undef P1_ROW
    }
}

template <int W>
__device__ __forceinline__ void p3_window_load(Frame& F, int g, int tp, int lane, bf16x8 (&v)[W]) {
    const int m = 2 * tp + (lane >> 5), t = m & (SEQ - 1), c0 = g * 256 + 8 * (lane & 31);
    const char* up = (const char*)(F.P + (size_t)m * PLD + C_U + c0);
#pragma unroll
    for (int tau = 0; tau < W; ++tau) { const int back = (t - tau >= 0) ? tau : 0; v[tau] = *(const bf16x8*)(up - (size_t)back * (PLD * 2)); }
}
template <int W>
__device__ __forceinline__ void p3_window_finish(Frame& F, int g, int tp, int lane, const bf16x8 (&v)[W]) {
    const int m = 2 * tp + (lane >> 5), t = m & (SEQ - 1), c0 = g * 256 + 8 * (lane & 31);
    float sum[8], self[8];
#pragma unroll
    for (int j = 0; j < 8; ++j) { self[j] = bf2f((bf16)v[0][j]); sum[j] = self[j]; }
#pragma unroll
    for (int tau = 1; tau < W; ++tau) { const float wgt = (t - tau >= 0) ? 1.f : 0.f;
#pragma unroll
        for (int j = 0; j < 8; ++j) sum[j] = fmaf(wgt, bf2f((bf16)v[tau][j]), sum[j]); }
    const float inv = 1.f / (float)((t + 1) < W ? (t + 1) : W);
    u32x4 o; o.x = cvt_pk_bf16(sum[0] * inv - self[0], sum[1] * inv - self[1]); o.y = cvt_pk_bf16(sum[2] * inv - self[2], sum[3] * inv - self[3]);
    o.z = cvt_pk_bf16(sum[4] * inv - self[4], sum[5] * inv - self[5]); o.w = cvt_pk_bf16(sum[6] * inv - self[6], sum[7] * inv - self[7]);
    *(u32x4*)(F.CAT + (size_t)m * DM + c0) = o;
}
__device__ __forceinline__ void p3_window(Frame& F) {
    const int gw = F.bid * NWAVES + F.wave, NGW = F.G * NWAVES, lane = F.lane;
    for (int tp = gw; tp < NTOK / 2; tp += NGW) {
        bf16x8 v2[2], v4[4], v8[8], v16[16];
        p3_window_load<2>(F, 0, tp, lane, v2); p3_window_load<4>(F, 1, tp, lane, v4); p3_window_load<8>(F, 2, tp, lane, v8); p3_window_load<16>(F, 3, tp, lane, v16);
        p3_window_finish<2>(F, 0, tp, lane, v2); p3_window_finish<4>(F, 1, tp, lane, v4); p3_window_finish<8>(F, 2, tp, lane, v8); p3_window_finish<16>(F, 3, tp, lane, v16);
    }
}
__device__ __forceinline__ int half_sum32(int v) {
    v += __builtin_amdgcn_update_dpp(0, v, 0x128, 0xf, 0xf, false);
    v += __builtin_amdgcn_update_dpp(0, v, 0x124, 0xf, 0xf, false);
    v += __builtin_amdgcn_update_dpp(0, v, 0x122, 0xf, 0xf, false);
    v += __builtin_amdgcn_update_dpp(0, v, 0x121, 0xf, 0xf, false);
    v += __shfl_xor(v, 16);
    return v;
}
__device__ __forceinline__ float half_max32(float v) {
    v = fmaxf(v, __builtin_bit_cast(float, __builtin_amdgcn_update_dpp(0, __builtin_bit_cast(int, v), 0x128, 0xf, 0xf, false)));
    v = fmaxf(v, __builtin_bit_cast(float, __builtin_amdgcn_update_dpp(0, __builtin_bit_cast(int, v), 0x124, 0xf, 0xf, false)));
    v = fmaxf(v, __builtin_bit_cast(float, __builtin_amdgcn_update_dpp(0, __builtin_bit_cast(int, v), 0x122, 0xf, 0xf, false)));
    v = fmaxf(v, __builtin_bit_cast(float, __builtin_amdgcn_update_dpp(0, __builtin_bit_cast(int, v), 0x121, 0xf, 0xf, false)));
    v = fmaxf(v, __shfl_xor(v, 16));
    return v;
}
typedef short s16x2_t __attribute__((ext_vector_type(2)));
typedef float f32x2_t __attribute__((ext_vector_type(2)));
typedef __bf16 bf16x2_t __attribute__((ext_vector_type(2)));
__device__ __forceinline__ unsigned cvt_pk_bf16_v(float lo, float hi) { const f32x2_t v = {lo, hi}; return __builtin_bit_cast(unsigned, __builtin_convertvector(v, bf16x2_t)); }
__device__ __forceinline__ unsigned relu_pk(unsigned p) { s16x2_t v = __builtin_bit_cast(s16x2_t, p); v = __builtin_elementwise_max(v, (s16x2_t){0, 0}); return __builtin_bit_cast(unsigned, v); }
__device__ __forceinline__ float relu_asm(float x) { const int i = __builtin_bit_cast(int, x); return __builtin_bit_cast(float, i > 0 ? i : 0); }
constexpr int IDX_CH = 512;
__device__ __forceinline__ void p3_indexer_item(Frame& F, int conv_it, const bf16* Pb, unsigned* Mb, int tb, LAS unsigned char* kl, int tid, int wave, int lane) {
    asm volatile("" : "+v"(lane), "+v"(tid));
    const int r = lane & 31, hi = lane >> 5, t0 = tb + 2 * wave, ktd = t0 >> 5, tq = t0 + hi;
    const int nch = ((tb + 15) / IDX_CH) + 1;
    const GAS char* Pc = (const GAS char*)Pb;
    const unsigned srow = (unsigned)(tid >> 3), sch = (unsigned)(tid & 7);
    const unsigned sgo = (srow * PLD + C_KI + sch * 8) * 2u;
    const unsigned slo = srow * 128u + ((sch ^ ((srow >> 1) & 7u)) * 16u);
    bf16x8 stg[8];
#define IDX_LOAD(c) do { _Pragma("unroll") for (int i = 0; i < 8; ++i) { const GAS char* bp_ = Pc + (size_t)((c) * IDX_CH + 64 * i) * (PLD * 2); asm volatile("" : "+s"(bp_)); \
        stg[i] = *(const GAS bf16x8*)(bp_ + sgo); } } while (0)
    IDX_LOAD(0);
    bf16x8 aq[4];
    { const unsigned qoff = (unsigned)((t0 + (r >> 4)) * PLD + C_QI + (r & 15) * 64 + 8 * hi) * 2u;
#pragma unroll
      for (int j = 0; j < 4; ++j) aq[j] = *(const GAS bf16x8*)(Pc + qoff + 32 * j); }
    bf16x8 a0, a1;
    { const GAS char* w0p = Pc + (size_t)t0 * (PLD * 2) + (C_WI + 4 * hi) * 2; const GAS char* w1p = w0p + PLD * 2;
      const u32x2 x0 = *(const GAS u32x2*)w0p, x1 = *(const GAS u32x2*)(w0p + 16), y0 = *(const GAS u32x2*)w1p, y1 = *(const GAS u32x2*)(w1p + 16);
      u32x4 wa = {x0.x, x0.y, x1.x, x1.y}, wb = {y0.x, y0.y, y1.x, y1.y};
      if (r != 0) wa = (u32x4){0u, 0u, 0u, 0u};
      if (r != 4) wb = (u32x4){0u, 0u, 0u, 0u};
      a0 = *reinterpret_cast<bf16x8*>(&wa); a1 = *reinterpret_cast<bf16x8*>(&wb); }
    float key[64];
    float vmax = -__builtin_inff(), vmin = __builtin_inff(), s1 = 0.f, s2 = 0.f;
    unsigned kro[4];
#pragma unroll
    for (int j = 0; j < 4; ++j) kro[j] = (unsigned)r * 128u + ((((unsigned)(2 * j + hi)) ^ (((unsigned)r >> 1) & 7u)) * 16u);
    for (int crep = 0; crep < ((PROBE_DUP == 32) ? 2 : 1); ++crep) {
    if (crep) { IDX_LOAD(0); }
#pragma unroll
    for (int c = 0; c < SEQ / IDX_CH; ++c) {
        if (c < nch) {
            __syncthreads();
#pragma unroll
            for (int i = 0; i < 8; ++i) *(LAS bf16x8*)(kl + slo + i * 8192) = stg[i];
            __syncthreads();
            if (c + 1 < nch) IDX_LOAD(c + 1);
            if (c == 0 && crep == 0) {
                const int r_ = conv_it & 255; const GAS char* gsrc_ = (const GAS char*)(F.w_gate + (size_t)(conv_it >> 8) * DM * DEXP + (size_t)(128 * (r_ >> 4)) * DEXP + 32 * (r_ & 15))
                    + ((size_t)(16 * (lane >> 3)) * DEXP + (lane & 7) * 4) * 4;
#pragma unroll
                for (int i = 0; i < 8; ++i) { const GAS char* gp_ = gsrc_ + (size_t)i * (DEXP * 4); const unsigned la_ = (unsigned)(size_t)(kl + 65536 + wave * 8192 + i * 1024);
                    asm volatile("s_mov_b32 m0, %1\n\tglobal_load_lds_dwordx4 %0, off" :: "v"(gp_), "s"(la_) : "m0", "memory"); }
            }
#pragma unroll
            for (int g = 0; g < IDX_CH / 128; ++g) {
                const int kt0 = c * (IDX_CH / 32) + 4 * g;
                if (kt0 <= ktd) {
#define IDX_PACK(d, b0, b1) do { \
                        b0.x = relu_pk(cvt_pk_bf16_v(d[0], d[1])); b0.y = relu_pk(cvt_pk_bf16_v(d[2], d[3])); b0.z = relu_pk(cvt_pk_bf16_v(d[4], d[5])); b0.w = relu_pk(cvt_pk_bf16_v(d[6], d[7])); \
                        b1.x = relu_pk(cvt_pk_bf16_v(d[8], d[9])); b1.y = relu_pk(cvt_pk_bf16_v(d[10], d[11])); b1.z = relu_pk(cvt_pk_bf16_v(d[12], d[13])); b1.w = relu_pk(cvt_pk_bf16_v(d[14], d[15])); } while (0)
#define IDX_TAKE(kt, e) do { if ((kt) < ktd) { const float e0_ = e[0]; key[kt] = e0_; vmax = fmaxf(vmax, e0_); vmin = fminf(vmin, e0_); s1 += e0_; s2 = fmaf(e0_, e0_, s2); }   \
                        else { const bool ok = ((kt) * 32 + r <= tq); const float sv = ok ? e[0] : -__builtin_inff(); \
                        key[kt] = sv; vmax = fmaxf(vmax, sv); vmin = fminf(vmin, ok ? e[0] : __builtin_inff()); \
                        { const float z0 = ok ? e[0] : 0.f; s1 += z0; s2 = fmaf(z0, z0, s2); } } } while (0)
#define IDX_FRAGS(fr, tl) do { _Pragma("unroll") for (int j = 0; j < 4; ++j) { fr[j] = *(const LAS bf16x8*)((tl) + kro[j]); fr[4 + j] = *(const LAS bf16x8*)((tl) + 4096 + kro[j]); } } while (0)
#define IDX_SCORE(fr, dA, dB) do { _Pragma("unroll") for (int j = 0; j < 4; ++j) dA = __builtin_amdgcn_mfma_f32_32x32x16_bf16(aq[j], fr[j], dA, 0, 0, 0); \
                        _Pragma("unroll") for (int j = 0; j < 4; ++j) dB = __builtin_amdgcn_mfma_f32_32x32x16_bf16(aq[j], fr[4 + j], dB, 0, 0, 0); } while (0)
#define IDX_REDUCE(dA, dB, eA, eB) do { u32x4 b0, b1, c0, c1; \
                        IDX_PACK(dA, b0, b1); asm volatile("s_nop 1" ::: "memory"); \
                        eA = __builtin_amdgcn_mfma_f32_32x32x16_bf16(a0, *reinterpret_cast<bf16x8*>(&b0), eA, 0, 0, 0); \
                        eA = __builtin_amdgcn_mfma_f32_32x32x16_bf16(a1, *reinterpret_cast<bf16x8*>(&b1), eA, 0, 0, 0); \
                        IDX_PACK(dB, c0, c1); asm volatile("s_nop 1" ::: "memory"); \
                        eB = __builtin_amdgcn_mfma_f32_32x32x16_bf16(a0, *reinterpret_cast<bf16x8*>(&c0), eB, 0, 0, 0); \
                        eB = __builtin_amdgcn_mfma_f32_32x32x16_bf16(a1, *reinterpret_cast<bf16x8*>(&c1), eB, 0, 0, 0); } while (0)
                    {
                        const LAS unsigned char* tl = kl + (4 * g) * 4096;
                        bf16x8 fr[8];
                        IDX_FRAGS(fr, tl);
                        __builtin_amdgcn_sched_barrier(0);
                        f32x16 dA = {}, dB = {}, eA = {}, eB = {};
                        IDX_SCORE(fr, dA, dB);
                        __builtin_amdgcn_sched_barrier(0);
                        IDX_FRAGS(fr, tl + 8192);
                        IDX_REDUCE(dA, dB, eA, eB);
                        __builtin_amdgcn_sched_barrier(0);
                        IDX_TAKE(kt0, eA); IDX_TAKE(kt0 + 1, eB);
                        __builtin_amdgcn_sched_barrier(0);
                        f32x16 dC = {}, dD = {}, eC = {}, eD = {};
                        IDX_SCORE(fr, dC, dD);
                        __builtin_amdgcn_sched_barrier(0);
                        IDX_REDUCE(dC, dD, eC, eD);
                        __builtin_amdgcn_sched_barrier(0);
                        IDX_TAKE(kt0 + 2, eC); IDX_TAKE(kt0 + 3, eD);
                    }
#undef IDX_FRAGS
#undef IDX_SCORE
#undef IDX_REDUCE
#undef IDX_PACK
#undef IDX_TAKE
                } else {
#pragma unroll
                    for (int q = 0; q < 4; ++q) key[kt0 + q] = -__builtin_inff();
                }
            }
        } else {
#pragma unroll
            for (int q = 0; q < IDX_CH / 32; ++q) key[c * (IDX_CH / 32) + q] = -__builtin_inff();
        }
    }
    }
#undef IDX_LOAD
    int ln = lane; asm volatile("" : "+v"(ln));
    f32x4 cv[16];
    { const int r = conv_it & 255; const float* gsrc = F.w_gate + (size_t)(conv_it >> 8) * DM * DEXP + (size_t)(128 * (r >> 4)) * DEXP + 32 * (r & 15) + (size_t)(16 * (ln >> 3)) * DEXP + (ln & 7) * 4;
#pragma unroll
      for (int i = 8; i < 16; ++i) cv[i] = *(const f32x4*)(gsrc + (size_t)i * DEXP); }
    float T = -3.0e38f;
    const bool need = (tq + 1) > TOPK;
    for (int srep = 0; srep < ((PROBE_DUP == 31) ? 2 : 1); ++srep)
    if (__any(need)) {
#pragma unroll
        for (int o = 1; o < 32; o <<= 1) { vmax = fmaxf(vmax, __shfl_xor(vmax, o)); vmin = fminf(vmin, __shfl_xor(vmin, o)); s1 += __shfl_xor(s1, o); s2 += __shfl_xor(s2, o); }
        const float nf = (float)(tq + 1), mu = s1 / nf, sd = sqrtf(fmaxf(s2 / nf - mu * mu, 1e-20f));
        float zq; { const float pu = (float)TOPK / nf;
            const float q = fminf(pu, 1.f - pu), t = sqrtf(-2.f * __logf(fmaxf(q, 1e-6f)));
            const float zz = t - (2.515517f + t * (0.802853f + t * 0.010328f)) / (1.f + t * (1.432788f + t * (0.189269f + t * 0.001308f)));
            zq = (pu < 0.5f) ? zz : -zz; }
        const float dens = nf * 0.3989423f * __expf(-0.5f * zq * zq) / sd;
        float lo = vmin, hi = vmax, prev = mu + zq * sd, flo = (float)(tq + 1) - 255.5f, fhi = 1.f - 255.5f; int pcnt = TOPK, side = 0, chi = 1; bool done = !need;
        for (int it = 0; it < 96; ++it) {
            const float mid = 0.5f * lo + 0.5f * hi;
            float cand = ((it & 3) == 3) ? mid : lo + (hi - lo) * flo / (flo - fhi);
            if (it == 0) cand = prev;
            if (it == 1) cand = prev + ((float)(pcnt - TOPK) + 0.5f) / dens;
            if (!(cand > lo && cand < hi)) cand = mid;
            if (!(cand > lo && cand < hi)) done = true;
            if (__all(done)) break;
            int cnt = 0;
#pragma unroll
            for (int g = 0; g < 8; ++g) {
                if (8 * g <= ktd) {
#define CNT4(k0, k1, k2, k3) asm volatile("v_cmp_ge_f32_e64 s[88:89], %1, %5\n\tv_cmp_ge_f32_e64 s[90:91], %2, %5\n\tv_cmp_ge_f32_e64 s[92:93], %3, %5\n\tv_cmp_ge_f32_e64 s[94:95], %4, %5\n\t" \
                        "v_addc_co_u32_e64 %0, s[88:89], 0, %0, s[88:89]\n\tv_addc_co_u32_e64 %0, s[90:91], 0, %0, s[90:91]\n\tv_addc_co_u32_e64 %0, s[92:93], 0, %0, s[92:93]\n\tv_addc_co_u32_e64 %0, s[94:95], 0, %0, s[94:95]" \
                        : "+v"(cnt) : "v"(k0), "v"(k1), "v"(k2), "v"(k3), "v"(cand) : "s88", "s89", "s90", "s91", "s92", "s93", "s94", "s95")
                    CNT4(key[8 * g + 0], key[8 * g + 1], key[8 * g + 2], key[8 * g + 3]);
                    CNT4(key[8 * g + 4], key[8 * g + 5], key[8 * g + 6], key[8 * g + 7]);
#undef CNT4
                }
            }
            cnt = half_sum32(cnt);
            if (!done) {
                if (cnt >= TOPK) { lo = cand; flo = (float)cnt - 255.5f; if (side == 1) fhi *= 0.5f; side = 1; }
                else { hi = cand; fhi = (float)cnt - 255.5f; chi = cnt; if (side == 2) flo *= 0.5f; side = 2; }
                if (cnt == TOPK) done = true; }
            prev = cand; pcnt = cnt;
            const bool snap = !done && chi == TOPK - 1;
            if (__any(snap)) {
                float m = -__builtin_inff();
#pragma unroll
                for (int g = 0; g < 8; ++g) {
                    if (8 * g <= ktd) {
#pragma unroll
                        for (int q = 0; q < 8; ++q) m = fmaxf(m, key[8 * g + q] < hi ? key[8 * g + q] : -__builtin_inff());
                    }
                }
                m = half_max32(m);
                if (snap) { lo = m; done = true; }
            }
        }
        if (need) T = lo;
    }
    unsigned mw0 = 0u, mw1 = 0u;
#pragma unroll
    for (int kt = 0; kt < 64; ++kt) {
        if (kt <= ktd) { const unsigned long long bal = __ballot(key[kt] >= T);
            const unsigned blo = (unsigned)bal, bhi = (unsigned)(bal >> 32);
            asm volatile("s_nop 4\n\tv_writelane_b32 %0, %2, %4\n\tv_writelane_b32 %1, %3, %4" : "+v"(mw0), "+v"(mw1) : "s"(blo), "s"(bhi), "n"(kt)); }
    }
    Mb[(size_t)t0 * 64 + ln] = mw0; Mb[(size_t)(t0 + 1) * 64 + ln] = mw1;
    { P0Tile t; const int r = conv_it & 255; t.src = nullptr; t.ld_src = DEXP; t.k0 = 128 * (r >> 4); t.n0 = 32 * (r & 15); t.nvalid = DEXP; t.dst = (unsigned char*)F.Wgu + (size_t)(conv_it >> 8) * 1024 * DM; t.ld_dst = DM;
      t.himul = 256; t.radd = 0; t.fp8 = 1; t.scale = WGU_SCALE;
      asm volatile("s_waitcnt vmcnt(0)" ::: "memory");
#pragma unroll
      for (int i = 0; i < 8; ++i) cv[i] = *(const LAS f32x4*)(kl + 65536 + wave * 8192 + i * 1024 + ln * 16);
      u32x4 co[8]; p0_tile_pack(t, cv, co); p0_tile_store(t, co, ln); }
}
__device__ __forceinline__ void p3_indexer(Frame& F) {
    for (int wgi = F.vcu; wgi < 256; wgi += F.G) {
        const int b = wgi >> 5, j = wgi & 31;
#pragma unroll 1
        for (int s = 0; s < 4; ++s) { const int q16 = (s == 0) ? j : (s == 1) ? 63 - j : (s == 2) ? 64 + j : 127 - j;
            p3_indexer_item(F, (wgi * 4 + s) * NWAVES + F.wave, F.P + (size_t)b * SEQ * PLD, F.MASK + (size_t)b * SEQ * 64, q16 * 16, F.lds, F.tid, F.wave, F.lane); }
    }
}

namespace att {
constexpr int D = 128, QBLK = 32, KVBLK = 64, QB = 256;
constexpr int SHM_V = KVBLK * D * 2, SHM_K = KVBLK * D * 2;
constexpr int ATT_LDS = 2 * SHM_V + 2 * SHM_K + NWAVES * 64 * 4;
constexpr float SCALE = 0.08838834764831845f, THR = 8.f;
constexpr int RMAX = 207, NBIAS = 304;
#define KSWZ(row, colB) ((row) * 256 + ((colB) ^ (((row) & 7) << 4)))
#define SBAR() __builtin_amdgcn_sched_barrier(0)
__device__ __forceinline__ int v_st(int k, int c) { const int kk = (k & ~0xC) | ((k & 4) << 1) | ((k & 8) >> 1); return ((kk >> 3) * 4 + (c >> 5)) * 512 + ((kk & 7) * 32 + (c & 31)) * 2; }
__device__ __forceinline__ int v_rd_base(int lane) { return ((lane & 3) << 3) | (((lane >> 2) & 3) << 6) | (((lane >> 4) & 1) << 5) | (((lane >> 5) & 1) << 8); }
constexpr int v_rd_off(int d0, int ks, int half) { return d0 * 512 + ks * 4096 + half * 2048; }
__device__ __forceinline__ int crow(int r, int hi) { return (r & 3) + 8 * (r >> 2) + 4 * hi; }

__device__ __forceinline__ void mask_bias_tile(f32x16& p0, f32x16& p1, u32x2 mk, int hi, bool near, const LAS float* tb) {
    const float NEG = -__builtin_inff();
    const unsigned w0 = mk.x >> (4 * hi), w1 = mk.y >> (4 * hi);
    if (near) {
#pragma unroll
        for (int r = 0; r < 16; ++r) { const int c = (r & 3) + 8 * (r >> 2); p0[r] += tb[c]; p1[r] += tb[c + 32]; }
    }
    const int negb = __float_as_int(NEG);
#pragma unroll
    for (int r = 0; r < 16; ++r) { const int c = (r & 3) + 8 * (r >> 2);
        const int m0 = __builtin_amdgcn_sbfe((int)w0, c, 1), m1 = __builtin_amdgcn_sbfe((int)w1, c, 1);
        const float x0 = p0[r], x1 = p1[r];
        p0[r] = __int_as_float((__float_as_int(x0) & m0) | (negb & ~m0));
        p1[r] = __int_as_float((__float_as_int(x1) & m1) | (negb & ~m1)); }
}
__device__ __forceinline__ void partialSM(f32x16& p0, f32x16& p1, float& m_reg, float& mn, float& alpha) {
    float pmax = p0[0];
#pragma unroll
    for (int r = 1; r < 16; ++r) pmax = fmaxf(pmax, p0[r]);
#pragma unroll
    for (int r = 0; r < 16; ++r) pmax = fmaxf(pmax, p1[r]);
    { auto rr = __builtin_amdgcn_permlane32_swap(__float_as_uint(pmax), __float_as_uint(pmax), false, false);
      pmax = fmaxf(__uint_as_float(rr[0]), __uint_as_float(rr[1])); }
    constexpr float C2 = 1.4426950408889634f * SCALE;
    if (__builtin_expect(__all((pmax - m_reg) * SCALE <= THR), 1)) { mn = m_reg; alpha = 1.f; }
    else { mn = fmaxf(m_reg, pmax); alpha = __builtin_amdgcn_exp2f((m_reg - mn) * C2); m_reg = mn; }
    const float mnL = -mn * C2;
#pragma unroll
    for (int r = 0; r < 16; ++r) p0[r] = fmaf(p0[r], C2, mnL);
#pragma unroll
    for (int r = 0; r < 16; ++r) p1[r] = fmaf(p1[r], C2, mnL);
#pragma unroll
    for (int r = 0; r < 16; ++r) p0[r] = __builtin_amdgcn_exp2f(p0[r]);
}
__device__ __forceinline__ void finishSM(f32x16& p0, f32x16& p1, float alpha, float& l_reg, bf16x8& pa0, bf16x8& pa1, bf16x8& pa2, bf16x8& pa3) {
#pragma unroll
    for (int r = 0; r < 16; ++r) p1[r] = __builtin_amdgcn_exp2f(p1[r]);
    float ps = 0;
#pragma unroll
    for (int r = 0; r < 16; ++r) ps += p0[r];
#pragma unroll
    for (int r = 0; r < 16; ++r) ps += p1[r];
    { auto rr = __builtin_amdgcn_permlane32_swap(__float_as_uint(ps), __float_as_uint(ps), false, false);
      ps = __uint_as_float(rr[0]) + __uint_as_float(rr[1]); }
    l_reg = l_reg * alpha + ps;
#define PK4(P, B_, OUT) do { unsigned a0 = cvt_pk_bf16(P[B_+0], P[B_+1]), a1 = cvt_pk_bf16(P[B_+2], P[B_+3]);                          \
        unsigned b0 = cvt_pk_bf16(P[B_+4], P[B_+5]), b1 = cvt_pk_bf16(P[B_+6], P[B_+7]);                                             \
        auto r0 = __builtin_amdgcn_permlane32_swap(a0, b0, false, false); auto r1 = __builtin_amdgcn_permlane32_swap(a1, b1, false, false); \
        u32x4 w = {r0[0], r1[0], r0[1], r1[1]}; OUT = *reinterpret_cast<bf16x8*>(&w); } while (0)
    PK4(p0, 0, pa0); PK4(p0, 8, pa1); PK4(p1, 0, pa2); PK4(p1, 8, pa3);
#undef PK4
}
template <int KB>
__device__ __forceinline__ void qkt(f32x16& p0, f32x16& p1, const char* K_lds, const char* Qw, int r32, int hi) {
    p0 = f32x16{}; p1 = f32x16{};
    const char* kb[4]; const char* qb[4];
#pragma unroll
    for (int dd = 0; dd < 4; ++dd) { kb[dd] = K_lds + KB * SHM_K + KSWZ(r32, (dd * 16 + hi * 8) * 2); qb[dd] = Qw + KSWZ(r32, (dd * 16 + hi * 8) * 2); }
#pragma unroll
    for (int d0 = 0; d0 < 8; ++d0) { const char* a = kb[d0 & 3] + (d0 >> 2) * 128;
        bf16x8 b0 = *reinterpret_cast<const bf16x8*>(a);
        bf16x8 b1 = *reinterpret_cast<const bf16x8*>(a + 32 * 256);
        bf16x8 q = *reinterpret_cast<const bf16x8*>(qb[d0 & 3] + (d0 >> 2) * 128);
        p0 = __builtin_amdgcn_mfma_f32_32x32x16_bf16(b0, q, p0, 0, 0, 0);
        p1 = __builtin_amdgcn_mfma_f32_32x32x16_bf16(b1, q, p1, 0, 0, 0); }
    __builtin_amdgcn_sched_group_barrier(0x100, 3, 0);
#pragma unroll
    for (int d0 = 0; d0 < 7; ++d0) { __builtin_amdgcn_sched_group_barrier(0x100, 3, 0); __builtin_amdgcn_sched_group_barrier(0x008, 2, 0); }
    __builtin_amdgcn_sched_group_barrier(0x008, 2, 0);
}
template <int VB>
__device__ __forceinline__ void pv_tile(f32x16* o, int vb0, bf16x8 pa0, bf16x8 pa1, bf16x8 pa2, bf16x8 pa3) {
#define TRRD(dst, off) asm volatile("ds_read_b64_tr_b16 %0, %1 offset:%2" : "=&v"(dst) : "v"(vb0), "i"(off) : "memory")
#define PV_D0(d0) do { s16x4 l0, l1, l2, l3, h0, h1, h2, h3; constexpr int b_ = VB * SHM_V + v_rd_off(d0, 0, 0); \
        TRRD(l0, b_); TRRD(h0, b_ + 2048); TRRD(l1, b_ + 4096); TRRD(h1, b_ + 6144); TRRD(l2, b_ + 8192); TRRD(h2, b_ + 10240); TRRD(l3, b_ + 12288); TRRD(h3, b_ + 14336); \
        asm volatile("s_waitcnt lgkmcnt(0)" ::: "memory"); SBAR();   \
        o[d0] = __builtin_amdgcn_mfma_f32_32x32x16_bf16(pa0, (bf16x8){l0[0], l0[1], l0[2], l0[3], h0[0], h0[1], h0[2], h0[3]}, o[d0], 0, 0, 0);   \
        o[d0] = __builtin_amdgcn_mfma_f32_32x32x16_bf16(pa1, (bf16x8){l1[0], l1[1], l1[2], l1[3], h1[0], h1[1], h1[2], h1[3]}, o[d0], 0, 0, 0);   \
        o[d0] = __builtin_amdgcn_mfma_f32_32x32x16_bf16(pa2, (bf16x8){l2[0], l2[1], l2[2], l2[3], h2[0], h2[1], h2[2], h2[3]}, o[d0], 0, 0, 0);   \
        o[d0] = __builtin_amdgcn_mfma_f32_32x32x16_bf16(pa3, (bf16x8){l3[0], l3[1], l3[2], l3[3], h3[0], h3[1], h3[2], h3[3]}, o[d0], 0, 0, 0); } while (0)
    PV_D0(0); PV_D0(1); PV_D0(2); PV_D0(3);
#undef PV_D0
#undef TRRD
}
struct BlockRef { const bf16* Q; const bf16* K; bf16* O; const unsigned* M; int P0; };
struct Seam { bf16x8 st_v0, st_v1, st_k0, st_k1; u32x2 mkA; };
constexpr int Q_OFF = 2 * SHM_V + 2 * SHM_K + NWAVES * 64 * 4;
constexpr int ATT_LDS_ALL = Q_OFF + NWAVES * 8192;
#define VMW() asm volatile("s_waitcnt vmcnt(0)" ::: "memory")
#define KVROW (PLD * 2)
#define SLOAD_H(Kp, k0) do { const char* kt_ = (const char*)(Kp) + (size_t)(k0) * KVROW; \
        S.st_k0 = *(const bf16x8*)(kt_ + kvo); S.st_k1 = *(const bf16x8*)(kt_ + 32 * KVROW + kvo); \
        S.st_v0 = *(const bf16x8*)(kt_ + (C_V - C_K) * 2 + kvo); S.st_v1 = *(const bf16x8*)(kt_ + 32 * KVROW + (C_V - C_K) * 2 + kvo); } while (0)
#define SWRITE_HK(bf) do { *(bf16x8*)(K_lds + (bf) * SHM_K + kws) = S.st_k0; *(bf16x8*)(K_lds + (bf) * SHM_K + kws + 32 * 256) = S.st_k1; } while (0)
#define SWRITE_HV(bf) do { *(bf16x8*)(V_lds + (bf) * SHM_V + vst0) = S.st_v0; *(bf16x8*)(V_lds + (bf) * SHM_V + vst1) = S.st_v1; } while (0)
#define SWRITE_H(bf) do { SWRITE_HV(bf); SWRITE_HK(bf); } while (0)
#define MLOAD(ref, tile) (*(const u32x2*)((const char*)((ref).M + (size_t)wid * QBLK * 64 + 2 * (tile)) + mro))
__device__ __forceinline__ void attn_prime(const BlockRef& cur, char* lds, Seam& S, const int wid, const int lane) {
    const int tid = wid * 64 + lane, r32 = lane & 31;
    const int sr = tid >> 4, sc = (tid & 15) * 8, kws = KSWZ(sr, sc * 2); char* K_lds = lds + 2 * SHM_V;
    const unsigned kvo = (unsigned)(sr * PLD + sc) * 2u, mro = (unsigned)r32 * 256u;
    SLOAD_H(cur.K, 0); S.mkA = MLOAD(cur, 0); VMW(); SWRITE_HK(0);
    __syncthreads();
}
__device__ __forceinline__ void attn_block(const BlockRef& cur, const BlockRef& nxt, char* lds, const LAS float* btab, Seam& S, const int wid, const int lane) {
    const int tid = wid * 64 + lane, r32 = lane & 31, hi = lane >> 5;
    const int NT = (cur.P0 + QB - 1) / KVBLK + 1;
    const int qlo = cur.P0 + wid * QBLK, pos = qlo + r32;
    char* V_lds = lds; char* K_lds = lds + 2 * SHM_V; char* Qw = lds + Q_OFF + wid * 8192;
    float* ws = (float*)(lds + 2 * SHM_V + 2 * SHM_K) + wid * 64; float* li_l = ws, * al_l = ws + 32;
    float m_reg = -1e30f, l_reg = 0; f32x16 o[4] = {};
    const int sr = tid >> 4, sc = (tid & 15) * 8, vst0 = v_st(sr, sc), vst1 = v_st(32 + sr, sc), kws = KSWZ(sr, sc * 2);
    const unsigned kvo = (unsigned)(sr * PLD + sc) * 2u, mro = (unsigned)r32 * 256u;
    const int vb0 = (int)(uintptr_t)V_lds + v_rd_base(lane);
    const bf16* Kh = cur.K;
    u32x2 mkA = S.mkA, mkB = (u32x2){0u, 0u};
    {
        const char* qg = (const char*)(cur.Q + (size_t)wid * QBLK * PLD) + (unsigned)(r32 * PLD + hi * 8) * 2u;
        bf16x8 qv[8];
#pragma unroll
        for (int d0 = 0; d0 < 8; ++d0) qv[d0] = *(const bf16x8*)(qg + d0 * 32);
#pragma unroll
        for (int d0 = 0; d0 < 8; ++d0) *(bf16x8*)(Qw + KSWZ(r32, (d0 * 16 + hi * 8) * 2)) = qv[d0];
        asm volatile("s_waitcnt lgkmcnt(0)" ::: "memory");
    }
#define RESC(a) do { if (__any((a) < 1.f)) { if (hi == 0) al_l[r32] = (a); asm volatile("s_waitcnt lgkmcnt(0)" ::: "memory");              \
                     for (int d_ = 0; d_ < 4; ++d_) for (int r = 0; r < 16; ++r) o[d_][r] *= al_l[crow(r, hi)]; } } while (0)
#define KBASE(t) ((t) * KVBLK)
#define MASKT(P0_, P1_, mk, t) do { const int kb_ = KBASE(t); const bool near_ = (kb_ <= qlo + QBLK - 1) && (kb_ > qlo - 176); \
        mask_bias_tile(P0_, P1_, mk, hi, near_, btab + (RMAX - (pos - kb_ - 4 * hi))); } while (0)
    f32x16 pA0, pA1, pB0, pB1; float mnA, mnB, alA, alB; bf16x8 pa0, pa1, pa2, pa3;
    SWRITE_HV(0); SBAR();
    if (NT > 1) { SLOAD_H(Kh, KBASE(1)); mkB = MLOAD(cur, 1); }
    SBAR(); qkt<0>(pA0, pA1, K_lds, Qw, r32, hi);
    MASKT(pA0, pA1, mkA, 0); partialSM(pA0, pA1, m_reg, mnA, alA);
    if (NT > 1) { VMW(); SWRITE_H(1); }
    __syncthreads();
#define HALF_STEP(PX0, PX1, mnX, alX, mkX, PY0, PY1, alY, mkY, t, KB, VB, SB) do {                                                      \
        SBAR(); qkt<KB>(PX0, PX1, K_lds, Qw, r32, hi);                                             \
        finishSM(PY0, PY1, alY, l_reg, pa0, pa1, pa2, pa3); SBAR();                                                           \
        if ((t) + 1 < NT) { SLOAD_H(Kh, KBASE((t) + 1)); mkY = MLOAD(cur, (t) + 1); SBAR(); }                                               \
        pv_tile<VB>(o, vb0, pa0, pa1, pa2, pa3); MASKT(PX0, PX1, mkX, (t)); partialSM(PX0, PX1, m_reg, mnX, alX);                                        \
        __syncthreads();                                                                                                      \
        if ((t) + 1 < NT) { VMW(); SWRITE_H(SB); }                                                                          \
        RESC(alX); __syncthreads(); } while (0)
    for (int t = 1; t + 1 < NT; t += 2) {
        HALF_STEP(pB0, pB1, mnB, alB, mkB, pA0, pA1, alA, mkA, t, 1, 0, 0);
        HALF_STEP(pA0, pA1, mnA, alA, mkA, pB0, pB1, alB, mkB, t + 1, 0, 1, 1);
    }
    const bool even = (NT & 1) == 0;
    if (even) { SBAR(); qkt<1>(pB0, pB1, K_lds, Qw, r32, hi); SBAR(); }
    SLOAD_H(nxt.K, 0); mkA = MLOAD(nxt, 0); SBAR();
    finishSM(pA0, pA1, alA, l_reg, pa0, pa1, pa2, pa3); SBAR();
    pv_tile<0>(o, vb0, pa0, pa1, pa2, pa3);
    if (even) { MASKT(pB0, pB1, mkB, NT - 1); partialSM(pB0, pB1, m_reg, mnB, alB); __syncthreads(); RESC(alB);
        finishSM(pB0, pB1, alB, l_reg, pa0, pa1, pa2, pa3); SBAR(); pv_tile<1>(o, vb0, pa0, pa1, pa2, pa3); }
    SBAR(); VMW(); SWRITE_HK(0); SBAR();
    S.mkA = mkA;
    if (hi == 0) li_l[r32] = l_reg; asm volatile("s_waitcnt lgkmcnt(0)" ::: "memory");
    float rli[16];
#pragma unroll
    for (int r = 0; r < 16; ++r) rli[r] = __builtin_amdgcn_rcpf(li_l[crow(r, hi)]);
    {
        bf16* ol = (bf16*)Qw;
#pragma unroll
        for (int r = 0; r < 16; ++r) { const int orow = crow(r, hi);
#pragma unroll
            for (int d0 = 0; d0 < 4; ++d0) ol[orow * D + d0 * 32 + r32] = (bf16)(cvt_pk_bf16(o[d0][r] * rli[r], 0.f) & 0xffffu); }
        asm volatile("s_waitcnt lgkmcnt(0)" ::: "memory");
        char* Ob = (char*)(cur.O + (size_t)(wid * QBLK) * DM);
        const unsigned ovo = (unsigned)((lane >> 4) * (DM * 2) + (lane & 15) * 16);
#pragma unroll
        for (int i = 0; i < 8; ++i) { const u32x4 w = *(const u32x4*)(Qw + i * 1024 + lane * 16);
            GAS char* Obi = (GAS char*)(Ob + (size_t)i * (4 * DM * 2)); asm volatile("" : "+s"(Obi));
            *(GAS u32x4*)(Obi + ovo) = w; }
        asm volatile("s_waitcnt lgkmcnt(0)" ::: "memory");
    }
    __syncthreads();
#undef RESC
#undef KBASE
#undef MASKT
#undef HALF_STEP
}
#undef VMW
#undef SLOAD_H
#undef SWRITE_HK
#undef SWRITE_HV
#undef SWRITE_H
#undef MLOAD
#undef KVROW
}

__device__ __forceinline__ int t5_bucket(int rel) {
    if (rel < 16) return rel;
    int v = 16 + (int)(logf((float)rel / 16.f) / logf(8.f) * 16.f);
    return v < 31 ? v : 31;
}
__device__ __forceinline__ att::BlockRef p4_ref(Frame& F, int it, int pass) {
    const int b = it >> 5, h = (it >> 2) & 7, p = it & 3, kvh = h >> 2, qb = pass ? 7 - p : p;
    const bf16* Pb = F.P + (size_t)b * SEQ * PLD;
    att::BlockRef r; r.P0 = qb * 256;
    r.Q = Pb + (size_t)r.P0 * PLD + C_Q + h * HD; r.K = Pb + C_K + kvh * HD;
    r.O = F.CAT + (size_t)(b * SEQ + r.P0) * DM + POOLW + h * HD; r.M = F.MASK + (size_t)(b * SEQ + r.P0) * 64;
    return r;
}
__device__ __forceinline__ void p4_attention(Frame& F, int nitems) {
    LAS float* btab = (LAS float*)(F.lds + MISC_BASE + MO_BIAS);
    char* lds = (char*)F.lds;
    int it = F.vcu, pass = 0;
    if (it >= nitems) return;
    att::Seam S;
    { const att::BlockRef c0 = p4_ref(F, it & 255, 0); att::attn_prime(c0, lds, S, F.wave, F.lane); }
    for (;;) {
        if (pass == 0) {
            const int h = (it >> 2) & 7;
            __syncthreads();
            for (int i = F.tid; i < att::NBIAS; i += NTHR) { const int rel = att::RMAX - i; float v = 0.f;
                if (rel >= 0) v = (F.rel_bias[t5_bucket(rel) * NHEAD + h] - F.rel_bias[31 * NHEAD + h]) * (1.f / att::SCALE);
                btab[i] = v; }
            __syncthreads();
        }
        const bool more_item = it + F.G < nitems, last = (pass == 1) && !more_item;
        const int itn = (pass == 0) ? it : (more_item ? it + F.G : it), passn = (pass == 0) ? 1 : (more_item ? 0 : 1);
        const att::BlockRef cur = p4_ref(F, it & 255, pass), nxt = p4_ref(F, itn & 255, passn);
        att::attn_block(cur, nxt, lds, btab, S, F.wave, F.lane);
        if (last) break;
        it = itn; pass = passn;
    }
}

constexpr int P6_ROWS = 32, P6_PITCH = 4112;
constexpr int P6_LOG = P6_ROWS * P6_PITCH;
static_assert(P6_LOG + P6_ROWS * 48 * 4 <= MISC_BASE, "P6 LDS");
struct P6Claim { int m, ex1, ex2; unsigned p1, p2; float g1, g2; };
__device__ __forceinline__ P6Claim p6_route_claim(Frame& F, const LAS float* lg, const LAS float* bl, int m) {
    float gmax = lg[0] + bl[0]; int gsel = 0;
#pragma unroll
    for (int i = 1; i < NGRP; ++i) { const float v = lg[i] + bl[i]; if (v > gmax) { gmax = v; gsel = i; } }
    float gz = 0.f;
#pragma unroll
    for (int i = 0; i < NGRP; ++i) gz += __expf(lg[i] + bl[i] - gmax);
    const float pg = 1.f / gz;
    float e1v = -3.0e38f, e2v = -3.0e38f; int i1 = 0, i2 = 0;
#pragma unroll
    for (int i = 0; i < EPG; ++i) { const float v = lg[4 + gsel * EPG + i] + bl[4 + gsel * EPG + i];
        if (v > e1v) { e2v = e1v; i2 = i1; e1v = v; i1 = i; } else if (v > e2v) { e2v = v; i2 = i; } }
    const float w1 = 1.f / (1.f + __expf(e2v - e1v)), w2 = 1.f - w1;
    P6Claim c; c.m = m; c.ex1 = gsel * EPG + i1; c.ex2 = gsel * EPG + i2; c.g1 = pg * w1; c.g2 = pg * w2;
    c.p1 = atomicAdd(F.ctl + CW_ECNT + 16 * c.ex1, 1u); c.p2 = atomicAdd(F.ctl + CW_ECNT + 16 * c.ex2, 1u);
    return c;
}
__device__ __forceinline__ void p6_route_commit(Frame& F, const P6Claim& c) {
    F.TOKLIST[c.ex1 * NTOK + (int)c.p1] = c.m; F.TOKLIST[c.ex2 * NTOK + (int)c.p2] = c.m;
    unsigned* ti = F.TOKINFO + (size_t)c.m * 8;
    ti[0] = (unsigned)c.ex1; ti[1] = c.p1; ti[2] = (unsigned)c.ex2; ti[3] = c.p2; ti[4] = __float_as_uint(c.g1); ti[5] = __float_as_uint(c.g2);
}
__device__ __forceinline__ void p6_route(Frame& F, const LAS float* lg, int m) {
    float gmax = lg[0] + F.b_group[0]; int gsel = 0;
#pragma unroll
    for (int i = 1; i < NGRP; ++i) { const float v = lg[i] + F.b_group[i]; if (v > gmax) { gmax = v; gsel = i; } }
    float gz = 0.f;
#pragma unroll
    for (int i = 0; i < NGRP; ++i) gz += __expf(lg[i] + F.b_group[i] - gmax);
    const float pg = 1.f / gz;
    float e1v = -3.0e38f, e2v = -3.0e38f; int i1 = 0, i2 = 0;
#pragma unroll
    for (int i = 0; i < EPG; ++i) { const float v = lg[4 + gsel * EPG + i] + F.b_router[gsel * EPG + i];
        if (v > e1v) { e2v = e1v; i2 = i1; e1v = v; i1 = i; } else if (v > e2v) { e2v = v; i2 = i; } }
    const float w1 = 1.f / (1.f + __expf(e2v - e1v)), w2 = 1.f - w1;
    const int ex1 = gsel * EPG + i1, ex2 = gsel * EPG + i2;
    const unsigned p1 = atomicAdd(F.ctl + CW_ECNT + 16 * ex1, 1u), p2 = atomicAdd(F.ctl + CW_ECNT + 16 * ex2, 1u);
    F.TOKLIST[ex1 * NTOK + (int)p1] = m; F.TOKLIST[ex2 * NTOK + (int)p2] = m;
    unsigned* ti = F.TOKINFO + (size_t)m * 8;
    ti[0] = (unsigned)ex1; ti[1] = p1; ti[2] = (unsigned)ex2; ti[3] = p2; ti[4] = __float_as_uint(pg * w1); ti[5] = __float_as_uint(pg * w2);
}
__device__ __forceinline__ void p6_norm_router(Frame& F, bool route) {
    LAS unsigned char* tile = F.lds;
    LAS float* logit = (LAS float*)(F.lds + P6_LOG);
    const int lane = F.lane, wave = F.wave, fr = lane & 15, fq = lane >> 4;
    int prev_m0 = -1;
    for (int grp = F.bid; grp < NTOK / P6_ROWS; grp += F.G) {
        const int m0 = grp * P6_ROWS, b = m0 / SEQ;
        const float* modb = F.mod + (size_t)b * (6 * DM);
        u32x2 xb[4][8];
#pragma unroll
        for (int rr = 0; rr < 4; ++rr)
#pragma unroll
            for (int j = 0; j < 8; ++j) xb[rr][j] = *(const u32x2*)(F.X1 + (size_t)(m0 + 4 * wave + rr) * DM + 256 * j + 4 * lane);
        f32x4 gs[8], sh[8];
#pragma unroll
        for (int j = 0; j < 8; ++j) { const int col = 256 * j + 4 * lane; const f32x4 g = *(const f32x4*)(F.g_ffn + col), sc = *(const f32x4*)(modb + 4 * DM + col);
            gs[j] = g * (sc + 1.f); sh[j] = *(const f32x4*)(modb + 3 * DM + col); }
        if (route && prev_m0 >= 0 && lane < 4) p6_route(F, logit + (4 * wave + lane) * 48, prev_m0 + 4 * wave + lane);
#pragma unroll
        for (int rr = 0; rr < 4; ++rr) {
            const int lr = 4 * wave + rr, m = m0 + lr;
            f32x4 v[8]; float s = 0.f;
#pragma unroll
            for (int j = 0; j < 8; ++j) { const u32x2 q = xb[rr][j];
                v[j][0] = __uint_as_float(q.x << 16); v[j][1] = __uint_as_float(q.x & 0xffff0000u); v[j][2] = __uint_as_float(q.y << 16); v[j][3] = __uint_as_float(q.y & 0xffff0000u);
                s += (v[j][0] * v[j][0] + v[j][1] * v[j][1]) + (v[j][2] * v[j][2] + v[j][3] * v[j][3]); }
            const float rstd = 1.f / sqrtf(wave_sum(s) * (1.f / DM) + EPS);
            unsigned char* orow = (unsigned char*)F.H + (size_t)m * DM;
#pragma unroll
            for (int j = 0; j < 8; ++j) { const f32x4 y = v[j] * rstd * gs[j] + sh[j];
                u32x2 o; o.x = cvt_pk_bf16(y[0], y[1]); o.y = cvt_pk_bf16(y[2], y[3]);
                *(unsigned*)(orow + 256 * j + 4 * lane) = pk4_fp8(y[0], y[1], y[2], y[3]);
                *(LAS u32x2*)(tile + lr * P6_PITCH + (256 * j + 4 * lane) * 2) = o; }
        }
        __syncthreads();
        if (wave < 6) {
            const int rb = wave / 3, nb = wave - 3 * rb;
            f32x4 acc = (f32x4){0.f, 0.f, 0.f, 0.f};
            const LAS unsigned char* ap = tile + (rb * 16 + fr) * P6_PITCH + 16 * fq;
            const bf16* bp = F.RW + (size_t)(nb * 16 + fr) * DM + 8 * fq;
#pragma unroll 16
            for (int ks = 0; ks < 64; ++ks) acc = __builtin_amdgcn_mfma_f32_16x16x32_bf16(*(const LAS bf16x8*)(ap + 64 * ks), *(const bf16x8*)(bp + 32 * ks), acc, 0, 0, 0);
#pragma unroll
            for (int j = 0; j < 4; ++j) logit[(rb * 16 + 4 * fq + j) * 48 + nb * 16 + fr] = acc[j];
        }
        __syncthreads();
        prev_m0 = m0;
    }
    if (route && prev_m0 >= 0 && lane < 4) p6_route(F, logit + (4 * wave + lane) * 48, prev_m0 + 4 * wave + lane);
}
constexpr int S6_ROWS = 16, S6_LOG = S6_ROWS * P6_PITCH, S6_CTR = 69120, S6_SCR_HI = 69632, S6_BIAS = 73728;
static_assert(S6_LOG + S6_ROWS * 48 * 4 <= S6_CTR && S6_SCR_HI + 4 * 16640 <= MISC_BASE, "side-by-side LDS map");
__device__ __forceinline__ void bar4(volatile LAS unsigned* cnt, unsigned& target, int lane) {
    asm volatile("s_waitcnt lgkmcnt(0)" ::: "memory");
    target += 4u;
    if (lane == 0) (void)__hip_atomic_fetch_add((LAS unsigned*)cnt, 1u, __ATOMIC_RELAXED, __HIP_MEMORY_SCOPE_WORKGROUP);
    while (*cnt < target) __builtin_amdgcn_s_sleep(1);
    asm volatile("" ::: "memory");
}
__device__ __forceinline__ void s6_router(Frame& F, volatile LAS unsigned* bcnt) {
    LAS unsigned char* tile = F.lds;
    LAS float* logit = (LAS float*)(F.lds + S6_LOG);
    const int lane = F.lane, wave = F.wave, fr = lane & 15, fq = lane >> 4;
    unsigned btarget = 0u; int prev_m0 = -1;
    P6Claim pend; pend.m = -1; pend.ex1 = pend.ex2 = 0; pend.p1 = pend.p2 = 0u; pend.g1 = pend.g2 = 0.f;
    u32x2 xb[4][8];
    f32x4 gv[8], sc[8], sh[8];
#define S6_LOADX(g_) do { _Pragma("unroll") for (int rr = 0; rr < 4; ++rr) _Pragma("unroll") for (int j = 0; j < 8; ++j) \
        xb[rr][j] = *(const u32x2*)(F.X1 + (size_t)((g_) * S6_ROWS + 4 * wave + rr) * DM + 256 * j + 4 * lane); } while (0)
#define S6_LOADM(g_) do { const float* modb_ = F.mod + (size_t)(((g_) * S6_ROWS) / SEQ) * (6 * DM); _Pragma("unroll") for (int j = 0; j < 8; ++j) { const int col = 256 * j + 4 * lane; \
        gv[j] = *(const f32x4*)(F.g_ffn + col); sc[j] = *(const f32x4*)(modb_ + 4 * DM + col); sh[j] = *(const f32x4*)(modb_ + 3 * DM + col); } } while (0)
    const bf16* bp = F.RW + (size_t)((wave < 3 ? wave : 0) * 16 + fr) * DM + 8 * fq;
#define S6_LOADB(f, q) do { _Pragma("unroll") for (int u = 0; u < 32; ++u) f[u] = *(const bf16x8*)(bp + 32 * (32 * (q) + u)); } while (0)
#define S6_MMA(f, q) do { _Pragma("unroll") for (int u = 0; u < 32; ++u) { acc = __builtin_amdgcn_mfma_f32_16x16x32_bf16(*(const LAS bf16x8*)(ap + 64 * (32 * (q) + u)), f[u], acc, 0, 0, 0); \
        if ((u & 3) == 3) __builtin_amdgcn_sched_barrier(0); } } while (0)
    LAS float* bl = (LAS float*)(F.lds + S6_BIAS) + wave * 64;
    if (lane < 36) bl[lane] = (lane < 4) ? F.b_group[lane] : F.b_router[lane - 4];
    if (F.bid < NTOK / S6_ROWS) { S6_LOADX(F.bid); }
    for (int grp = F.bid; grp < NTOK / S6_ROWS; grp += F.G) {
        const int m0 = grp * S6_ROWS;
        S6_LOADM(grp);
        if (lane < 4) { if (pend.m >= 0) p6_route_commit(F, pend); pend.m = -1;
            if (prev_m0 >= 0) pend = p6_route_claim(F, logit + (4 * wave + lane) * 48, bl, prev_m0 + 4 * wave + lane); }
        bar4(bcnt, btarget, lane);
#pragma unroll
        for (int rr = 0; rr < 4; ++rr) {
            const int lr = 4 * wave + rr, m = m0 + lr;
            f32x4 v[8]; float s = 0.f;
#pragma unroll
            for (int j = 0; j < 8; ++j) { const u32x2 q = xb[rr][j];
                v[j][0] = __uint_as_float(q.x << 16); v[j][1] = __uint_as_float(q.x & 0xffff0000u); v[j][2] = __uint_as_float(q.y << 16); v[j][3] = __uint_as_float(q.y & 0xffff0000u);
                s += (v[j][0] * v[j][0] + v[j][1] * v[j][1]) + (v[j][2] * v[j][2] + v[j][3] * v[j][3]); }
            const float rstd = 1.f / sqrtf(wave_sum(s) * (1.f / DM) + EPS);
            unsigned char* orow = (unsigned char*)F.H + (size_t)m * DM;
#pragma unroll
            for (int j = 0; j < 8; ++j) { const f32x4 y = v[j] * rstd * (gv[j] * (sc[j] + 1.f)) + sh[j];
                u32x2 o; o.x = cvt_pk_bf16(y[0], y[1]); o.y = cvt_pk_bf16(y[2], y[3]);
                *(unsigned*)(orow + 256 * j + 4 * lane) = pk4_fp8(y[0], y[1], y[2], y[3]);
                *(LAS u32x2*)(tile + lr * P6_PITCH + (256 * j + 4 * lane) * 2) = o; }
        }
        const bool more = grp + F.G < NTOK / S6_ROWS;
        if (more) S6_LOADX(grp + F.G);
        bf16x8 fa[32];
        bar4(bcnt, btarget, lane);
        if (wave < 3) {
            S6_LOADB(fa, 0);
            const int nb = wave;
            f32x4 acc = (f32x4){0.f, 0.f, 0.f, 0.f};
            const LAS unsigned char* ap = tile + fr * P6_PITCH + 16 * fq;
            __builtin_amdgcn_sched_barrier(0);
            S6_MMA(fa, 0); S6_LOADB(fa, 1); __builtin_amdgcn_sched_barrier(0);
            S6_MMA(fa, 1);
#pragma unroll
            for (int j = 0; j < 4; ++j) logit[(4 * fq + j) * 48 + nb * 16 + fr] = acc[j];
        }
        bar4(bcnt, btarget, lane);
        prev_m0 = m0;
    }
    if (lane < 4) { if (pend.m >= 0) p6_route_commit(F, pend);
        if (prev_m0 >= 0) { const P6Claim c = p6_route_claim(F, logit + (4 * wave + lane) * 48, bl, prev_m0 + 4 * wave + lane); p6_route_commit(F, c); } }
    bar4(bcnt, btarget, lane);
#undef S6_LOADX
#undef S6_LOADM
#undef S6_LOADB
#undef S6_MMA
}
constexpr int S32_GS = MISC_BASE + MO_ROWTAB, S32_SH = MISC_BASE + 11456, S32_BIAS = MISC_BASE + MO_BIAS, S32_CTR = MISC_BASE + MO_BARW + 64;
static_assert(S32_SH + 8192 <= LDS_TOTAL && S32_SH >= MISC_BASE + MO_BIAS + 304 * 4 && (S32_SH & 15) == 0 && MO_BARW + 64 + 16 <= MO_TB, "32-row router LDS map");
__device__ __forceinline__ void s6_router32(Frame& F, volatile LAS unsigned* bcnt) {
    LAS unsigned char* tile = F.lds;
    LAS float* logit = (LAS float*)(F.lds + P6_LOG);
    LAS f32x4* gsL = (LAS f32x4*)(F.lds + S32_GS); LAS f32x4* shL = (LAS f32x4*)(F.lds + S32_SH);
    int lane = F.lane; const int wave = F.wave;
    unsigned btarget = 0u; int prev_m0 = -1;
    P6Claim pend; pend.m = -1; pend.ex1 = pend.ex2 = 0; pend.p1 = pend.p2 = 0u; pend.g1 = pend.g2 = 0.f;
    u32x2 xa[4][8], xc[4][8];
    f32x4 mg[2], msc[2], msh[2];
#define S32_LOADXA(g_) do { _Pragma("unroll") for (int rr = 0; rr < 4; ++rr) _Pragma("unroll") for (int j = 0; j < 8; ++j) \
        xa[rr][j] = *(const u32x2*)(F.X1 + (size_t)((g_) * 32 + 8 * wave + rr) * DM + 256 * j + 4 * lane); } while (0)
#define S32_LOADXC(g_) do { _Pragma("unroll") for (int rr = 0; rr < 4; ++rr) _Pragma("unroll") for (int j = 0; j < 8; ++j) \
        xc[rr][j] = *(const u32x2*)(F.X1 + (size_t)((g_) * 32 + 8 * wave + 4 + rr) * DM + 256 * j + 4 * lane); } while (0)
#define S32_LOADM(g_) do { const float* modb_ = F.mod + (size_t)(((g_) * 32) / SEQ) * (6 * DM); _Pragma("unroll") for (int q = 0; q < 2; ++q) { const int col = 256 * (2 * wave + q) + 4 * lane; \
        mg[q] = *(const f32x4*)(F.g_ffn + col); msc[q] = *(const f32x4*)(modb_ + 4 * DM + col); msh[q] = *(const f32x4*)(modb_ + 3 * DM + col); } } while (0)
#define S32_NORM(xb, r0) do { _Pragma("unroll") for (int rr = 0; rr < 4; ++rr) { \
            const int lr = 8 * wave + (r0) + rr, m = m0 + lr; \
            f32x4 v[8]; float s = 0.f; \
            _Pragma("unroll") for (int j = 0; j < 8; ++j) { const u32x2 q = xb[rr][j]; \
                v[j][0] = __uint_as_float(q.x << 16); v[j][1] = __uint_as_float(q.x & 0xffff0000u); v[j][2] = __uint_as_float(q.y << 16); v[j][3] = __uint_as_float(q.y & 0xffff0000u); \
                s += (v[j][0] * v[j][0] + v[j][1] * v[j][1]) + (v[j][2] * v[j][2] + v[j][3] * v[j][3]); } \
            const float rstd = 1.f / sqrtf(wave_sum(s) * (1.f / DM) + EPS); \
            unsigned char* orow = (unsigned char*)F.H + (size_t)m * DM; \
            _Pragma("unroll") for (int j = 0; j < 8; ++j) { const f32x4 y = v[j] * rstd * gsL[j * 64 + lane] + shL[j * 64 + lane]; \
                u32x2 o; o.x = cvt_pk_bf16(y[0], y[1]); o.y = cvt_pk_bf16(y[2], y[3]); \
                *(unsigned*)(orow + 256 * j + 4 * lane) = pk4_fp8(y[0], y[1], y[2], y[3]); \
                *(LAS u32x2*)(tile + lr * P6_PITCH + (256 * j + 4 * lane) * 2) = o; } } } while (0)
    LAS float* bl = (LAS float*)(F.lds + S32_BIAS) + wave * 64;
    if (lane < 36) bl[lane] = (lane < 4) ? F.b_group[lane] : F.b_router[lane - 4];
    constexpr int NG = NTOK / 32;
    if (F.bid < NG) { S32_LOADM(F.bid); }
    for (int grp = F.bid; grp < NG; grp += F.G) {
        asm volatile("" : "+v"(lane));
        const int fr = lane & 15, fq = lane >> 4;
        const int m0 = grp * 32;
        if (lane < 8) { if (pend.m >= 0) p6_route_commit(F, pend); pend.m = -1;
            if (prev_m0 >= 0) pend = p6_route_claim(F, logit + (8 * wave + lane) * 48, bl, prev_m0 + 8 * wave + lane); }
        S32_LOADXA(grp); S32_LOADXC(grp);
#pragma unroll
        for (int q = 0; q < 2; ++q) { gsL[(2 * wave + q) * 64 + lane] = mg[q] * (msc[q] + 1.f); shL[(2 * wave + q) * 64 + lane] = msh[q]; }
        bar4(bcnt, btarget, lane);
        S32_NORM(xa, 0);
        const bool more = grp + F.G < NG;
        S32_NORM(xc, 4);
        bar4(bcnt, btarget, lane);
        if (wave < 3) {
            const int nb = wave;
            const bf16* bp = F.RW + (size_t)(nb * 16 + fr) * DM + 8 * fq;
            f32x4 acc0 = (f32x4){0.f, 0.f, 0.f, 0.f}, acc1 = acc0;
            const LAS unsigned char* ap = tile + fr * P6_PITCH + 16 * fq;
            bf16x8 fa[32];
#pragma unroll
            for (int h = 0; h < 2; ++h) {
#pragma unroll
                for (int u = 0; u < 32; ++u) fa[u] = *(const bf16x8*)(bp + 32 * (32 * h + u));
                __builtin_amdgcn_sched_barrier(0);
#pragma unroll
                for (int u = 0; u < 32; ++u) { const int ks = 32 * h + u;
                    acc0 = __builtin_amdgcn_mfma_f32_16x16x32_bf16(*(const LAS bf16x8*)(ap + 64 * ks), fa[u], acc0, 0, 0, 0);
                    acc1 = __builtin_amdgcn_mfma_f32_16x16x32_bf16(*(const LAS bf16x8*)(ap + 16 * P6_PITCH + 64 * ks), fa[u], acc1, 0, 0, 0);
                    if ((u & 3) == 3) __builtin_amdgcn_sched_barrier(0); }
            }
#pragma unroll
            for (int j = 0; j < 4; ++j) { logit[(4 * fq + j) * 48 + nb * 16 + fr] = acc0[j]; logit[(16 + 4 * fq + j) * 48 + nb * 16 + fr] = acc1[j]; }
        }
        if (more) { S32_LOADM(grp + F.G); }
        bar4(bcnt, btarget, lane);
        prev_m0 = m0;
    }
    if (lane < 8) { if (pend.m >= 0) p6_route_commit(F, pend);
        if (prev_m0 >= 0) { const P6Claim c = p6_route_claim(F, logit + (8 * wave + lane) * 48, bl, prev_m0 + 8 * wave + lane); p6_route_commit(F, c); } }
    bar4(bcnt, btarget, lane);
#undef S32_LOADXA
#undef S32_LOADXC
#undef S32_LOADM
#undef S32_NORM
}
__device__ __forceinline__ int lds_pop(LAS unsigned* ctr, int lane) {
    int v = 0; if (lane == 0) v = (int)__hip_atomic_fetch_add(ctr, 1u, __ATOMIC_RELAXED, __HIP_MEMORY_SCOPE_WORKGROUP);
    return __builtin_amdgcn_readfirstlane(v);
}
__device__ __forceinline__ void s6_convert(Frame& F, LAS unsigned* ctr, int a0, int total) {
    f32x4 va[16], vb[16]; u32x4 o[8]; P0Tile ta, tb, t;
    int da = F.bid + F.G * lds_pop(ctr, F.lane);
    if (da >= total) return;
    ta = p0_decode(F, a0 + da); p0_tile_load(ta, va, F.lane);
    int db = F.bid + F.G * lds_pop(ctr, F.lane);
    if (db < total) { tb = p0_decode(F, a0 + db); p0_tile_load(tb, vb, F.lane); }
    for (;;) {
        p0_tile_pack(ta, va, o); t = ta;
        da = F.bid + F.G * lds_pop(ctr, F.lane);
        if (da < total) { ta = p0_decode(F, a0 + da); p0_tile_load(ta, va, F.lane); }
        p0_tile_store(t, o, F.lane);
        if (db >= total) break;
        p0_tile_pack(tb, vb, o); t = tb;
        db = F.bid + F.G * lds_pop(ctr, F.lane);
        if (db < total) { tb = p0_decode(F, a0 + db); p0_tile_load(tb, vb, F.lane); }
        p0_tile_store(t, o, F.lane);
        if (da >= total) break;
    }
}
__device__ __forceinline__ void p6_side_by_side(Frame& F) {
    LAS unsigned* ctrs = (LAS unsigned*)(F.lds + S32_CTR);
    __syncthreads();
    if (F.tid == 0) { ctrs[0] = 0u; ctrs[1] = 0u; }
    __syncthreads();
    constexpr int A0 = P0_EARLY_A + P0_R2;
    const int total = P0_R2;
    if (F.wave < 4) { __builtin_amdgcn_s_setprio(3); s6_router32(F, (volatile LAS unsigned*)ctrs); __builtin_amdgcn_s_setprio(0); s6_convert(F, ctrs + 1, A0, total); }
    else s6_convert(F, ctrs + 1, A0, total);
}

__device__ __forceinline__ pg8::MoeTabs moe_tabs(Frame& F) {
    pg8::MoeTabs T; T.tb = (const LAS int*)(F.lds + MISC_BASE + MO_TB); T.tf = T.tb + 40; T.hl = T.tb + 80; T.te = (const LAS int*)(F.lds + MISC_BASE + MO_BIAS); return T;
}
__device__ __forceinline__ void p7_tail_convert(Frame& F) {
    const pg8::MoeTabs T = moe_tabs(F);
    const int total = (T.tf[NEXP] + T.hl[NEXP]) * 4, rem = total % F.G;
    int rank = F.vcu, cnt = F.G;
    if (rem != 0 && F.G - rem >= F.G / 4) { if (F.vcu < rem) return; rank = F.vcu - rem; cnt = F.G - rem; }
    const int a0 = P0_R0 + P0_R1 + 2 * P0_R2, len = (F.G == 256) ? P0_DEF_E0 * 256 : P0_R2;
    p0_run(F, rank * NWAVES + F.wave, cnt * NWAVES, a0, len, 0, 0);
}
__device__ __forceinline__ void moe_tables(Frame& F) {
    LAS int* tb = (LAS int*)(F.lds + MISC_BASE + MO_TB); LAS int* tf = tb + 40; LAS int* hl = tb + 80; LAS int* cnt = (LAS int*)(F.lds + MISC_BASE + MO_CNT);
    __syncthreads();
    if (F.tid < NEXP) cnt[F.tid] = (int)__hip_atomic_load(F.ctl + CW_ECNT + 16 * F.tid, __ATOMIC_RELAXED, __HIP_MEMORY_SCOPE_AGENT);
    __syncthreads();
    if (F.tid == 0) { int s = 0, f = 0, nh = 0;
        for (int e = 0; e < NEXP; ++e) { const int c = cnt[e], t = (c + 255) >> 8, rem = c - ((t - 1) << 8), h = (t > 0 && rem <= 128) ? 1 : 0;
            tb[e] = s; tf[e] = f; s += t; f += t - h; if (h) hl[nh++] = e; }
        tb[NEXP] = s; tf[NEXP] = f; hl[NEXP] = nh; }
    __syncthreads();
    { LAS int* te = (LAS int*)(F.lds + MISC_BASE + MO_BIAS);
      if (F.tid < MAXSLOT / 256) { int x = 0; while (x < NEXP - 1 && tf[x + 1] <= F.tid) ++x; te[F.tid] = x; } }
    __syncthreads();
}
__device__ __forceinline__ void p7_rowtab(Frame& F, int reps) {
    const pg8::MoeTabs T = moe_tabs(F); const LAS int* cnt = (const LAS int*)(F.lds + MISC_BASE + MO_CNT);
    LAS unsigned* rowtab = (LAS unsigned*)(F.lds + MISC_BASE + MO_ROWTAB);
    unsigned off[MAXU * 256 / NTHR];
#pragma unroll
    for (int q = 0; q < MAXU * 256 / NTHR; ++q) { const int idx = F.tid + q * NTHR, ord = idx >> 8, r = idx & 255; int pm, pn, e, half; off[q] = 0u;
        if (pg8::moe_unit(T, 4, ord * F.G + F.vcu, reps, pm, pn, e, half)) {
            const int slot = (pm - T.tb[e]) * 256 + r; if (slot < cnt[e]) off[q] = (unsigned)F.TOKLIST[e * NTOK + slot] * (unsigned)DM; } }
#pragma unroll
    for (int q = 0; q < MAXU * 256 / NTHR; ++q) rowtab[F.tid + q * NTHR] = off[q];
    __syncthreads();
}
struct P9Row { u32x2 x[8]; int ya[8], yc[8]; };
__device__ __forceinline__ void p9_load(Frame& F, const LAS int* tb, int m, int e1, int p1, int e2, int p2, P9Row& R, int lane) {
    const bf16* x1r = F.X1 + (size_t)m * DM;
    const unsigned char* y1 = (const unsigned char*)F.Y + ((size_t)tb[e1] * 256 + p1) * DM; const unsigned char* y2 = (const unsigned char*)F.Y + ((size_t)tb[e2] * 256 + p2) * DM;
#pragma unroll
    for (int j = 0; j < 8; ++j) { const int col = 256 * j + 4 * lane; R.x[j] = *(const u32x2*)(x1r + col); R.ya[j] = *(const int*)(y1 + col); R.yc[j] = *(const int*)(y2 + col); }
}
__device__ __forceinline__ void p9_final(Frame& F) {
    const LAS int* tb = (const LAS int*)(F.lds + MISC_BASE + MO_TB);
    const int gw = F.bid * NWAVES + F.wave, NGW = F.G * NWAVES, lane = F.lane;
    for (int grp = gw; grp < NTOK / 8; grp += NGW) {
        const int m0 = grp * 8, b = m0 / SEQ;
        const unsigned tiw = (lane < 48) ? F.TOKINFO[(size_t)(m0 + lane / 6) * 8 + (lane % 6)] : 0u;
        f32x4 gt[8], gf[8];
#pragma unroll
        for (int j = 0; j < 8; ++j) { const int col = 256 * j + 4 * lane; gt[j] = *(const f32x4*)(F.mod + (size_t)b * (6 * DM) + 5 * DM + col); gf[j] = *(const f32x4*)(F.g_final + col); }
        P9Row R[2];
#define P9_TI(r, w) __builtin_amdgcn_readlane((int)tiw, 6 * (r) + (w))
        p9_load(F, tb, m0, P9_TI(0, 0), P9_TI(0, 1), P9_TI(0, 2), P9_TI(0, 3), R[0], lane);
#pragma unroll
        for (int r = 0; r < 8; ++r) {
            if (r + 1 < 8) p9_load(F, tb, m0 + r + 1, P9_TI(r + 1, 0), P9_TI(r + 1, 1), P9_TI(r + 1, 2), P9_TI(r + 1, 3), R[(r + 1) & 1], lane);
            const P9Row& C = R[r & 1];
            const float g1s = __uint_as_float((unsigned)P9_TI(r, 4)) * (1.f / Y_SCALE), g2s = __uint_as_float((unsigned)P9_TI(r, 5)) * (1.f / Y_SCALE);
            f32x4 v[8]; float s = 0.f;
#pragma unroll
            for (int j = 0; j < 8; ++j) { const u32x2 xb = C.x[j]; const int a = C.ya[j], c = C.yc[j];
                f32x4 xv; xv[0] = __uint_as_float(xb.x << 16); xv[1] = __uint_as_float(xb.x & 0xffff0000u); xv[2] = __uint_as_float(xb.y << 16); xv[3] = __uint_as_float(xb.y & 0xffff0000u);
                f32x4 ya, yc;
                { const f32x2 lo = __builtin_amdgcn_cvt_pk_f32_fp8(a, false), hi = __builtin_amdgcn_cvt_pk_f32_fp8(a, true); ya[0] = lo[0]; ya[1] = lo[1]; ya[2] = hi[0]; ya[3] = hi[1]; }
                { const f32x2 lo = __builtin_amdgcn_cvt_pk_f32_fp8(c, false), hi = __builtin_amdgcn_cvt_pk_f32_fp8(c, true); yc[0] = lo[0]; yc[1] = lo[1]; yc[2] = hi[0]; yc[3] = hi[1]; }
                v[j] = xv + gt[j] * (ya * g1s + yc * g2s);
                s += (v[j][0] * v[j][0] + v[j][1] * v[j][1]) + (v[j][2] * v[j][2] + v[j][3] * v[j][3]); }
            const float rstd = 1.f / sqrtf(wave_sum(s) * (1.f / DM) + EPS);
            float* xr = F.out + (size_t)(m0 + r) * DM;
#pragma unroll
            for (int j = 0; j < 8; ++j) *(f32x4*)(xr + 256 * j + 4 * lane) = v[j] * rstd * gf[j];
        }
#undef P9_TI
    }
}

struct Args { const float* in[19]; float* out; unsigned char* ws; int ph_lo, ph_hi; };
constexpr int N_PHASES = 10;
__global__ void __launch_bounds__(NTHR, 2) fwd(Args args) {
    extern __shared__ __attribute__((aligned(16))) unsigned char lds_raw[];
    Frame F;
    F.lds = (LAS unsigned char*)lds_raw;
    F.wave = __builtin_amdgcn_readfirstlane((int)threadIdx.x >> 6); F.lane = lane_now(); F.tid = F.wave * 64 + F.lane; F.G = gridDim.x; F.bid = blockIdx.x; F.vcu = (F.G % 8 == 0) ? (F.bid % 8) * (F.G / 8) + F.bid / 8 : F.bid;
    unsigned char* ws = args.ws;
    F.ctl = (unsigned*)(ws + WS_CTL);
    F.x = args.in[0]; F.c = args.in[1]; F.w_ada = args.in[2]; F.b_ada = args.in[3]; F.g_mix = args.in[4]; F.w_in = args.in[5]; F.w_pool = args.in[6]; F.pool_scale = args.in[7];
    F.rel_bias = args.in[8]; F.w_out = args.in[9]; F.g_ffn = args.in[10]; F.w_group = args.in[11]; F.b_group = args.in[12]; F.w_router = args.in[13]; F.b_router = args.in[14];
    F.w_gate = args.in[15]; F.w_up = args.in[16]; F.w_down = args.in[17]; F.g_final = args.in[18];
    F.out = args.out; F.mod = (float*)(ws + WS_MOD);
    F.RW = (bf16*)(ws + WS_RW); F.WpT = (bf16*)(ws + WS_WPT); F.WinP = (bf16*)(ws + WS_WINP); F.Win = (bf16*)(ws + WS_WIN); F.Wout = (bf16*)(ws + WS_WOUT);
    F.Wgu = (bf16*)(ws + WS_WGU); F.Wd = (bf16*)(ws + WS_WD); F.H = (bf16*)(ws + WS_H); F.P = (bf16*)(ws + WS_P); F.CAT = (bf16*)(ws + WS_CAT); F.Y = (bf16*)(ws + WS_Y); F.A = (bf16*)(ws + WS_A); F.X1 = (bf16*)(ws + WS_X1);
    F.MASK = (unsigned*)(ws + WS_MASK); F.TOKLIST = (int*)(ws + WS_TOKLIST); F.TOKINFO = (unsigned*)(ws + WS_TOKINFO);
    volatile LAS unsigned* barw = (volatile LAS unsigned*)(F.lds + MISC_BASE + MO_BARW);
    if (F.tid < 4) barw[F.tid] = 0u;
    __syncthreads();
    XcdBarrier bar; bar.bar = F.ctl + CW_BAR; bar.x = 0; bar.st = nullptr; bar.wave = F.wave;
    if (MK_N_LAUNCHES == 1) bar = xcd_barrier_post(F.ctl + CW_BAR, barw, F.wave);
    const int lo = args.ph_lo, hi = args.ph_hi;
#ifndef PH_MASK
#define PH_MASK 0x3ff
#endif
#define IN(k) (((PH_MASK >> (k)) & 1) && lo <= (k) && (k) < hi && (F.lane = lane_now(), F.tid = F.wave * 64 + F.lane, true))
#define SEAM(k) do { if (MK_N_LAUNCHES == 1 && IN(k) && IN((k) + 1)) xcd_barrier(bar); } while (0)
    LAS unsigned char* ring = F.lds;

#define REP(k) for (int rep_ = 0; rep_ < ((PROBE_DUP == (k) && ((k) == 0 || (k) == 6 || (k) == 9 || (k) == 11)) ? 2 : 1); ++rep_)
#define NREP(k) ((PROBE_DUP == (k)) ? 2 : 1)
    unsigned long long pt0_ = 0ull;
#define PT_BEGIN(k) do { if (PROBE_TIME >= 0) { if ((k) > 0 && PROBE_TIME == (k) - 1) { const unsigned long long t1_ = __builtin_amdgcn_s_memrealtime(); \
        if (F.bid == 0 || (k) == 10) { const unsigned long long until_ = t1_ + 4ull * (t1_ - pt0_); while (__builtin_amdgcn_s_memrealtime() < until_) __builtin_amdgcn_s_sleep(8); } } \
        if (PROBE_TIME == (k)) pt0_ = __builtin_amdgcn_s_memrealtime(); } } while (0)
    PT_BEGIN(0);
    if (IN(0)) { REP(0) { p0_prologue(F, CW_Q0 + 64 * rep_); } SEAM(0); }
    PT_BEGIN(1);
    if (IN(1)) {
        REP(1) {
        { pg8::Gemm g{F.WpT, F.WinP, 256, 256, 1024, nullptr}; pg8::FoldOrder S{F.G, F.bid}; pg8::EpiBf16 E{F.Win, DM, F.pool_scale, 1.f};
          pg8::gemm_phase<pg8::EpiBf16, pg8::FoldOrder, false, true>(ring, g, S, E, F.wave); }
        REP(11) { p1_norm_rows(F, F.x, F.g_mix, 0, DM, F.H); }
        }
        SEAM(1);
    }
    PT_BEGIN(2);
    if (IN(2)) {
        REP(2) {
        pg8::Gemm g{F.H, F.Win, DM, DM, DM, nullptr}; pg8::StaticOrder S; S.init(NTOK, PLD, F.G, F.bid); S.reps = NREP(2); pg8::EpiBf16 E{F.P, PLD, nullptr, 1.f};
        pg8::gemm_phase<pg8::EpiBf16, pg8::StaticOrder, false, true>(ring, g, S, E, F.wave);
        }
        p0_deferred(F);
        SEAM(2);
    }
    PT_BEGIN(3);
    if (IN(3)) { if (PROBE_DUP == 3) { p3_window(F); p3_indexer(F); } if (PROBE_DUP == 33) p3_window(F); p3_window(F); p3_indexer(F); SEAM(3); }
    PT_BEGIN(4);
    if (IN(4)) { p4_attention(F, PROBE_DUP == 4 ? 512 : 256); SEAM(4); }
    PT_BEGIN(5);
    if (IN(5)) {
        REP(5) {
        pg8::Gemm g{F.CAT, F.Wout, DM, DM, DM, nullptr}; pg8::StaticOrder S; S.init(NTOK, DM, F.G, F.bid); S.reps = NREP(5); pg8::EpiResid E{F.x, F.X1, F.mod + 2 * DM};
        pg8::gemm_phase<pg8::EpiResid, pg8::StaticOrder, false, true>(ring, g, S, E, F.wave);
        }
        SEAM(5);
    }
    PT_BEGIN(6);
    if (IN(6)) { if (PROBE_DUP == 6) { REP(6) { p6_norm_router(F, rep_ == 0); } p0_late(F); } else p6_side_by_side(F); SEAM(6); }
    PT_BEGIN(7);
    if (IN(7)) {
        moe_tables(F); p7_rowtab(F, NREP(7));
        REP(7) {
        pg8::Gemm g{F.H, F.Wgu, DM / 2, DM / 2, DM / 2, (const LAS unsigned*)(F.lds + MISC_BASE + MO_ROWTAB)};
        pg8::GroupedOrder S{moe_tabs(F), 4, F.G, F.vcu, 1024, NREP(7)}; pg8::EpiGateUp E{(unsigned char*)F.A, 1.f / WGU_SCALE};
        pg8::gemm_phase<pg8::EpiGateUp, pg8::GroupedOrder, true, true, true>(ring, g, S, E, F.wave);
        }
        p7_tail_convert(F);
        SEAM(7);
    }
    PT_BEGIN(8);
    if (IN(8)) {
        if (MK_N_LAUNCHES != 1) moe_tables(F);
        REP(8) {
        pg8::Gemm g{F.A, F.Wd, DEXP / 2, DEXP / 2, DEXP / 2, nullptr};
        pg8::GroupedOrder S{moe_tabs(F), 8, F.G, F.vcu, DM, NREP(8)}; pg8::EpiFp8 E{(unsigned char*)F.Y, DM, Y_SCALE / WD_SCALE};
        pg8::gemm_phase<pg8::EpiFp8, pg8::GroupedOrder, false, P8_ALIGN, true>(ring, g, S, E, F.wave);
        }
        SEAM(8);
    }
    PT_BEGIN(9);
    if (IN(9)) { if (MK_N_LAUNCHES != 1) moe_tables(F); REP(9) { p9_final(F); } }
    PT_BEGIN(10);
#undef REP
#undef NREP
#undef PT_BEGIN
#undef IN
#undef SEAM
}

extern "C" void kernel_launch(void* const* d_in, const int* in_sizes, int n_in, void* d_out, int out_size, void* d_ws, size_t ws_size, hipStream_t stream) {
    static int grid = 0;
    if (grid == 0) {
        if (n_in != 19 || in_sizes[0] != NTOK * DM || out_size != NTOK * DM || ws_size < WS_END) {
            fprintf(stderr, "kernel_launch: unexpected shapes (n_in %d, in0 %d, out %d, ws %zu); nothing launched\n", n_in, n_in > 0 ? in_sizes[0] : -1, out_size, ws_size); grid = -1; return; }
        int dev = 0, cus = 0;
        if (hipGetDevice(&dev) != hipSuccess || hipDeviceGetAttribute(&cus, hipDeviceAttributeMultiprocessorCount, dev) != hipSuccess || cus < 128) { fprintf(stderr, "kernel_launch: device query failed or too few CUs (%d)\n", cus); grid = -1; return; }
        if (hipFuncSetAttribute((const void*)fwd, hipFuncAttributeMaxDynamicSharedMemorySize, LDS_TOTAL) != hipSuccess) { fprintf(stderr, "kernel_launch: hipFuncSetAttribute failed\n"); grid = -1; return; }
        int per_cu = 0;
        if (hipOccupancyMaxActiveBlocksPerMultiprocessor(&per_cu, (const void*)fwd, NTHR, LDS_TOTAL) != hipSuccess || per_cu < 1) fprintf(stderr, "kernel_launch: note: occupancy query reports %d blocks per CU\n", per_cu);
        (void)hipGetLastError();
        grid = cus;
    }
    if (grid < 0) return;
    if (hipMemsetAsync((char*)d_ws + WS_CTL, 0, CTL_ZERO_BYTES, stream) != hipSuccess) { fprintf(stderr, "kernel_launch: memset failed\n"); return; }
    Args a{};
    for (int i = 0; i < 19; ++i) a.in[i] = (const float*)d_in[i];
    a.out = (float*)d_out; a.ws = (unsigned char*)d_ws;
    const int nl = MK_N_LAUNCHES;
    for (int li = 0; li < nl; ++li) {
        a.ph_lo = (nl == 1) ? 0 : li; a.ph_hi = (nl == 1) ? N_PHASES : li + 1;
        hipLaunchKernelGGL(fwd, dim3(grid), dim3(NTHR), LDS_TOTAL, stream, a);
        const hipError_t le = hipPeekAtLastError();
        if (le != hipSuccess) { fprintf(stderr, "kernel_launch: launch %d failed: %s\n", li, hipGetErrorName(le)); break; }
    }
}
```
